# Optimizing an MI355X kernel written in HIP

```python
import math
import jax
import jax.numpy as jnp
from jax import lax
import numpy as np

D_MODEL = 4096
BATCH = 4
SEQ = 4096
DEPTH = 1

GRID_W = 64
CTX_LEN = 256
N_MOD = 6
D_MIX = D_MODEL
S5_WIDTH = D_MIX // 4
S5_GROUP = 16
S5_GROUPS = S5_WIDTH // S5_GROUP
S5_STATE = 64
MLA_NOPE = 128
MLA_ROPE = 64
MLA_V = 128
MLA_HEADS = (D_MIX - S5_WIDTH) // MLA_V
MLA_Q_RANK = D_MODEL // 4
MLA_KV_RANK = 512
MLA_SCALE = (MLA_NOPE + MLA_ROPE) ** -0.5
ROPE_FREQS = MLA_ROPE // 4
ROPE_BASE = 10000.0
IN_SPLITS = (S5_WIDTH, S5_WIDTH + MLA_Q_RANK, S5_WIDTH + MLA_Q_RANK + MLA_KV_RANK)
IN_COLS = IN_SPLITS[-1] + MLA_ROPE
D_FF = ((8 * D_MODEL // 3 + 255) // 256) * 256
CONV_WIDTH = 3
Q_BLOCK = 128
EPS = 1e-6
F32 = jnp.float32

kernel_name = 'hybrid_s5_mla_convffn_dit_layer'


def _rmsnorm(x, g):
    xf = x.astype(F32)
    y = xf * lax.rsqrt(jnp.mean(xf * xf, axis=-1, keepdims=True) + EPS)
    return (y * g.astype(F32)).astype(x.dtype)


def _modulate(h, shift, scale):
    return h * (1.0 + scale) + shift


def _axial_rope_angles(rows):
    row = jnp.repeat(jnp.arange(rows, dtype=F32), GRID_W)
    col = jnp.tile(jnp.arange(GRID_W, dtype=F32), rows)
    inv = ROPE_BASE ** (-jnp.arange(ROPE_FREQS, dtype=F32) / ROPE_FREQS)
    ang = jnp.concatenate([row[:, None] * inv, col[:, None] * inv], axis=-1)
    return jnp.cos(ang), jnp.sin(ang)


def _rope(x, cos, sin):
    xf = x.astype(F32).reshape(x.shape[:-1] + (MLA_ROPE // 2, 2))
    x1, x2 = xf[..., 0], xf[..., 1]
    out = jnp.stack([x1 * cos - x2 * sin, x1 * sin + x2 * cos], axis=-1)
    return out.reshape(x.shape).astype(x.dtype)


def _cmul(ar, ai, br, bi):
    return ar * br - ai * bi, ar * bi + ai * br


def _s5_discretise(lam_re, lam_im, log_step, b_re, b_im):
    lr, li = lam_re.astype(F32), lam_im.astype(F32)
    dt = jnp.exp(log_step.astype(F32))[:, None]
    mag = jnp.exp(lr * dt)
    ar, ai = mag * jnp.cos(li * dt), mag * jnp.sin(li * dt)
    den = lr * lr + li * li
    nr, ni = ar - 1.0, ai
    fr = (nr * lr + ni * li) / den
    fi = (ni * lr - nr * li) / den
    br, bi = b_re.astype(F32), b_im.astype(F32)
    bbar_r = fr[..., None] * br - fi[..., None] * bi
    bbar_i = fr[..., None] * bi + fi[..., None] * br
    return ar, ai, bbar_r, bbar_i


def _s5_drive(u, bbar_r, bbar_i):
    ug = u.astype(F32).reshape(u.shape[:2] + (S5_GROUPS, S5_GROUP))
    return jnp.einsum('blgc,gpc->blgp', ug, bbar_r), jnp.einsum('blgc,gpc->blgp', ug, bbar_i)


def _s5_scan(a_r, a_i, bu_r, bu_i, reverse, h0=None):
    if h0 is not None:
        first = -1 if reverse else 0
        hr, hi = _cmul(a_r, a_i, h0[0], h0[1])
        bu_r = bu_r.at[:, first].add(hr)
        bu_i = bu_i.at[:, first].add(hi)
    n = bu_r.shape[1]
    a_r = jnp.broadcast_to(a_r, (1, n) + a_r.shape)
    a_i = jnp.broadcast_to(a_i, (1, n) + a_i.shape)

    def combine(e1, e2):
        a1r, a1i, b1r, b1i = e1
        a2r, a2i, b2r, b2i = e2
        ar, ai = _cmul(a2r, a2i, a1r, a1i)
        br, bi = _cmul(a2r, a2i, b1r, b1i)
        return ar, ai, br + b2r, bi + b2i

    _, _, h_r, h_i = lax.associative_scan(combine, (a_r, a_i, bu_r, bu_i), reverse=reverse, axis=1)
    return h_r, h_i


def _s5_readout(h_r, h_i, c_re, c_im):
    y = jnp.einsum('blgp,gcp->blgc', h_r, c_re.astype(F32)) - jnp.einsum('blgp,gcp->blgc', h_i, c_im.astype(F32))
    return y.reshape(y.shape[:2] + (S5_WIDTH,))


def _s5_glu(y, w_glu):
    y = jax.nn.gelu(y)
    return y * jax.nn.sigmoid(y @ w_glu)


def _s5_mixer(u_x, u_c, lam_re, lam_im, log_step, b_re, b_im, c_re, c_im, d, w_glu, with_ctx_out):
    df = d.astype(F32)
    y_x = df * u_x.astype(F32)
    y_c = df * u_c.astype(F32) if with_ctx_out else None
    for dirn, reverse in enumerate((False, True)):
        a_r, a_i, bb_r, bb_i = _s5_discretise(lam_re[dirn], lam_im[dirn], log_step[dirn], b_re[dirn], b_im[dirn])
        cu_r, cu_i = _s5_drive(u_c, bb_r, bb_i)
        hc_r, hc_i = _s5_scan(a_r, a_i, cu_r, cu_i, reverse)
        end = 0 if reverse else -1
        xu_r, xu_i = _s5_drive(u_x, bb_r, bb_i)
        hx_r, hx_i = _s5_scan(a_r, a_i, xu_r, xu_i, reverse, (hc_r[:, end], hc_i[:, end]))
        y_x = y_x + _s5_readout(hx_r, hx_i, c_re[dirn], c_im[dirn])
        if with_ctx_out:
            y_c = y_c + _s5_readout(hc_r, hc_i, c_re[dirn], c_im[dirn])
    out_x = _s5_glu(y_x.astype(u_x.dtype), w_glu)
    out_c = _s5_glu(y_c.astype(u_c.dtype), w_glu) if with_ctx_out else None
    return out_x, out_c


def _mla_queries(q_c, g_q, w_uq):
    q = (_rmsnorm(q_c, g_q) @ w_uq).reshape(q_c.shape[:2] + (MLA_HEADS, MLA_NOPE + MLA_ROPE))
    return q[..., :MLA_NOPE], q[..., MLA_NOPE:]


def _mla_keys_values(kv_c, g_kv, w_ukv):
    kv = (_rmsnorm(kv_c, g_kv) @ w_ukv).reshape(kv_c.shape[:2] + (MLA_HEADS, MLA_NOPE + MLA_V))
    return kv[..., :MLA_NOPE], kv[..., MLA_NOPE:]


def _mla_attend(q_nope, q_rope, k_nope, k_rope, v):
    s = jnp.einsum('bqhd,bkhd->bhqk', q_nope, k_nope) + jnp.einsum('bqhr,bkr->bhqk', q_rope, k_rope)
    p = jax.nn.softmax(s.astype(F32) * MLA_SCALE, axis=-1).astype(v.dtype)
    return jnp.einsum('bhqk,bkhd->bqhd', p, v)


def _mla_block_attention(q_nope, q_rope, k_nope, k_rope, v):
    b, n = q_nope.shape[:2]
    nb = n // Q_BLOCK

    def to_blocks(t):
        return t.reshape((b, nb, Q_BLOCK) + t.shape[2:]).swapaxes(0, 1)

    out = lax.map(lambda qs: _mla_attend(qs[0], qs[1], k_nope, k_rope, v), (to_blocks(q_nope), to_blocks(q_rope)))
    return out.swapaxes(0, 1).reshape(b, n, MLA_HEADS * MLA_V)


def _dwconv3(g, w, b):
    gp = jnp.pad(g, ((0, 0), (1, 1), (0, 0)))
    return gp[:, :-2] * w[0] + gp[:, 1:-1] * w[1] + gp[:, 2:] * w[2] + b


def _conv_ffn(h, w_in, conv_w, conv_b, w_down):
    gate, up = jnp.split(h @ w_in, 2, axis=-1)
    return (jax.nn.silu(_dwconv3(gate, conv_w, conv_b)) * up) @ w_down


def setup_inputs(seed: int = 0) -> dict:
    key = jax.random.key(seed)
    ks = jax.random.split(key, 32)
    d = D_MODEL

    def nrm(k, shape, scale):
        return scale * jax.random.normal(k, shape, F32)

    def gain(k, shape):
        return 1.0 + nrm(k, shape, 0.02)

    lam_im_base = jnp.pi * jnp.arange(S5_STATE, dtype=F32)
    return {
        'x': nrm(ks[0], (BATCH, SEQ, d), 1.0),
        'c': nrm(ks[1], (BATCH, d), 1.0),
        'ctx': nrm(ks[2], (BATCH, CTX_LEN, d), 1.0),
        'c_ctx': nrm(ks[3], (d,), 1.0),
        'w_ada': nrm(ks[4], (DEPTH, d, N_MOD * d), 0.5 * d ** -0.5),
        'b_ada': nrm(ks[5], (DEPTH, N_MOD * d), 0.01),
        'g_pre_mix': gain(ks[6], (DEPTH, d)),
        'g_post_mix': gain(ks[7], (DEPTH, d)),
        'g_pre_ffn': gain(ks[8], (DEPTH, d)),
        'g_post_ffn': gain(ks[9], (DEPTH, d)),
        'w_in': nrm(ks[10], (DEPTH, d, IN_COLS), d ** -0.5),
        's5_lambda_re': -0.5 + nrm(ks[11], (DEPTH, 2, S5_GROUPS, S5_STATE), 0.01),
        's5_lambda_im': lam_im_base + nrm(ks[12], (DEPTH, 2, S5_GROUPS, S5_STATE), 0.01),
        's5_log_step': jax.random.uniform(ks[13], (DEPTH, 2, S5_GROUPS), F32, math.log(1e-3), math.log(1e-1)),
        's5_b_re': nrm(ks[14], (DEPTH, 2, S5_GROUPS, S5_STATE, S5_GROUP), (2 * S5_GROUP) ** -0.5),
        's5_b_im': nrm(ks[15], (DEPTH, 2, S5_GROUPS, S5_STATE, S5_GROUP), (2 * S5_GROUP) ** -0.5),
        's5_c_re': nrm(ks[16], (DEPTH, 2, S5_GROUPS, S5_GROUP, S5_STATE), 0.5),
        's5_c_im': nrm(ks[17], (DEPTH, 2, S5_GROUPS, S5_GROUP, S5_STATE), 0.5),
        's5_d': nrm(ks[18], (DEPTH, S5_WIDTH), 0.5),
        's5_w_glu': nrm(ks[19], (DEPTH, S5_WIDTH, S5_WIDTH), S5_WIDTH ** -0.5),
        'mla_g_q': gain(ks[20], (DEPTH, MLA_Q_RANK)),
        'mla_w_uq': nrm(ks[21], (DEPTH, MLA_Q_RANK, MLA_HEADS * (MLA_NOPE + MLA_ROPE)), MLA_Q_RANK ** -0.5),
        'mla_g_kv': gain(ks[22], (DEPTH, MLA_KV_RANK)),
        'mla_w_ukv': nrm(ks[23], (DEPTH, MLA_KV_RANK, MLA_HEADS * (MLA_NOPE + MLA_V)), MLA_KV_RANK ** -0.5),
        'w_out': nrm(ks[24], (DEPTH, D_MIX, d), D_MIX ** -0.5),
        'ffn_w_in': nrm(ks[25], (DEPTH, d, 2 * D_FF), d ** -0.5),
        'ffn_conv_w': nrm(ks[26], (DEPTH, CONV_WIDTH, D_FF), CONV_WIDTH ** -0.5),
        'ffn_conv_b': nrm(ks[27], (DEPTH, D_FF), 0.01),
        'ffn_w_down': nrm(ks[28], (DEPTH, D_FF, d), D_FF ** -0.5),
    }


def reference(x, c, ctx, c_ctx, w_ada, b_ada, g_pre_mix, g_post_mix, g_pre_ffn, g_post_ffn, w_in,
              s5_lambda_re, s5_lambda_im, s5_log_step, s5_b_re, s5_b_im, s5_c_re, s5_c_im, s5_d, s5_w_glu,
              mla_g_q, mla_w_uq, mla_g_kv, mla_w_ukv, w_out, ffn_w_in, ffn_conv_w, ffn_conv_b, ffn_w_down):
    rows = x.shape[1] // GRID_W
    cos, sin = _axial_rope_angles(rows)
    for layer in range(DEPTH):
        update_ctx = layer < DEPTH - 1
        mod_x = jax.nn.silu(c) @ w_ada[layer] + b_ada[layer]
        mod_c = jax.nn.silu(c_ctx) @ w_ada[layer] + b_ada[layer]
        sh_a, sc_a, ga_a, sh_f, sc_f, ga_f = jnp.split(mod_x[:, None, :], N_MOD, axis=-1)
        csh_a, csc_a, cga_a, csh_f, csc_f, cga_f = jnp.split(mod_c, N_MOD, axis=-1)

        px = _modulate(_rmsnorm(x, g_pre_mix[layer]), sh_a, sc_a) @ w_in[layer]
        pc = _modulate(_rmsnorm(ctx, g_pre_mix[layer]), csh_a, csc_a) @ w_in[layer]
        u_x, qc_x, kvc_x, kr_x = jnp.split(px, IN_SPLITS, axis=-1)
        u_c, qc_c, kvc_c, kr_c = jnp.split(pc, IN_SPLITS, axis=-1)

        s5_x, s5_c = _s5_mixer(u_x, u_c, s5_lambda_re[layer], s5_lambda_im[layer], s5_log_step[layer],
                               s5_b_re[layer], s5_b_im[layer], s5_c_re[layer], s5_c_im[layer],
                               s5_d[layer], s5_w_glu[layer], update_ctx)

        kn_x, v_x = _mla_keys_values(kvc_x, mla_g_kv[layer], mla_w_ukv[layer])
        kn_c, v_c = _mla_keys_values(kvc_c, mla_g_kv[layer], mla_w_ukv[layer])
        kr_x = _rope(kr_x, cos, sin)
        qn_x, qr_x = _mla_queries(qc_x, mla_g_q[layer], mla_w_uq[layer])
        qr_x = _rope(qr_x, cos[:, None, :], sin[:, None, :])
        att_x = _mla_block_attention(qn_x, qr_x,
                                     jnp.concatenate([kn_c, kn_x], axis=1),
                                     jnp.concatenate([kr_c, kr_x], axis=1),
                                     jnp.concatenate([v_c, v_x], axis=1))
        mix_x = jnp.concatenate([s5_x, att_x], axis=-1) @ w_out[layer]
        x_mid = x + ga_a * _rmsnorm(mix_x, g_post_mix[layer])

        if update_ctx:
            qn_c, qr_c = _mla_queries(qc_c, mla_g_q[layer], mla_w_uq[layer])
            att_c = _mla_attend(qn_c, qr_c, kn_c, kr_c, v_c)
            att_c = att_c.reshape(att_c.shape[:2] + (MLA_HEADS * MLA_V,))
            mix_c = jnp.concatenate([s5_c, att_c], axis=-1) @ w_out[layer]
            ctx = ctx + cga_a * _rmsnorm(mix_c, g_post_mix[layer])
            hc = _modulate(_rmsnorm(ctx, g_pre_ffn[layer]), csh_f, csc_f)
            ctx = ctx + cga_f * _rmsnorm(_conv_ffn(hc, ffn_w_in[layer], ffn_conv_w[layer], ffn_conv_b[layer], ffn_w_down[layer]), g_post_ffn[layer])

        hx = _modulate(_rmsnorm(x_mid, g_pre_ffn[layer]), sh_f, sc_f)
        f_x = _conv_ffn(hx, ffn_w_in[layer], ffn_conv_w[layer], ffn_conv_b[layer], ffn_w_down[layer])
        x = x_mid + ga_f * _rmsnorm(f_x, g_post_ffn[layer])
    return x
```

```cpp
#include <hip/hip_runtime.h>
#include <cstdio>
#include <cstdint>
#include <cmath>

#ifndef MK_ONE_LAUNCH
#define MK_ONE_LAUNCH 0
#endif

namespace pg8 {
#define PG8_LAS __attribute__((address_space(3)))
typedef unsigned short bf16_t;
typedef short bf16x8 __attribute__((ext_vector_type(8)));
typedef float f32x4 __attribute__((ext_vector_type(4)));
typedef float f32x2 __attribute__((ext_vector_type(2)));
typedef unsigned u32x4 __attribute__((ext_vector_type(4)));
constexpr int BM = 256, BK = 64, HALF = 128, HTB = HALF * BK * 2  , STAGE_BYTES = 8 * HTB, NXCD = 8, WGM = 8;

__host__ __device__ __forceinline__ int lds_byte(int r, int c) { const int st = (r >> 4) * 2 + (c >> 5), rr = r & 15, cc = c & 31, ob = rr * 64 + cc * 2; return st * 1024 + (ob ^ (((ob >> 9) & 1) << 5)); }
__host__ __device__ __forceinline__ void stage_rc(int b, int& R, int& C) { const int st = b / 1024, sb = b % 1024, swz = sb ^ (((sb >> 9) & 1) << 5); R = (st >> 1) * 16 + swz / 64; C = (st & 1) * 32 + (swz % 64) / 2; }
__host__ __device__ __forceinline__ int perm32(int rho) { const int n = rho >> 4, i = rho & 15; return 8 * (i >> 2) + 4 * n + (i & 3); }

struct Unit { int pm, pn; };
struct Gemm { const bf16_t* A; const bf16_t* Bt; int M, N, K; };

struct StaticOrder {
    int nM, nN, nwg, G, c;
    __host__ __device__ void init(int M, int N, int G_, int c_) { nM = M / BM; nN = N / BM; nwg = nM * nN; G = G_; c = c_; }
    __host__ __device__ bool next(int i, Unit& u) const {
        const long L = (long)i * G + c; if (L >= nwg) return false;
        int wgid = (int)L; { const int q = nwg / NXCD, r = nwg % NXCD, xcd = wgid % NXCD, off = wgid / NXCD; wgid = (xcd < r ? xcd * (q + 1) : r * (q + 1) + (xcd - r) * q) + off; }
        const int nig = WGM * nN, gid = wgid / nig, fm = gid * WGM, gsz = (nM - fm) < WGM ? (nM - fm) : WGM;
        u.pm = fm + ((wgid % nig) % gsz); u.pn = (wgid % nig) / gsz; return true;
    }
    __device__ __forceinline__ void a_ready(const Unit&) const {}
    __device__ __forceinline__ void done(const Unit&) const {}
};

__device__ __forceinline__ unsigned cvt_pk_bf16(float lo, float hi) { unsigned r; asm volatile("v_cvt_pk_bf16_f32 %0, %1, %2" : "=v"(r) : "v"(lo), "v"(hi)); return r; }
__device__ __forceinline__ float bf_lo(unsigned w) { return __uint_as_float(w << 16); }
__device__ __forceinline__ float bf_hi(unsigned w) { return __uint_as_float(w & 0xffff0000u); }

struct EpiBf16P {
    static constexpr bool PERM = true, AFTER_DRAIN = false;
    bf16_t* O; int ldc;
    __device__ __forceinline__ void operator()(const f32x4 (&acc)[2][2][4][2], const Unit& u, int wr, int wc, int fr, int fq) const {
        const int row0 = u.pm * BM + wr * 64 + fr, col0 = u.pn * BM + wc * 32 + 8 * fq;
#pragma unroll
        for (int ai = 0; ai < 2; ++ai)
#pragma unroll
            for (int m = 0; m < 4; ++m) { bf16_t* rowp = O + (size_t)(row0 + ai * HALF + m * 16) * ldc + col0;
#pragma unroll
                for (int bj = 0; bj < 2; ++bj) { const f32x4 v0 = acc[ai][bj][m][0], v1 = acc[ai][bj][m][1];
                    u32x4 w; w.x = cvt_pk_bf16(v0[0], v0[1]); w.y = cvt_pk_bf16(v0[2], v0[3]); w.z = cvt_pk_bf16(v1[0], v1[1]); w.w = cvt_pk_bf16(v1[2], v1[3]);
                    *(u32x4*)(rowp + bj * HALF) = w; } }
    }
};
struct EpiF32P {
    static constexpr bool PERM = false, AFTER_DRAIN = false;
    float* C; int ldc;
    __device__ __forceinline__ void operator()(const f32x4 (&acc)[2][2][4][2], const Unit& u, int wr, int wc, int fr, int fq) const {
        const int row0 = u.pm * BM + wr * 64 + fr, col0 = u.pn * BM + wc * 32 + 4 * fq;
#pragma unroll
        for (int ai = 0; ai < 2; ++ai)
#pragma unroll
            for (int m = 0; m < 4; ++m) { float* rowp = C + (size_t)(row0 + ai * HALF + m * 16) * ldc + col0;
#pragma unroll
                for (int bj = 0; bj < 2; ++bj)
#pragma unroll
                    for (int n = 0; n < 2; ++n) *(f32x4*)(rowp + bj * HALF + n * 16) = acc[ai][bj][m][n]; }
    }
};
struct EpiQ {
    static constexpr bool PERM = true, AFTER_DRAIN = false;
    bf16_t* O; const float* rope; float scale;
    __device__ __forceinline__ void operator()(const f32x4 (&acc)[2][2][4][2], const Unit& u, int wr, int wc, int fr, int fq) const {
        const int row0 = u.pm * BM + wr * 64 + fr, col0 = u.pn * BM + wc * 32 + 8 * fq;
#pragma unroll
        for (int ai = 0; ai < 2; ++ai)
#pragma unroll
            for (int m = 0; m < 4; ++m) { const int row = row0 + ai * HALF + m * 16; const int t = row & 4095; bf16_t* rowp = O + (size_t)row * 4608 + col0;
#pragma unroll
                for (int bj = 0; bj < 2; ++bj) { f32x4 v0 = acc[ai][bj][m][0] * scale, v1 = acc[ai][bj][m][1] * scale;
                    const int col = col0 + bj * HALF; const int within = col % 192;
                    if (within >= 128) { const float* cs = rope + ((size_t)t * 32 + ((within - 128) >> 1)) * 2; const f32x4 c01 = *(const f32x4*)cs, c23 = *(const f32x4*)(cs + 4);
                        const float a0 = v0[0], a1 = v0[1], a2 = v0[2], a3 = v0[3], b0 = v1[0], b1 = v1[1], b2 = v1[2], b3 = v1[3];
                        v0[0] = a0 * c01[0] - a1 * c01[1]; v0[1] = a0 * c01[1] + a1 * c01[0]; v0[2] = a2 * c01[2] - a3 * c01[3]; v0[3] = a2 * c01[3] + a3 * c01[2];
                        v1[0] = b0 * c23[0] - b1 * c23[1]; v1[1] = b0 * c23[1] + b1 * c23[0]; v1[2] = b2 * c23[2] - b3 * c23[3]; v1[3] = b2 * c23[3] + b3 * c23[2]; }
                    u32x4 w; w.x = cvt_pk_bf16(v0[0], v0[1]); w.y = cvt_pk_bf16(v0[2], v0[3]); w.z = cvt_pk_bf16(v1[0], v1[1]); w.w = cvt_pk_bf16(v1[2], v1[3]);
                    *(u32x4*)(rowp + bj * HALF) = w; } }
    }
};
struct EpiGlu {
    static constexpr bool PERM = true, AFTER_DRAIN = false;
    const bf16_t* YG; bf16_t* O; int ldo;
    __device__ __forceinline__ void operator()(const f32x4 (&acc)[2][2][4][2], const Unit& u, int wr, int wc, int fr, int fq) const {
        const int row0 = u.pm * BM + wr * 64 + fr, col0 = u.pn * BM + wc * 32 + 8 * fq;
#pragma unroll
        for (int ai = 0; ai < 2; ++ai)
#pragma unroll
            for (int m = 0; m < 4; ++m) { const int row = row0 + ai * HALF + m * 16;
#pragma unroll
                for (int bj = 0; bj < 2; ++bj) { const int col = col0 + bj * HALF; const u32x4 y = *(const u32x4*)(YG + (size_t)row * 1024 + col);
                    const f32x4 v0 = acc[ai][bj][m][0], v1 = acc[ai][bj][m][1];
                    float o[8]; const float yv[8] = {bf_lo(y.x), bf_hi(y.x), bf_lo(y.y), bf_hi(y.y), bf_lo(y.z), bf_hi(y.z), bf_lo(y.w), bf_hi(y.w)};
#pragma unroll
                    for (int j = 0; j < 4; ++j) { o[j] = yv[j] / (1.f + __expf(-v0[j])); o[4 + j] = yv[4 + j] / (1.f + __expf(-v1[j])); }
                    u32x4 w; w.x = cvt_pk_bf16(o[0], o[1]); w.y = cvt_pk_bf16(o[2], o[3]); w.z = cvt_pk_bf16(o[4], o[5]); w.w = cvt_pk_bf16(o[6], o[7]);
                    *(u32x4*)(O + (size_t)row * ldo + col) = w; } }
    }
};

template <class Epi, class Sched, bool ALIGN_EPI = false, bool SP2 = false>
__device__ __forceinline__ void gemm_phase(PG8_LAS unsigned char* lds, const Gemm g, const Sched& S, const Epi& E) {
    const int tid = threadIdx.x, wid = __builtin_amdgcn_readfirstlane(tid >> 6), lane = tid & 63, wr = wid >> 2, wc = wid & 3, fr = lane & 15, fq = lane >> 4;
    const int K = g.K, nt = K / BK;
    unsigned voffA[2], voffB[2];
#pragma unroll
    for (int i = 0; i < 2; ++i) { int R, C; stage_rc(tid * 16 + i * 8192, R, C); const int Rb = Epi::PERM ? ((R & ~31) + perm32(R & 31)) : R;
        voffA[i] = (unsigned)(R * K + C) * 2u; voffB[i] = (unsigned)(Rb * K + C) * 2u; }
    const size_t kstep = (size_t)(BK * 2);
    const size_t hstep = (size_t)HALF * K * 2;
    const size_t tstep = 2 * hstep;
    const unsigned ldsw = (unsigned)wid * 1024u;
    const int aoff = lds_byte(wr * 64 + fr, fq * 8), boff = lds_byte(wc * 32 + fr, fq * 8);
#define PG8_SA(b, h) (((b) * 2 + (h)) * HTB)
#define PG8_SB(b, h) ((4 + (b) * 2 + (h)) * HTB)
#define PG8_STAGE(bufoff, gbase, voff) do { _Pragma("unroll") for (int _i = 0; _i < 2; ++_i) \
        __builtin_amdgcn_global_load_lds((const unsigned*)((const char*)(gbase) + (voff)[_i]), (PG8_LAS unsigned*)(lds + (bufoff) + ldsw + _i * 8192), 16, 0, 0); } while (0)
#define PG8_LDA(dst, b, h) do { _Pragma("unroll") for (int m = 0; m < 4; ++m) _Pragma("unroll") for (int k = 0; k < 2; ++k) dst[m][k] = *(const PG8_LAS bf16x8*)(lds + PG8_SA(b, h) + aoff + m * 2048 + k * 1024); } while (0)
#define PG8_LDB(dst, b, h) do { _Pragma("unroll") for (int n = 0; n < 2; ++n) _Pragma("unroll") for (int k = 0; k < 2; ++k) dst[n][k] = *(const PG8_LAS bf16x8*)(lds + PG8_SB(b, h) + boff + n * 2048 + k * 1024); } while (0)
#define PG8_MMA(ai, bj, At, Bt) do { __builtin_amdgcn_s_setprio(1); _Pragma("unroll") for (int m = 0; m < 4; ++m) _Pragma("unroll") for (int n = 0; n < 2; ++n) _Pragma("unroll") for (int k = 0; k < 2; ++k) \
        acc[ai][bj][m][n] = __builtin_amdgcn_mfma_f32_16x16x32_bf16(Bt[n][k], At[m][k], acc[ai][bj][m][n], 0, 0, 0); __builtin_amdgcn_s_setprio(0); } while (0)
#define PG8_WAIT_V(n) asm volatile("s_waitcnt vmcnt(" #n ")" ::: "memory")
#define PG8_WAIT_L(n) asm volatile("s_waitcnt lgkmcnt(" #n ")" ::: "memory")
#define PG8_BAR __builtin_amdgcn_s_barrier()
#define PG8_SCHED __builtin_amdgcn_sched_barrier(0)
    Unit cur, nxt; int ui = 0;
    if (!S.next(0, cur)) return;
    f32x4 acc[2][2][4][2];
#pragma unroll
    for (int a = 0; a < 2; ++a)
#pragma unroll
        for (int b = 0; b < 2; ++b)
#pragma unroll
            for (int m = 0; m < 4; ++m)
#pragma unroll
                for (int n = 0; n < 2; ++n) acc[a][b][m][n] = (f32x4){0.f, 0.f, 0.f, 0.f};
    bf16x8 At[4][2], B0[2][2], B1[2][2];
    const char* cA = (const char*)g.A + (size_t)cur.pm * tstep; const char* cB = (const char*)g.Bt + (size_t)cur.pn * tstep;
    S.a_ready(cur);
    if constexpr (SP2) {
        PG8_STAGE(PG8_SB(0, 0), cB, voffB); PG8_STAGE(PG8_SB(0, 1), cB + hstep, voffB); PG8_STAGE(PG8_SA(0, 0), cA, voffA); PG8_STAGE(PG8_SA(0, 1), cA + hstep, voffA);
        if (wr == 1) PG8_BAR;
        PG8_WAIT_V(2); PG8_BAR;
        PG8_STAGE(PG8_SB(1, 0), cB + kstep, voffB); PG8_STAGE(PG8_SA(1, 0), cA + kstep, voffA); PG8_STAGE(PG8_SB(1, 1), cB + hstep + kstep, voffB);
        PG8_WAIT_V(6); PG8_BAR;
    } else {
        PG8_STAGE(PG8_SB(0, 0), cB, voffB); PG8_STAGE(PG8_SA(0, 0), cA, voffA); PG8_STAGE(PG8_SB(0, 1), cB + hstep, voffB); PG8_STAGE(PG8_SA(0, 1), cA + hstep, voffA);
        if (wr == 1) PG8_BAR;
        PG8_WAIT_V(4); PG8_BAR;
        PG8_STAGE(PG8_SB(1, 0), cB + kstep, voffB); PG8_STAGE(PG8_SA(1, 0), cA + kstep, voffA); PG8_STAGE(PG8_SB(1, 1), cB + hstep + kstep, voffB);
        PG8_WAIT_V(6); PG8_BAR;
    }
    for (;;) {
        const bool has_next = S.next(ui + 1, nxt);
        const char* nA = has_next ? (const char*)g.A + (size_t)nxt.pm * tstep : cA; const char* nB = has_next ? (const char*)g.Bt + (size_t)nxt.pn * tstep : cB;
        for (int t = 0; t < nt; t += 2) {
            const bool last = (t == nt - 2);
            const char* a1 = cA + (size_t)(t + 1) * kstep;
            const char* a2 = last ? nA : cA + (size_t)(t + 2) * kstep; const char* b2 = last ? nB : cB + (size_t)(t + 2) * kstep;
            const char* a3 = a2 + kstep; const char* b3 = b2 + kstep;
            if (last && has_next) S.a_ready(nxt);
            if constexpr (SP2) {
            PG8_LDB(B0, 0, 0); PG8_LDB(B1, 0, 1); PG8_SCHED; PG8_LDA(At, 0, 0); PG8_STAGE(PG8_SA(1, 1), a1 + hstep, voffA);
            PG8_WAIT_V(8); PG8_WAIT_L(0); PG8_BAR; PG8_MMA(0, 0, At, B0); PG8_MMA(0, 1, At, B1); PG8_BAR; PG8_SCHED;
            PG8_LDA(At, 0, 1); PG8_STAGE(PG8_SB(0, 0), b2, voffB); PG8_STAGE(PG8_SB(0, 1), b2 + hstep, voffB); PG8_STAGE(PG8_SA(0, 0), a2, voffA);
            PG8_WAIT_V(8); PG8_WAIT_L(0); PG8_BAR; PG8_MMA(1, 0, At, B0); PG8_MMA(1, 1, At, B1); PG8_BAR; PG8_SCHED;
            PG8_LDB(B0, 1, 0); PG8_LDB(B1, 1, 1); PG8_SCHED; PG8_LDA(At, 1, 0); PG8_STAGE(PG8_SA(0, 1), a2 + hstep, voffA);
            PG8_WAIT_V(8); PG8_WAIT_L(0); PG8_BAR; PG8_MMA(0, 0, At, B0); PG8_MMA(0, 1, At, B1); PG8_BAR; PG8_SCHED;
            PG8_LDA(At, 1, 1); PG8_STAGE(PG8_SB(1, 0), b3, voffB); PG8_STAGE(PG8_SB(1, 1), b3 + hstep, voffB); PG8_STAGE(PG8_SA(1, 0), a3, voffA);
            PG8_WAIT_V(8); PG8_WAIT_L(0); PG8_BAR; PG8_MMA(1, 0, At, B0); PG8_MMA(1, 1, At, B1); PG8_BAR; PG8_SCHED;
            } else {
            PG8_LDB(B0, 0, 0); PG8_SCHED; PG8_LDA(At, 0, 0); PG8_STAGE(PG8_SA(1, 1), a1 + hstep, voffA);
            PG8_WAIT_L(8); PG8_BAR; PG8_WAIT_L(0); PG8_MMA(0, 0, At, B0); PG8_BAR; PG8_SCHED;
            PG8_LDB(B1, 0, 1); PG8_STAGE(PG8_SB(0, 0), b2, voffB);
            PG8_BAR; PG8_WAIT_L(0); PG8_MMA(0, 1, At, B1); PG8_BAR;
            PG8_LDA(At, 0, 1); PG8_STAGE(PG8_SA(0, 0), a2, voffA);
            PG8_BAR; PG8_WAIT_L(0); PG8_MMA(1, 0, At, B0); PG8_BAR; PG8_SCHED;
            PG8_STAGE(PG8_SB(0, 1), b2 + hstep, voffB);
            PG8_WAIT_V(6); PG8_BAR; PG8_MMA(1, 1, At, B1); PG8_BAR;
            PG8_LDB(B0, 1, 0); PG8_SCHED; PG8_LDA(At, 1, 0); PG8_STAGE(PG8_SA(0, 1), a2 + hstep, voffA);
            PG8_WAIT_L(8); PG8_BAR; PG8_WAIT_L(0); PG8_MMA(0, 0, At, B0); PG8_BAR; PG8_SCHED;
            PG8_LDB(B1, 1, 1); PG8_STAGE(PG8_SB(1, 0), b3, voffB);
            PG8_BAR; PG8_WAIT_L(0); PG8_MMA(0, 1, At, B1); PG8_BAR;
            PG8_LDA(At, 1, 1); PG8_STAGE(PG8_SA(1, 0), a3, voffA);
            PG8_BAR; PG8_WAIT_L(0); PG8_MMA(1, 0, At, B0); PG8_BAR; PG8_SCHED;
            PG8_STAGE(PG8_SB(1, 1), b3 + hstep, voffB);
            PG8_WAIT_V(6); PG8_BAR; PG8_MMA(1, 1, At, B1); PG8_BAR;
            }
        }
        if constexpr (ALIGN_EPI) { if (wr == 0) PG8_BAR; }
        if constexpr (!Epi::AFTER_DRAIN) { E(acc, cur, wr, wc, fr, fq); S.done(cur); }
        if (!has_next) break;
#pragma unroll
        for (int a = 0; a < 2; ++a)
#pragma unroll
            for (int b = 0; b < 2; ++b)
#pragma unroll
                for (int m = 0; m < 4; ++m)
#pragma unroll
                    for (int n = 0; n < 2; ++n) acc[a][b][m][n] = (f32x4){0.f, 0.f, 0.f, 0.f};
        cur = nxt; cA = nA; cB = nB; ++ui;
        if constexpr (ALIGN_EPI) { if (wr == 1) PG8_BAR; }
    }
    PG8_WAIT_V(0);
    if constexpr (!ALIGN_EPI) { if (wr == 0) PG8_BAR; }
    PG8_BAR;
    if constexpr (Epi::AFTER_DRAIN) { E.fused(acc, cur, wr, wc, fr, fq, lds, wid, lane); S.done(cur); }
#undef PG8_SA
#undef PG8_SB
#undef PG8_STAGE
#undef PG8_LDA
#undef PG8_LDB
#undef PG8_MMA
#undef PG8_WAIT_V
#undef PG8_WAIT_L
#undef PG8_BAR
#undef PG8_SCHED
}
}

constexpr int DM = 4096, NB = 4, SEQ = 4096, CTXL = 256;
constexpr int MX = NB * SEQ, MC = NB * CTXL, MALL = MX + MC;
constexpr int S5W = 1024, QRANK = 1024, KVRANK = 512, ROPED = 64;
constexpr int INC = 2624, INCP = 2816;
constexpr int NH = 24, DQK = 192, DNOPE = 128, DV = 128;
constexpr int NQ = NH * DQK, NKV = NH * (DNOPE + DV);
constexpr int DFF = 11008, NMOD = 6 * DM;
constexpr float EPS = 1e-6f;
constexpr float QSCALE = 0.07216878364870322f * 1.4426950408889634f;
constexpr int NKT = (CTXL + SEQ) / 64;

constexpr size_t MiB = 1u << 20;
constexpr size_t WS_CTL = 0, CTL_ZERO_BYTES = 1 * MiB;
constexpr size_t WS_MOD = 1 * MiB;
constexpr size_t WS_S5A = 2 * MiB;
constexpr size_t WS_S5BR = 2 * MiB + 65536;
constexpr size_t WS_S5BI = WS_S5BR + 524288;
constexpr size_t WS_ROPE = 4 * MiB;
constexpr size_t WS_PART = 5 * MiB;
constexpr size_t WS_WIN = 16 * MiB, WS_WUQ = 38 * MiB, WS_WUKV = 47 * MiB, WS_WGLU = 53 * MiB, WS_WOUT = 55 * MiB, WS_WFIN = 87 * MiB, WS_WDOWN = 259 * MiB;
constexpr size_t WS_R1 = 345 * MiB, WS_R2 = 1033 * MiB, WS_END = 1377 * MiB;
constexpr size_t WS_H = WS_R1, WS_PX = WS_R1 + 136 * MiB, WS_QCN = WS_R1 + 230 * MiB, WS_KVCN = WS_R1 + 262 * MiB, WS_KROPE = WS_R1 + 279 * MiB, WS_Q = WS_R1 + 282 * MiB, WS_KV = WS_R1 + 426 * MiB;
constexpr size_t WS_MIX = WS_R1, WS_GU = WS_R1, WS_F = WS_R1;
constexpr size_t WS_MIXIN = WS_R2, WS_YG = WS_R2 + 128 * MiB, WS_YDIR = WS_R2 + 160 * MiB, WS_HX = WS_R2, WS_ACT = WS_R2;
static_assert(WS_KV + (size_t)MALL * NKV * 2 <= WS_R2 && WS_YDIR + (size_t)2 * MX * S5W * 4 <= WS_END && WS_GU + (size_t)MX * 2 * DFF * 2 <= WS_R2 && WS_ACT + (size_t)MX * DFF * 2 <= WS_END, "ws map");
static_assert(WS_WIN + (size_t)INCP * DM * 2 <= WS_WUQ && WS_WFIN + (size_t)2 * DFF * DM * 2 <= WS_WDOWN && WS_WDOWN + (size_t)DM * DFF * 2 <= WS_R1 && WS_PART + (size_t)16 * 5 * NMOD * 4 <= WS_WIN, "ws map (weights)");
constexpr int CW_BAR = 4096;

constexpr int RING_BYTES = 131072;
constexpr int LDSCTL_OFF = RING_BYTES, MISC_OFF = LDSCTL_OFF + 320;
constexpr int LDS_BYTES = 147456;
constexpr int NWAVES = 8;

#define GAS __attribute__((address_space(1)))
#define LAS __attribute__((address_space(3)))
typedef unsigned short bf16;
typedef unsigned v4u __attribute__((ext_vector_type(4)));
typedef unsigned v2u __attribute__((ext_vector_type(2)));
typedef float f32x4 __attribute__((ext_vector_type(4)));
#define LDS_WAIT() asm volatile("s_waitcnt lgkmcnt(0)" ::: "memory")
__device__ __forceinline__ unsigned f2bf(float f) { unsigned u = __builtin_bit_cast(unsigned, f); return (u + 0x7fffu + ((u >> 16) & 1u)) >> 16; }
__device__ __forceinline__ unsigned pk2(float lo, float hi) { return f2bf(lo) | (f2bf(hi) << 16); }
__device__ __forceinline__ float bflo(unsigned w) { return __uint_as_float(w << 16); }
__device__ __forceinline__ float bfhi(unsigned w) { return __uint_as_float(w & 0xffff0000u); }
__device__ __forceinline__ float wave_sum(float v) {
#pragma unroll
    for (int o = 1; o < 64; o <<= 1) v += __shfl_xor(v, o);
    return v;
}

#define XB_TMO      128
#define XB_XCNT(j)  (256  + 64 * (j))
#define XB_XSUB(j)  (1280 + 64 * (j))
#define XB_XGEN(j)  (2304 + 64 * (j))
#define XB_TOP      3328
#define XB_TOPGEN   3392
#define XCD_BAR_WORDS 3456
#define XB_SPIN_CAP (1u << 18)

__device__ __forceinline__ unsigned xb_ld(unsigned* p)              { return __hip_atomic_load(p, __ATOMIC_RELAXED, __HIP_MEMORY_SCOPE_AGENT); }
__device__ __forceinline__ unsigned xb_add(unsigned* p, unsigned v) { return __hip_atomic_fetch_add(p, v, __ATOMIC_RELAXED, __HIP_MEMORY_SCOPE_AGENT); }
__device__ __forceinline__ unsigned xb_xcc_id() { return (unsigned)__builtin_amdgcn_s_getreg((3 << 11) | 20) & 0xFu; }
#define XB_SPIN(cond, bar) do { unsigned _sp = 0; while (cond) { __builtin_amdgcn_s_sleep(1); \
    if ((++_sp & 255u) == 0u) { if (xb_ld(&(bar)[XB_TMO])) break; if (_sp > XB_SPIN_CAP) { atomicAdd(&(bar)[XB_TMO], 1u); break; } } } } while (0)

struct XcdBarrier {
    unsigned* bar; unsigned x;
    volatile LAS unsigned* st;
};

__device__ __forceinline__ XcdBarrier xcd_barrier_post(unsigned* bar, volatile LAS unsigned* st) {
    XcdBarrier b; b.bar = bar; b.x = xb_xcc_id(); b.st = st;
    if (threadIdx.x == 0) (void)xb_add(&bar[XB_XCNT(b.x)], 1u);
    return b;
}
__device__ __forceinline__ void xcd_barrier_complete(unsigned* bar, unsigned x, unsigned& nloc, unsigned& nx) {
    const unsigned G = gridDim.x * gridDim.y * gridDim.z;
    unsigned sum, cnt, mine, sp = 0u;
    for (;;) {
        sum = 0u; cnt = 0u; mine = 0u;
#pragma unroll
        for (unsigned j = 0; j < 16; ++j) { const unsigned c = xb_ld(&bar[XB_XCNT(j)]); sum += c; cnt += (c > 0u) ? 1u : 0u; mine = (j == x) ? c : mine; }
        if (sum == G) break;
        __builtin_amdgcn_s_sleep(1);
        if ((++sp & 255u) == 0u) { if (xb_ld(&bar[XB_TMO])) break; if (sp > XB_SPIN_CAP) { atomicAdd(&bar[XB_TMO], 1u); break; } }
    }
    nloc = mine > 0u ? mine : 1u; nx = cnt > 0u ? cnt : 1u;
}

__device__ __forceinline__ void xcd_barrier(const XcdBarrier& b) {
    asm volatile("s_waitcnt vmcnt(0)" ::: "memory");
    __syncthreads();
    if (threadIdx.x == 0) {
        unsigned* bar = b.bar;
        __builtin_amdgcn_s_waitcnt(0);
        unsigned nloc = b.st[0], nx = b.st[1];
        if (nloc == 0u) { xcd_barrier_complete(bar, b.x, nloc, nx); b.st[0] = nloc; b.st[1] = nx; }
        const unsigned old = xb_add(&bar[XB_XSUB(b.x)], 1u);
        const unsigned gen = old / nloc;
        if (old + 1u == (gen + 1u) * nloc) {
            __builtin_amdgcn_fence(__ATOMIC_RELEASE, "agent");
            asm volatile("s_waitcnt vmcnt(0)" ::: "memory");
            const unsigned og = xb_add(&bar[XB_TOP], 1u);
            const unsigned tg = og / nx;
            if (og + 1u == (tg + 1u) * nx) xb_add(&bar[XB_TOPGEN], 1u);
            else XB_SPIN(xb_ld(&bar[XB_TOPGEN]) == tg, bar);
            __builtin_amdgcn_fence(__ATOMIC_ACQUIRE, "agent");
            xb_add(&bar[XB_XGEN(b.x)], 1u);
            asm volatile("s_waitcnt vmcnt(0)" ::: "memory");
        } else {
            XB_SPIN(xb_ld(&bar[XB_XGEN(b.x)]) == gen, bar);
            __builtin_amdgcn_fence(__ATOMIC_ACQUIRE, "agent");
            asm volatile("s_waitcnt vmcnt(0)" ::: "memory");
        }
    }
    __syncthreads();
}

__device__ __forceinline__ void p0_transpose_item(const float* W, int K, int N, bf16* WT, LAS float* scr, int item, int lane) {
    const int nblk = N / 32, kb = item / nblk, nb = item % nblk, k0 = 64 * kb, n0 = 32 * nb;
#pragma unroll 8
    for (int i = 0; i < 32; ++i) { const int kk = 2 * i + (lane >> 5); scr[kk * 33 + (lane & 31)] = W[(size_t)(k0 + kk) * N + n0 + (lane & 31)]; }
    LDS_WAIT(); asm volatile("" ::: "memory");
    const int c = lane & 7;
#pragma unroll
    for (int j = 0; j < 4; ++j) { const int n = (lane >> 3) + 8 * j; const LAS float* s = scr + (8 * c) * 33 + n;
        v4u o; o.x = pk2(s[0 * 33], s[1 * 33]); o.y = pk2(s[2 * 33], s[3 * 33]); o.z = pk2(s[4 * 33], s[5 * 33]); o.w = pk2(s[6 * 33], s[7 * 33]);
        *(GAS v4u*)(WT + (size_t)(n0 + n) * K + k0 + 8 * c) = o; }
    LDS_WAIT(); asm volatile("" ::: "memory");
}
__device__ __forceinline__ void p0_ada_item(const float* c, const float* cctx, const float* w_ada, float* part, int item, int lane) {
    const int nb = item % 96, ks = item / 96, n0 = nb * 256 + lane * 4, k0 = ks * 256;
    f32x4 acc[5];
#pragma unroll
    for (int r = 0; r < 5; ++r) acc[r] = (f32x4){0.f, 0.f, 0.f, 0.f};
    for (int kk = 0; kk < 256; kk += 4) {
        f32x4 w[4];
#pragma unroll
        for (int j = 0; j < 4; ++j) w[j] = *(const GAS f32x4*)(w_ada + (size_t)(k0 + kk + j) * NMOD + n0);
#pragma unroll
        for (int j = 0; j < 4; ++j) {
#pragma unroll
            for (int r = 0; r < 5; ++r) { const float cv = (r < 4) ? c[r * DM + k0 + kk + j] : cctx[k0 + kk + j]; const float s = cv / (1.f + expf(-cv)); acc[r] += w[j] * s; }
        }
    }
#pragma unroll
    for (int r = 0; r < 5; ++r) *(GAS f32x4*)(part + (size_t)(ks * 5 + r) * NMOD + n0) = acc[r];
}

struct P {
    const float *x, *c, *ctx, *cctx, *w_ada, *b_ada, *g_pre_mix, *g_post_mix, *g_pre_ffn, *g_post_ffn, *w_in;
    const float *lam_re, *lam_im, *log_step, *b_re, *b_im, *c_re, *c_im, *s5d, *w_glu, *g_q, *w_uq, *g_kv, *w_ukv, *w_out, *ffn_w_in, *conv_w, *conv_b, *ffn_w_down;
    float* out;
    float *mod, *abar, *bbr, *bbi, *rope, *part, *mix, *f, *ydir;
    bf16 *WinT, *WuqT, *WukvT, *WgluT, *WoutT, *WfinT, *WdownT;
    bf16 *h, *px, *qcn, *kvcn, *krope, *q, *kv, *mixin, *yg, *hx, *gu, *act;
};

__device__ __forceinline__ void phase_prologue(const P& p, LAS unsigned char* lds, int gw, int NGW, int wave, int lane, int gtid, int NGT) {
    LAS float* scr = (LAS float*)(lds + wave * 16384);
    constexpr int I_IN = (DM / 64) * (INC / 32), I_UQ = (QRANK / 64) * (NQ / 32), I_UKV = (KVRANK / 64) * (NKV / 32), I_GLU = (S5W / 64) * (S5W / 32),
                  I_OUT = (DM / 64) * (DM / 32), I_FIN = (DM / 64) * (2 * DFF / 32), I_DOWN = (DFF / 64) * (DM / 32), I_ADA = 96 * 16;
    constexpr int NITEMS = I_ADA + I_IN + I_UQ + I_UKV + I_GLU + I_OUT + I_FIN + I_DOWN;
    for (int it = gw; it < NITEMS; it += NGW) {
        int r = it;
        if (r < I_ADA) { p0_ada_item(p.c, p.cctx, p.w_ada, p.part, r, lane); continue; } r -= I_ADA;
        if (r < I_IN) { p0_transpose_item(p.w_in, DM, INC, p.WinT, scr, r, lane); continue; } r -= I_IN;
        if (r < I_UQ) { p0_transpose_item(p.w_uq, QRANK, NQ, p.WuqT, scr, r, lane); continue; } r -= I_UQ;
        if (r < I_UKV) { p0_transpose_item(p.w_ukv, KVRANK, NKV, p.WukvT, scr, r, lane); continue; } r -= I_UKV;
        if (r < I_GLU) { p0_transpose_item(p.w_glu, S5W, S5W, p.WgluT, scr, r, lane); continue; } r -= I_GLU;
        if (r < I_OUT) { p0_transpose_item(p.w_out, DM, DM, p.WoutT, scr, r, lane); continue; } r -= I_OUT;
        if (r < I_FIN) { p0_transpose_item(p.ffn_w_in, DM, 2 * DFF, p.WfinT, scr, r, lane); continue; } r -= I_FIN;
        p0_transpose_item(p.ffn_w_down, DFF, DM, p.WdownT, scr, r, lane);
    }
    { GAS v4u* z = (GAS v4u*)(p.WinT + (size_t)INC * DM); const int n16 = (INCP - INC) * DM * 2 / 16; for (int i = gtid; i < n16; i += NGT) z[i] = (v4u){0u, 0u, 0u, 0u}; }
    for (int i = gtid; i < 2 * 64 * 64; i += NGT) {
        const int dg = i >> 6;
        const float lr = p.lam_re[i], li = p.lam_im[i], dt = expf(p.log_step[dg]);
        const float mag = expf(lr * dt); float sn, cs; sincosf(li * dt, &sn, &cs);
        const float ar = mag * cs, ai = mag * sn, den = lr * lr + li * li, nr = ar - 1.f, ni = ai;
        const float fr = (nr * lr + ni * li) / den, fi = (ni * lr - nr * li) / den;
        p.abar[2 * i] = ar; p.abar[2 * i + 1] = ai;
#pragma unroll
        for (int cc = 0; cc < 16; ++cc) { const float br = p.b_re[(size_t)i * 16 + cc], bi = p.b_im[(size_t)i * 16 + cc]; p.bbr[(size_t)i * 16 + cc] = fr * br - fi * bi; p.bbi[(size_t)i * 16 + cc] = fr * bi + fi * br; }
    }
    for (int i = gtid; i < SEQ * 32; i += NGT) {
        const int t = i >> 5, j = i & 31; const float pos = (float)((j < 16) ? (t >> 6) : (t & 63));
        const float inv = powf(10000.f, -(float)(j & 15) * (1.f / 16.f)); float sn, cs; sincosf(pos * inv, &sn, &cs);
        p.rope[2 * i] = cs; p.rope[2 * i + 1] = sn;
    }
}
__device__ __forceinline__ void phase_modreduce(const P& p, int gtid, int NGT) {
    for (int i = gtid; i < 5 * NMOD; i += NGT) { const int n = i % NMOD; float s = p.b_ada[n];
#pragma unroll
        for (int ks = 0; ks < 16; ++ks) s += p.part[(size_t)ks * 5 * NMOD + i];
        p.mod[i] = s; }
}
__device__ __forceinline__ void phase_norm1(const P& p, int gw, int NGW, int lane) {
    for (int row = gw; row < MALL; row += NGW) {
        const float* src = row < MX ? p.x + (size_t)row * DM : p.ctx + (size_t)(row - MX) * DM;
        const float* md = p.mod + (size_t)(row < MX ? row / SEQ : 4) * NMOD;
        const GAS f32x4* xr = (const GAS f32x4*)src + lane;
        f32x4 v[16]; float ss = 0.f;
#pragma unroll
        for (int j = 0; j < 16; ++j) { v[j] = xr[64 * j]; ss += (v[j].x * v[j].x + v[j].y * v[j].y) + (v[j].z * v[j].z + v[j].w * v[j].w); }
        const float rstd = rsqrtf(wave_sum(ss) * (1.f / DM) + EPS);
        GAS unsigned long long* o8 = (GAS unsigned long long*)(p.h + (size_t)row * DM) + lane;
#pragma unroll
        for (int j = 0; j < 16; ++j) { const f32x4 g = ((const GAS f32x4*)p.g_pre_mix)[lane + 64 * j], sh = ((const GAS f32x4*)md)[lane + 64 * j], sc = ((const GAS f32x4*)(md + DM))[lane + 64 * j];
            const f32x4 o = (v[j] * rstd) * g * (sc + 1.f) + sh;
            o8[64 * j] = (unsigned long long)pk2(o.x, o.y) | ((unsigned long long)pk2(o.z, o.w) << 32); }
    }
}
__device__ __forceinline__ void phase_postin(const P& p, int gw, int NGW, int lane) {
    for (int row = gw; row < MALL; row += NGW) {
        const bf16* pr = p.px + (size_t)row * INCP;
        { const v4u w = *(const GAS v4u*)(pr + 2048 + lane * 8);
          float v[8] = {bflo(w.x), bfhi(w.x), bflo(w.y), bfhi(w.y), bflo(w.z), bfhi(w.z), bflo(w.w), bfhi(w.w)}; float ss = 0.f;
#pragma unroll
          for (int j = 0; j < 8; ++j) ss += v[j] * v[j];
          const float rstd = rsqrtf(wave_sum(ss) * (1.f / KVRANK) + EPS);
          const f32x4 g0 = *(const GAS f32x4*)(p.g_kv + lane * 8), g1 = *(const GAS f32x4*)(p.g_kv + lane * 8 + 4);
          v4u o; o.x = pk2(v[0] * rstd * g0.x, v[1] * rstd * g0.y); o.y = pk2(v[2] * rstd * g0.z, v[3] * rstd * g0.w); o.z = pk2(v[4] * rstd * g1.x, v[5] * rstd * g1.y); o.w = pk2(v[6] * rstd * g1.z, v[7] * rstd * g1.w);
          *(GAS v4u*)(p.kvcn + (size_t)row * KVRANK + lane * 8) = o; }
        if (lane < 32) { const unsigned w = *(const GAS unsigned*)(pr + 2560 + lane * 2); float x1 = bflo(w), x2 = bfhi(w);
          if (row < MX) { const int t = row & (SEQ - 1); const float cs = p.rope[((size_t)t * 32 + lane) * 2], sn = p.rope[((size_t)t * 32 + lane) * 2 + 1]; const float a = x1 * cs - x2 * sn, b = x1 * sn + x2 * cs; x1 = a; x2 = b; }
          *(GAS unsigned*)(p.krope + (size_t)row * ROPED + lane * 2) = pk2(x1, x2); }
        if (row < MX) {
          const v4u w0 = *(const GAS v4u*)(pr + 1024 + lane * 8), w1 = *(const GAS v4u*)(pr + 1024 + 512 + lane * 8);
          float v[16] = {bflo(w0.x), bfhi(w0.x), bflo(w0.y), bfhi(w0.y), bflo(w0.z), bfhi(w0.z), bflo(w0.w), bfhi(w0.w), bflo(w1.x), bfhi(w1.x), bflo(w1.y), bfhi(w1.y), bflo(w1.z), bfhi(w1.z), bflo(w1.w), bfhi(w1.w)}; float ss = 0.f;
#pragma unroll
          for (int j = 0; j < 16; ++j) ss += v[j] * v[j];
          const float rstd = rsqrtf(wave_sum(ss) * (1.f / QRANK) + EPS);
#pragma unroll
          for (int hh = 0; hh < 2; ++hh) { const f32x4 g0 = *(const GAS f32x4*)(p.g_q + hh * 512 + lane * 8), g1 = *(const GAS f32x4*)(p.g_q + hh * 512 + lane * 8 + 4);
            v4u o; o.x = pk2(v[8 * hh + 0] * rstd * g0.x, v[8 * hh + 1] * rstd * g0.y); o.y = pk2(v[8 * hh + 2] * rstd * g0.z, v[8 * hh + 3] * rstd * g0.w);
            o.z = pk2(v[8 * hh + 4] * rstd * g1.x, v[8 * hh + 5] * rstd * g1.y); o.w = pk2(v[8 * hh + 6] * rstd * g1.z, v[8 * hh + 7] * rstd * g1.w);
            *(GAS v4u*)(p.qcn + (size_t)row * QRANK + hh * 512 + lane * 8) = o; }
        }
    }
}

__device__ __forceinline__ void phase_attn_v0(const P& p, LAS unsigned char* lds, int blk, int G) {
    constexpr int QS = 400, KS = 400, VS = 272, PS = 272;
    LAS unsigned char* Qs = lds; LAS unsigned char* Ks = lds + 128 * QS; LAS unsigned char* Vs = Ks + 64 * KS; LAS unsigned char* Ps = Vs + 64 * VS;
    const int tid = threadIdx.x, tq = tid >> 4, tk = tid & 15;
    for (int unit = blk; unit < NB * NH * (SEQ / 128); unit += G) {
        const int qt = unit % (SEQ / 128), bh = unit / (SEQ / 128), b = bh / NH, hd = bh % NH;
        const size_t qrow0 = (size_t)b * SEQ + qt * 128;
        __syncthreads();
        for (int c = tid; c < 128 * 24; c += 512) { const int r = c / 24, part = c % 24; *(LAS v4u*)(Qs + r * QS + part * 16) = *(const GAS v4u*)(p.q + (qrow0 + r) * NQ + hd * DQK + part * 8); }
        float m[4], l[4], o[4][8];
#pragma unroll
        for (int i = 0; i < 4; ++i) { m[i] = -INFINITY; l[i] = 0.f;
#pragma unroll
            for (int e = 0; e < 8; ++e) o[i][e] = 0.f; }
        for (int kt = 0; kt < NKT; ++kt) {
            __syncthreads();
            for (int c = tid; c < 64 * 24; c += 512) { const int kk = c / 24, part = c % 24; const int n = kt * 64 + kk; const size_t row = n < CTXL ? (size_t)MX + b * CTXL + n : (size_t)b * SEQ + (n - CTXL);
                const v4u w = part < 16 ? *(const GAS v4u*)(p.kv + row * NKV + hd * 256 + part * 8) : *(const GAS v4u*)(p.krope + row * ROPED + (part - 16) * 8);
                *(LAS v4u*)(Ks + kk * KS + part * 16) = w; }
            for (int c = tid; c < 64 * 16; c += 512) { const int kk = c / 16, part = c % 16; const int n = kt * 64 + kk; const size_t row = n < CTXL ? (size_t)MX + b * CTXL + n : (size_t)b * SEQ + (n - CTXL);
                *(LAS v4u*)(Vs + kk * VS + part * 16) = *(const GAS v4u*)(p.kv + row * NKV + hd * 256 + 128 + part * 8); }
            __syncthreads();
            float s[4][4];
#pragma unroll
            for (int i = 0; i < 4; ++i)
#pragma unroll
                for (int j = 0; j < 4; ++j) s[i][j] = 0.f;
            for (int d = 0; d < 24; ++d) {
                v4u qv[4], kv4[4];
#pragma unroll
                for (int i = 0; i < 4; ++i) { qv[i] = *(const LAS v4u*)(Qs + (4 * tq + i) * QS + d * 16); kv4[i] = *(const LAS v4u*)(Ks + (4 * tk + i) * KS + d * 16); }
#pragma unroll
                for (int i = 0; i < 4; ++i)
#pragma unroll
                    for (int j = 0; j < 4; ++j) {
                        s[i][j] += bflo(qv[i].x) * bflo(kv4[j].x) + bfhi(qv[i].x) * bfhi(kv4[j].x) + bflo(qv[i].y) * bflo(kv4[j].y) + bfhi(qv[i].y) * bfhi(kv4[j].y)
                                 + bflo(qv[i].z) * bflo(kv4[j].z) + bfhi(qv[i].z) * bfhi(kv4[j].z) + bflo(qv[i].w) * bflo(kv4[j].w) + bfhi(qv[i].w) * bfhi(kv4[j].w); }
            }
#pragma unroll
            for (int i = 0; i < 4; ++i) {
                float rm = fmaxf(fmaxf(s[i][0], s[i][1]), fmaxf(s[i][2], s[i][3]));
                rm = fmaxf(rm, __shfl_xor(rm, 1)); rm = fmaxf(rm, __shfl_xor(rm, 2)); rm = fmaxf(rm, __shfl_xor(rm, 4)); rm = fmaxf(rm, __shfl_xor(rm, 8));
                const float mn = fmaxf(m[i], rm), alpha = exp2f(m[i] - mn); m[i] = mn;
                float rs = 0.f;
#pragma unroll
                for (int j = 0; j < 4; ++j) { s[i][j] = exp2f(s[i][j] - mn); rs += s[i][j]; }
                rs += __shfl_xor(rs, 1); rs += __shfl_xor(rs, 2); rs += __shfl_xor(rs, 4); rs += __shfl_xor(rs, 8);
                l[i] = l[i] * alpha + rs;
#pragma unroll
                for (int e = 0; e < 8; ++e) o[i][e] *= alpha;
                *(LAS f32x4*)(Ps + (4 * tq + i) * PS + tk * 16) = (f32x4){s[i][0], s[i][1], s[i][2], s[i][3]};
            }
            __syncthreads();
            for (int j = 0; j < 64; ++j) {
                const v4u vv = *(const LAS v4u*)(Vs + j * VS + tk * 16);
                const float v8[8] = {bflo(vv.x), bfhi(vv.x), bflo(vv.y), bfhi(vv.y), bflo(vv.z), bfhi(vv.z), bflo(vv.w), bfhi(vv.w)};
#pragma unroll
                for (int i = 0; i < 4; ++i) { const float pj = *(const LAS float*)(Ps + (4 * tq + i) * PS + j * 4);
#pragma unroll
                    for (int e = 0; e < 8; ++e) o[i][e] += pj * v8[e]; }
            }
        }
#pragma unroll
        for (int i = 0; i < 4; ++i) { const float rl = 1.f / l[i];
            v4u w; w.x = pk2(o[i][0] * rl, o[i][1] * rl); w.y = pk2(o[i][2] * rl, o[i][3] * rl); w.z = pk2(o[i][4] * rl, o[i][5] * rl); w.w = pk2(o[i][6] * rl, o[i][7] * rl);
            *(GAS v4u*)(p.mixin + (qrow0 + 4 * tq + i) * DM + S5W + hd * DV + tk * 8) = w; }
    }
}

__device__ __forceinline__ void phase_s5_v0(const P& p, LAS unsigned char* lds, int blk, int G, int wave, int lane) {
    if (wave >= 2) return;
    LAS float* ul = (LAS float*)(lds + wave * 49152);
    LAS float* hbr = ul + 1024;
    LAS float* hbi = hbr + 64 * 65;
    LAS float* Cl = hbi + 64 * 65;
    for (int unit = blk + G * wave; unit < NB * 2 * 64; unit += 2 * G) {
        const int g = unit & 63, dir = (unit >> 6) & 1, b = unit >> 7;
        const int sidx = (dir * 64 + g) * 64 + lane;
        const float ar = p.abar[2 * sidx], ai = p.abar[2 * sidx + 1];
        float bbr[16], bbi[16];
#pragma unroll
        for (int cc = 0; cc < 16; ++cc) { bbr[cc] = p.bbr[(size_t)sidx * 16 + cc]; bbi[cc] = p.bbi[(size_t)sidx * 16 + cc]; }
        LDS_WAIT();
#pragma unroll
        for (int cc = 0; cc < 16; ++cc) { Cl[lane * 32 + cc] = p.c_re[((size_t)(dir * 64 + g) * 16 + cc) * 64 + lane]; Cl[lane * 32 + 16 + cc] = p.c_im[((size_t)(dir * 64 + g) * 16 + cc) * 64 + lane]; }
        float hr = 0.f, hi = 0.f;
        for (int k = 0; k < NKT; ++k) {
            { const int s = k * 64 + lane; size_t row;
              if (dir == 0) row = s < CTXL ? (size_t)MX + b * CTXL + s : (size_t)b * SEQ + (s - CTXL);
              else row = s < CTXL ? (size_t)MX + b * CTXL + (CTXL - 1 - s) : (size_t)b * SEQ + (SEQ - 1 - (s - CTXL));
              const v4u w0 = *(const GAS v4u*)(p.px + row * INCP + g * 16), w1 = *(const GAS v4u*)(p.px + row * INCP + g * 16 + 8);
              LDS_WAIT();
              *(LAS f32x4*)(ul + lane * 16) = (f32x4){bflo(w0.x), bfhi(w0.x), bflo(w0.y), bfhi(w0.y)}; *(LAS f32x4*)(ul + lane * 16 + 4) = (f32x4){bflo(w0.z), bfhi(w0.z), bflo(w0.w), bfhi(w0.w)};
              *(LAS f32x4*)(ul + lane * 16 + 8) = (f32x4){bflo(w1.x), bfhi(w1.x), bflo(w1.y), bfhi(w1.y)}; *(LAS f32x4*)(ul + lane * 16 + 12) = (f32x4){bflo(w1.z), bfhi(w1.z), bflo(w1.w), bfhi(w1.w)}; }
            LDS_WAIT();
#pragma unroll 4
            for (int j = 0; j < 64; ++j) {
                const f32x4 u0 = *(const LAS f32x4*)(ul + j * 16), u1 = *(const LAS f32x4*)(ul + j * 16 + 4), u2 = *(const LAS f32x4*)(ul + j * 16 + 8), u3 = *(const LAS f32x4*)(ul + j * 16 + 12);
                const float uu[16] = {u0.x, u0.y, u0.z, u0.w, u1.x, u1.y, u1.z, u1.w, u2.x, u2.y, u2.z, u2.w, u3.x, u3.y, u3.z, u3.w};
                float bur = 0.f, bui = 0.f;
#pragma unroll
                for (int cc = 0; cc < 16; ++cc) { bur += bbr[cc] * uu[cc]; bui += bbi[cc] * uu[cc]; }
                const float nhr = ar * hr - ai * hi + bur, nhi = ar * hi + ai * hr + bui; hr = nhr; hi = nhi;
                if (k >= CTXL / 64) { hbr[j * 65 + lane] = hr; hbi[j * 65 + lane] = hi; }
            }
            if (k >= CTXL / 64) {
                LDS_WAIT();
                float acc[16];
#pragma unroll
                for (int cc = 0; cc < 16; ++cc) acc[cc] = 0.f;
#pragma unroll 2
                for (int pp = 0; pp < 64; ++pp) {
                    const float xr = hbr[lane * 65 + pp], xi = hbi[lane * 65 + pp];
                    const f32x4 r0 = *(const LAS f32x4*)(Cl + pp * 32), r1 = *(const LAS f32x4*)(Cl + pp * 32 + 4), r2 = *(const LAS f32x4*)(Cl + pp * 32 + 8), r3 = *(const LAS f32x4*)(Cl + pp * 32 + 12);
                    const f32x4 i0 = *(const LAS f32x4*)(Cl + pp * 32 + 16), i1 = *(const LAS f32x4*)(Cl + pp * 32 + 20), i2 = *(const LAS f32x4*)(Cl + pp * 32 + 24), i3 = *(const LAS f32x4*)(Cl + pp * 32 + 28);
                    const float cr[16] = {r0.x, r0.y, r0.z, r0.w, r1.x, r1.y, r1.z, r1.w, r2.x, r2.y, r2.z, r2.w, r3.x, r3.y, r3.z, r3.w};
                    const float ci[16] = {i0.x, i0.y, i0.z, i0.w, i1.x, i1.y, i1.z, i1.w, i2.x, i2.y, i2.z, i2.w, i3.x, i3.y, i3.z, i3.w};
#pragma unroll
                    for (int cc = 0; cc < 16; ++cc) acc[cc] += cr[cc] * xr - ci[cc] * xi;
                }
                const int s = k * 64 + lane - CTXL; const int t = dir == 0 ? s : SEQ - 1 - s;
                GAS f32x4* yo = (GAS f32x4*)(p.ydir + ((size_t)dir * MX + (size_t)b * SEQ + t) * S5W + g * 16);
                yo[0] = (f32x4){acc[0], acc[1], acc[2], acc[3]}; yo[1] = (f32x4){acc[4], acc[5], acc[6], acc[7]}; yo[2] = (f32x4){acc[8], acc[9], acc[10], acc[11]}; yo[3] = (f32x4){acc[12], acc[13], acc[14], acc[15]};
            }
        }
    }
}
__device__ __forceinline__ void phase_s5gelu(const P& p, int gtid, int NGT) {
    for (int i = gtid; i < MX * (S5W / 8); i += NGT) {
        const int row = i >> 7, c0 = (i & 127) * 8;
        const v4u uw = *(const GAS v4u*)(p.px + (size_t)row * INCP + c0);
        const float u[8] = {bflo(uw.x), bfhi(uw.x), bflo(uw.y), bfhi(uw.y), bflo(uw.z), bfhi(uw.z), bflo(uw.w), bfhi(uw.w)};
        const f32x4 a0 = *(const GAS f32x4*)(p.ydir + (size_t)row * S5W + c0), a1 = *(const GAS f32x4*)(p.ydir + (size_t)row * S5W + c0 + 4);
        const f32x4 b0 = *(const GAS f32x4*)(p.ydir + ((size_t)MX + row) * S5W + c0), b1 = *(const GAS f32x4*)(p.ydir + ((size_t)MX + row) * S5W + c0 + 4);
        const f32x4 d0 = *(const GAS f32x4*)(p.s5d + c0), d1 = *(const GAS f32x4*)(p.s5d + c0 + 4);
        const float y[8] = {d0.x * u[0] + a0.x + b0.x, d0.y * u[1] + a0.y + b0.y, d0.z * u[2] + a0.z + b0.z, d0.w * u[3] + a0.w + b0.w, d1.x * u[4] + a1.x + b1.x, d1.y * u[5] + a1.y + b1.y, d1.z * u[6] + a1.z + b1.z, d1.w * u[7] + a1.w + b1.w};
        float gl[8];
#pragma unroll
        for (int j = 0; j < 8; ++j) { const float v = y[j]; gl[j] = 0.5f * v * (1.f + tanhf(0.7978845608028654f * (v + 0.044715f * v * v * v))); }
        v4u o; o.x = pk2(gl[0], gl[1]); o.y = pk2(gl[2], gl[3]); o.z = pk2(gl[4], gl[5]); o.w = pk2(gl[6], gl[7]);
        *(GAS v4u*)(p.yg + (size_t)row * S5W + c0) = o;
    }
}
__device__ __forceinline__ void phase_mid(const P& p, int gw, int NGW, int lane) {
    for (int row = gw; row < MX; row += NGW) {
        const float* md = p.mod + (size_t)(row / SEQ) * NMOD;
        const GAS f32x4* mr = (const GAS f32x4*)(p.mix + (size_t)row * DM) + lane; const GAS f32x4* xr = (const GAS f32x4*)(p.x + (size_t)row * DM) + lane;
        f32x4 v[16]; float ss = 0.f;
#pragma unroll
        for (int j = 0; j < 16; ++j) { v[j] = mr[64 * j]; ss += (v[j].x * v[j].x + v[j].y * v[j].y) + (v[j].z * v[j].z + v[j].w * v[j].w); }
        const float rstd = rsqrtf(wave_sum(ss) * (1.f / DM) + EPS); float s2 = 0.f;
        GAS f32x4* xo = (GAS f32x4*)(p.out + (size_t)row * DM) + lane;
#pragma unroll
        for (int j = 0; j < 16; ++j) { const f32x4 g = ((const GAS f32x4*)p.g_post_mix)[lane + 64 * j], ga = ((const GAS f32x4*)(md + 2 * DM))[lane + 64 * j];
            v[j] = xr[64 * j] + ga * ((v[j] * rstd) * g); xo[64 * j] = v[j]; s2 += (v[j].x * v[j].x + v[j].y * v[j].y) + (v[j].z * v[j].z + v[j].w * v[j].w); }
        const float rstd2 = rsqrtf(wave_sum(s2) * (1.f / DM) + EPS);
        GAS unsigned long long* o8 = (GAS unsigned long long*)(p.hx + (size_t)row * DM) + lane;
#pragma unroll
        for (int j = 0; j < 16; ++j) { const f32x4 g = ((const GAS f32x4*)p.g_pre_ffn)[lane + 64 * j], sh = ((const GAS f32x4*)(md + 3 * DM))[lane + 64 * j], sc = ((const GAS f32x4*)(md + 4 * DM))[lane + 64 * j];
            const f32x4 o = (v[j] * rstd2) * g * (sc + 1.f) + sh;
            o8[64 * j] = (unsigned long long)pk2(o.x, o.y) | ((unsigned long long)pk2(o.z, o.w) << 32); }
    }
}
__device__ __forceinline__ void phase_convact(const P& p, int gtid, int NGT) {
    constexpr int CB = DFF / 8;
    for (int it = gtid; it < (MX / 16) * CB; it += NGT) {
        const int cb = it % CB, rb = it / CB, c0 = cb * 8, r0 = rb * 16;
        float w0[8], w1[8], w2[8], bb[8];
#pragma unroll
        for (int j = 0; j < 8; ++j) { w0[j] = p.conv_w[c0 + j]; w1[j] = p.conv_w[DFF + c0 + j]; w2[j] = p.conv_w[2 * DFF + c0 + j]; bb[j] = p.conv_b[c0 + j]; }
        float gp[8], gc[8], gn[8];
        { const bool has = (r0 & (SEQ - 1)) != 0; v4u w = (v4u){0u, 0u, 0u, 0u}; if (has) w = *(const GAS v4u*)(p.gu + (size_t)(r0 - 1) * (2 * DFF) + c0);
          gp[0] = bflo(w.x); gp[1] = bfhi(w.x); gp[2] = bflo(w.y); gp[3] = bfhi(w.y); gp[4] = bflo(w.z); gp[5] = bfhi(w.z); gp[6] = bflo(w.w); gp[7] = bfhi(w.w); }
        { const v4u w = *(const GAS v4u*)(p.gu + (size_t)r0 * (2 * DFF) + c0);
          gc[0] = bflo(w.x); gc[1] = bfhi(w.x); gc[2] = bflo(w.y); gc[3] = bfhi(w.y); gc[4] = bflo(w.z); gc[5] = bfhi(w.z); gc[6] = bflo(w.w); gc[7] = bfhi(w.w); }
        for (int r = 0; r < 16; ++r) {
            const int row = r0 + r; const bool has = ((row + 1) & (SEQ - 1)) != 0; v4u w = (v4u){0u, 0u, 0u, 0u}; if (has) w = *(const GAS v4u*)(p.gu + (size_t)(row + 1) * (2 * DFF) + c0);
            gn[0] = bflo(w.x); gn[1] = bfhi(w.x); gn[2] = bflo(w.y); gn[3] = bfhi(w.y); gn[4] = bflo(w.z); gn[5] = bfhi(w.z); gn[6] = bflo(w.w); gn[7] = bfhi(w.w);
            const v4u uw = *(const GAS v4u*)(p.gu + (size_t)row * (2 * DFF) + DFF + c0);
            const float up[8] = {bflo(uw.x), bfhi(uw.x), bflo(uw.y), bfhi(uw.y), bflo(uw.z), bfhi(uw.z), bflo(uw.w), bfhi(uw.w)};
            float a[8];
#pragma unroll
            for (int j = 0; j < 8; ++j) { const float cv = w0[j] * gp[j] + w1[j] * gc[j] + w2[j] * gn[j] + bb[j]; a[j] = cv / (1.f + __expf(-cv)) * up[j]; gp[j] = gc[j]; gc[j] = gn[j]; }
            v4u o; o.x = pk2(a[0], a[1]); o.y = pk2(a[2], a[3]); o.z = pk2(a[4], a[5]); o.w = pk2(a[6], a[7]);
            *(GAS v4u*)(p.act + (size_t)row * DFF + c0) = o;
        }
    }
}
__device__ __forceinline__ void phase_final(const P& p, int gw, int NGW, int lane) {
    for (int row = gw; row < MX; row += NGW) {
        const float* md = p.mod + (size_t)(row / SEQ) * NMOD;
        const GAS f32x4* fr = (const GAS f32x4*)(p.f + (size_t)row * DM) + lane;
        f32x4 v[16]; float ss = 0.f;
#pragma unroll
        for (int j = 0; j < 16; ++j) { v[j] = fr[64 * j]; ss += (v[j].x * v[j].x + v[j].y * v[j].y) + (v[j].z * v[j].z + v[j].w * v[j].w); }
        const float rstd = rsqrtf(wave_sum(ss) * (1.f / DM) + EPS);
        GAS f32x4* xo = (GAS f32x4*)(p.out + (size_t)row * DM) + lane;
#pragma unroll
        for (int j = 0; j < 16; ++j) { const f32x4 g = ((const GAS f32x4*)p.g_post_ffn)[lane + 64 * j], ga = ((const GAS f32x4*)(md + 5 * DM))[lane + 64 * j];
            xo[64 * j] = xo[64 * j] + ga * ((v[j] * rstd) * g); }
    }
}

constexpr int N_PHASES = 16;
struct Args { const float* in[29]; float* out; unsigned char* ws; int ph_lo, ph_hi, li, pad; };
__global__ void __launch_bounds__(NWAVES * 64, 2) skel_fwd(Args args) {
    extern __shared__ __attribute__((aligned(16))) unsigned char lds_raw[];
    LAS unsigned char* lds = (LAS unsigned char*)lds_raw;
    volatile LAS unsigned* MISC = (volatile LAS unsigned*)(lds + MISC_OFF);
    const int tid = threadIdx.x, lane = tid & 63, wave = __builtin_amdgcn_readfirstlane(tid >> 6);
    const int G = gridDim.x, blk = blockIdx.x;
    const int vcu = (G % 8 == 0) ? (blk % 8) * (G / 8) + blk / 8 : blk;
    const int gw = vcu * NWAVES + wave, NGW = G * NWAVES, gtid = blk * (NWAVES * 64) + tid, NGT = G * NWAVES * 64;
    unsigned char* ws = args.ws;
    P p;
    p.x = args.in[0]; p.c = args.in[1]; p.ctx = args.in[2]; p.cctx = args.in[3]; p.w_ada = args.in[4]; p.b_ada = args.in[5];
    p.g_pre_mix = args.in[6]; p.g_post_mix = args.in[7]; p.g_pre_ffn = args.in[8]; p.g_post_ffn = args.in[9]; p.w_in = args.in[10];
    p.lam_re = args.in[11]; p.lam_im = args.in[12]; p.log_step = args.in[13]; p.b_re = args.in[14]; p.b_im = args.in[15]; p.c_re = args.in[16]; p.c_im = args.in[17];
    p.s5d = args.in[18]; p.w_glu = args.in[19]; p.g_q = args.in[20]; p.w_uq = args.in[21]; p.g_kv = args.in[22]; p.w_ukv = args.in[23]; p.w_out = args.in[24];
    p.ffn_w_in = args.in[25]; p.conv_w = args.in[26]; p.conv_b = args.in[27]; p.ffn_w_down = args.in[28];
    p.out = args.out;
    p.mod = (float*)(ws + WS_MOD); p.abar = (float*)(ws + WS_S5A); p.bbr = (float*)(ws + WS_S5BR); p.bbi = (float*)(ws + WS_S5BI); p.rope = (float*)(ws + WS_ROPE); p.part = (float*)(ws + WS_PART);
    p.mix = (float*)(ws + WS_MIX); p.f = (float*)(ws + WS_F); p.ydir = (float*)(ws + WS_YDIR);
    p.WinT = (bf16*)(ws + WS_WIN); p.WuqT = (bf16*)(ws + WS_WUQ); p.WukvT = (bf16*)(ws + WS_WUKV); p.WgluT = (bf16*)(ws + WS_WGLU); p.WoutT = (bf16*)(ws + WS_WOUT); p.WfinT = (bf16*)(ws + WS_WFIN); p.WdownT = (bf16*)(ws + WS_WDOWN);
    p.h = (bf16*)(ws + WS_H); p.px = (bf16*)(ws + WS_PX); p.qcn = (bf16*)(ws + WS_QCN); p.kvcn = (bf16*)(ws + WS_KVCN); p.krope = (bf16*)(ws + WS_KROPE); p.q = (bf16*)(ws + WS_Q); p.kv = (bf16*)(ws + WS_KV);
    p.mixin = (bf16*)(ws + WS_MIXIN); p.yg = (bf16*)(ws + WS_YG); p.hx = (bf16*)(ws + WS_HX); p.gu = (bf16*)(ws + WS_GU); p.act = (bf16*)(ws + WS_ACT);

    for (int u = tid; u < (LDS_BYTES - LDSCTL_OFF) / 4; u += NWAVES * 64) ((LAS unsigned*)(lds + LDSCTL_OFF))[u] = 0u;
    __syncthreads();
#if MK_ONE_LAUNCH
    XcdBarrier bar = xcd_barrier_post((unsigned*)(ws + WS_CTL) + CW_BAR, MISC + 8);
#define GRID_BAR() xcd_barrier(bar)
#else
    (void)MISC;
#define GRID_BAR() do { } while (0)
#endif
    const int lo = args.ph_lo, hi = args.ph_hi;
#define IN(k) (lo <= (k) && (k) < hi)
#define SEAM(k) do { if (IN(k) && IN((k) + 1)) GRID_BAR(); } while (0)
    typedef pg8::StaticOrder SO;

    if (IN(0)) { phase_prologue(p, lds, gw, NGW, wave, lane, gtid, NGT); } SEAM(0);
    if (IN(1)) { phase_modreduce(p, gtid, NGT); } SEAM(1);
    if (IN(2)) { phase_norm1(p, gw, NGW, lane); } SEAM(2);
    if (IN(3)) { pg8::Gemm g{p.h, p.WinT, MALL, INCP, DM}; SO S; S.init(MALL, INCP, G, blk); pg8::EpiBf16P E{p.px, INCP};
                 pg8::gemm_phase<pg8::EpiBf16P, SO, true, true>(lds, g, S, E); } SEAM(3);
    if (IN(4)) { phase_postin(p, gw, NGW, lane); } SEAM(4);
    if (IN(5)) { { pg8::Gemm g{p.qcn, p.WuqT, MX, NQ, QRANK}; SO S; S.init(MX, NQ, G, blk); pg8::EpiQ E{p.q, p.rope, QSCALE};
                   pg8::gemm_phase<pg8::EpiQ, SO, true, true>(lds, g, S, E); }
                 { pg8::Gemm g{p.kvcn, p.WukvT, MALL, NKV, KVRANK}; SO S; S.init(MALL, NKV, G, blk); pg8::EpiBf16P E{p.kv, NKV};
                   pg8::gemm_phase<pg8::EpiBf16P, SO, true, true>(lds, g, S, E); } } SEAM(5);
    if (IN(6)) { phase_attn_v0(p, lds, blk, G); } SEAM(6);
    if (IN(7)) { phase_s5_v0(p, lds, blk, G, wave, lane); } SEAM(7);
    if (IN(8)) { phase_s5gelu(p, gtid, NGT); } SEAM(8);
    if (IN(9)) { pg8::Gemm g{p.yg, p.WgluT, MX, S5W, S5W}; SO S; S.init(MX, S5W, G, blk); pg8::EpiGlu E{p.yg, p.mixin, DM};
                 pg8::gemm_phase<pg8::EpiGlu, SO, true, true>(lds, g, S, E); } SEAM(9);
    if (IN(10)) { pg8::Gemm g{p.mixin, p.WoutT, MX, DM, DM}; SO S; S.init(MX, DM, G, blk); pg8::EpiF32P E{p.mix, DM};
                  pg8::gemm_phase<pg8::EpiF32P, SO, true, true>(lds, g, S, E); } SEAM(10);
    if (IN(11)) { phase_mid(p, gw, NGW, lane); } SEAM(11);
    if (IN(12)) { pg8::Gemm g{p.hx, p.WfinT, MX, 2 * DFF, DM}; SO S; S.init(MX, 2 * DFF, G, blk); pg8::EpiBf16P E{p.gu, 2 * DFF};
                  pg8::gemm_phase<pg8::EpiBf16P, SO, true, true>(lds, g, S, E); } SEAM(12);
    if (IN(13)) { phase_convact(p, gtid, NGT); } SEAM(13);
    if (IN(14)) { pg8::Gemm g{p.act, p.WdownT, MX, DM, DFF}; SO S; S.init(MX, DM, G, blk); pg8::EpiF32P E{p.f, DM};
                  pg8::gemm_phase<pg8::EpiF32P, SO, true, true>(lds, g, S, E); } SEAM(14);
    if (IN(15)) { phase_final(p, gw, NGW, lane); }
#undef IN
#undef SEAM
}

extern "C" void kernel_launch(void* const* d_in, const int* in_sizes, int n_in, void* d_out, int out_size, void* d_ws, size_t ws_size, hipStream_t stream) {
    static int grid = 0;
    if (grid == 0) {
        if (n_in != 29 || out_size != MX * DM || ws_size < WS_END) { fprintf(stderr, "kernel_launch: unexpected shapes: n_in %d out %d ws %zu (need %zu)\n", n_in, out_size, ws_size, (size_t)WS_END); grid = -1; return; }
        int dev = 0, cus = 0;
        if (hipGetDevice(&dev) != hipSuccess || hipDeviceGetAttribute(&cus, hipDeviceAttributeMultiprocessorCount, dev) != hipSuccess) { grid = -1; return; }
        if (hipFuncSetAttribute((const void*)skel_fwd, hipFuncAttributeMaxDynamicSharedMemorySize, LDS_BYTES) != hipSuccess) { fprintf(stderr, "kernel_launch: hipFuncSetAttribute failed\n"); grid = -1; return; }
        int per_cu = 0;
        if (hipOccupancyMaxActiveBlocksPerMultiprocessor(&per_cu, (const void*)skel_fwd, NWAVES * 64, LDS_BYTES) != hipSuccess || per_cu < 1) fprintf(stderr, "kernel_launch: occupancy query says %d\n", per_cu);
        (void)hipGetLastError();
        grid = cus;
    }
    if (grid < 0) return;
    (void)hipMemsetAsync((char*)d_ws + WS_CTL, 0, CTL_ZERO_BYTES, stream);
    Args a{};
    for (int i = 0; i < 29; ++i) a.in[i] = (const float*)d_in[i];
    a.out = (float*)d_out; a.ws = (unsigned char*)d_ws;
#if MK_ONE_LAUNCH
    a.ph_lo = 0; a.ph_hi = N_PHASES; a.li = 0;
    hipLaunchKernelGGL(skel_fwd, dim3(grid), dim3(NWAVES * 64), LDS_BYTES, stream, a);
#else
    for (int ph = 0; ph < N_PHASES; ++ph) { a.ph_lo = ph; a.ph_hi = ph + 1; a.li = ph; hipLaunchKernelGGL(skel_fwd, dim3(grid), dim3(NWAVES * 64), LDS_BYTES, stream, a); }
#endif
    const hipError_t le = hipPeekAtLastError();
    if (le != hipSuccess) fprintf(stderr, "kernel_launch: launch failed: %s\n", hipGetErrorName(le));
}
```

```cpp
#include <hip/hip_runtime.h>
#include <cstdio>
#include <cstdint>
#include <cmath>

#ifndef MK_ONE_LAUNCH
#define MK_ONE_LAUNCH 1
#endif

namespace pg8 {
#define PG8_LAS __attribute__((address_space(3)))
typedef unsigned short bf16_t;
typedef short bf16x8 __attribute__((ext_vector_type(8)));
typedef float f32x4 __attribute__((ext_vector_type(4)));
typedef float f32x2 __attribute__((ext_vector_type(2)));
typedef unsigned u32x4 __attribute__((ext_vector_type(4)));
constexpr int BM = 256, BK = 64, HALF = 128, HTB = HALF * BK * 2  , STAGE_BYTES = 8 * HTB, NXCD = 8, WGM = 8;

__host__ __device__ __forceinline__ int lds_byte(int r, int c) { const int st = (r >> 4) * 2 + (c >> 5), rr = r & 15, cc = c & 31, ob = rr * 64 + cc * 2; return st * 1024 + (ob ^ (((ob >> 9) & 1) << 5)); }
__host__ __device__ __forceinline__ void stage_rc(int b, int& R, int& C) { const int st = b / 1024, sb = b % 1024, swz = sb ^ (((sb >> 9) & 1) << 5); R = (st >> 1) * 16 + swz / 64; C = (st & 1) * 32 + (swz % 64) / 2; }
__host__ __device__ __forceinline__ int perm32(int rho) { const int n = rho >> 4, i = rho & 15; return 8 * (i >> 2) + 4 * n + (i & 3); }

struct Unit { int pm, pn; };
struct Gemm { const bf16_t* A; const bf16_t* Bt; int M, N, K; };

struct StaticOrder {
    int nM, nN, nwg, G, c;
    __host__ __device__ void init(int M, int N, int G_, int c_) { nM = M / BM; nN = N / BM; nwg = nM * nN; G = G_; c = c_; }
    __host__ __device__ bool next(int i, Unit& u) const {
        const long L = (long)i * G + c; if (L >= nwg) return false;
        int wgid = (int)L; { const int q = nwg / NXCD, r = nwg % NXCD, xcd = wgid % NXCD, off = wgid / NXCD; wgid = (xcd < r ? xcd * (q + 1) : r * (q + 1) + (xcd - r) * q) + off; }
        const int nig = WGM * nN, gid = wgid / nig, fm = gid * WGM, gsz = (nM - fm) < WGM ? (nM - fm) : WGM;
        u.pm = fm + ((wgid % nig) % gsz); u.pn = (wgid % nig) / gsz; return true;
    }
    __device__ __forceinline__ void a_ready(const Unit&) const {}
    __device__ __forceinline__ void done(const Unit&) const {}
};

__device__ __forceinline__ unsigned cvt_pk_bf16(float lo, float hi) { unsigned r; asm volatile("v_cvt_pk_bf16_f32 %0, %1, %2" : "=v"(r) : "v"(lo), "v"(hi)); return r; }
__device__ __forceinline__ float bf_lo(unsigned w) { return __uint_as_float(w << 16); }
__device__ __forceinline__ float bf_hi(unsigned w) { return __uint_as_float(w & 0xffff0000u); }

struct EpiBf16P {
    static constexpr bool PERM = true, AFTER_DRAIN = false;
    bf16_t* O; int ldc;
    __device__ __forceinline__ void operator()(const f32x4 (&acc)[2][2][4][2], const Unit& u, int wr, int wc, int fr, int fq) const {
        const int row0 = u.pm * BM + wr * 64 + fr, col0 = u.pn * BM + wc * 32 + 8 * fq;
#pragma unroll
        for (int ai = 0; ai < 2; ++ai)
#pragma unroll
            for (int m = 0; m < 4; ++m) { bf16_t* rowp = O + (size_t)(row0 + ai * HALF + m * 16) * ldc + col0;
#pragma unroll
                for (int bj = 0; bj < 2; ++bj) { const f32x4 v0 = acc[ai][bj][m][0], v1 = acc[ai][bj][m][1];
                    u32x4 w; w.x = cvt_pk_bf16(v0[0], v0[1]); w.y = cvt_pk_bf16(v0[2], v0[3]); w.z = cvt_pk_bf16(v1[0], v1[1]); w.w = cvt_pk_bf16(v1[2], v1[3]);
                    *(u32x4*)(rowp + bj * HALF) = w; } }
    }
};
struct EpiF32P {
    static constexpr bool PERM = false, AFTER_DRAIN = false;
    float* C; int ldc;
    __device__ __forceinline__ void operator()(const f32x4 (&acc)[2][2][4][2], const Unit& u, int wr, int wc, int fr, int fq) const {
        const int row0 = u.pm * BM + wr * 64 + fr, col0 = u.pn * BM + wc * 32 + 4 * fq;
#pragma unroll
        for (int ai = 0; ai < 2; ++ai)
#pragma unroll
            for (int m = 0; m < 4; ++m) { float* rowp = C + (size_t)(row0 + ai * HALF + m * 16) * ldc + col0;
#pragma unroll
                for (int bj = 0; bj < 2; ++bj)
#pragma unroll
                    for (int n = 0; n < 2; ++n) *(f32x4*)(rowp + bj * HALF + n * 16) = acc[ai][bj][m][n]; }
    }
};
struct EpiQ {
    static constexpr bool PERM = true, AFTER_DRAIN = false;
    bf16_t* O; const float* rope; float scale;
    __device__ __forceinline__ void operator()(const f32x4 (&acc)[2][2][4][2], const Unit& u, int wr, int wc, int fr, int fq) const {
        const int row0 = u.pm * BM + wr * 64 + fr, col0 = u.pn * BM + wc * 32 + 8 * fq;
#pragma unroll
        for (int ai = 0; ai < 2; ++ai)
#pragma unroll
            for (int m = 0; m < 4; ++m) { const int row = row0 + ai * HALF + m * 16; const int t = row & 4095; bf16_t* rowp = O + (size_t)row * 4608 + col0;
#pragma unroll
                for (int bj = 0; bj < 2; ++bj) { f32x4 v0 = acc[ai][bj][m][0] * scale, v1 = acc[ai][bj][m][1] * scale;
                    const int col = col0 + bj * HALF; const int within = col % 192;
                    if (within >= 128) { const float* cs = rope + ((size_t)t * 32 + ((within - 128) >> 1)) * 2; const f32x4 c01 = *(const f32x4*)cs, c23 = *(const f32x4*)(cs + 4);
                        const float a0 = v0[0], a1 = v0[1], a2 = v0[2], a3 = v0[3], b0 = v1[0], b1 = v1[1], b2 = v1[2], b3 = v1[3];
                        v0[0] = a0 * c01[0] - a1 * c01[1]; v0[1] = a0 * c01[1] + a1 * c01[0]; v0[2] = a2 * c01[2] - a3 * c01[3]; v0[3] = a2 * c01[3] + a3 * c01[2];
                        v1[0] = b0 * c23[0] - b1 * c23[1]; v1[1] = b0 * c23[1] + b1 * c23[0]; v1[2] = b2 * c23[2] - b3 * c23[3]; v1[3] = b2 * c23[3] + b3 * c23[2]; }
                    u32x4 w; w.x = cvt_pk_bf16(v0[0], v0[1]); w.y = cvt_pk_bf16(v0[2], v0[3]); w.z = cvt_pk_bf16(v1[0], v1[1]); w.w = cvt_pk_bf16(v1[2], v1[3]);
                    *(u32x4*)(rowp + bj * HALF) = w; } }
    }
};
struct EpiGlu {
    static constexpr bool PERM = true, AFTER_DRAIN = false;
    const bf16_t* YG; bf16_t* O; int ldo;
    __device__ __forceinline__ void operator()(const f32x4 (&acc)[2][2][4][2], const Unit& u, int wr, int wc, int fr, int fq) const {
        const int row0 = u.pm * BM + wr * 64 + fr, col0 = u.pn * BM + wc * 32 + 8 * fq;
#pragma unroll
        for (int ai = 0; ai < 2; ++ai)
#pragma unroll
            for (int m = 0; m < 4; ++m) { const int row = row0 + ai * HALF + m * 16;
#pragma unroll
                for (int bj = 0; bj < 2; ++bj) { const int col = col0 + bj * HALF; const u32x4 y = *(const u32x4*)(YG + (size_t)row * 1024 + col);
                    const f32x4 v0 = acc[ai][bj][m][0], v1 = acc[ai][bj][m][1];
                    float o[8]; const float yv[8] = {bf_lo(y.x), bf_hi(y.x), bf_lo(y.y), bf_hi(y.y), bf_lo(y.z), bf_hi(y.z), bf_lo(y.w), bf_hi(y.w)};
#pragma unroll
                    for (int j = 0; j < 4; ++j) { o[j] = yv[j] / (1.f + __expf(-v0[j])); o[4 + j] = yv[4 + j] / (1.f + __expf(-v1[j])); }
                    u32x4 w; w.x = cvt_pk_bf16(o[0], o[1]); w.y = cvt_pk_bf16(o[2], o[3]); w.z = cvt_pk_bf16(o[4], o[5]); w.w = cvt_pk_bf16(o[6], o[7]);
                    *(u32x4*)(O + (size_t)row * ldo + col) = w; } }
    }
};

template <class Epi, class Sched, bool ALIGN_EPI = false, bool SP2 = false>
__device__ __forceinline__ void gemm_phase(PG8_LAS unsigned char* lds, const Gemm g, const Sched& S, const Epi& E) {
    const int tid = threadIdx.x, wid = __builtin_amdgcn_readfirstlane(tid >> 6), lane = tid & 63, wr = wid >> 2, wc = wid & 3, fr = lane & 15, fq = lane >> 4;
    const int K = g.K, nt = K / BK;
    unsigned voffA[2], voffB[2];
#pragma unroll
    for (int i = 0; i < 2; ++i) { int R, C; stage_rc(tid * 16 + i * 8192, R, C); const int Rb = Epi::PERM ? ((R & ~31) + perm32(R & 31)) : R;
        voffA[i] = (unsigned)(R * K + C) * 2u; voffB[i] = (unsigned)(Rb * K + C) * 2u; }
    const size_t kstep = (size_t)(BK * 2);
    const size_t hstep = (size_t)HALF * K * 2;
    const size_t tstep = 2 * hstep;
    const unsigned ldsw = (unsigned)wid * 1024u;
    const int aoff = lds_byte(wr * 64 + fr, fq * 8), boff = lds_byte(wc * 32 + fr, fq * 8);
#define PG8_SA(b, h) (((b) * 2 + (h)) * HTB)
#define PG8_SB(b, h) ((4 + (b) * 2 + (h)) * HTB)
#define PG8_STAGE(bufoff, gbase, voff) do { _Pragma("unroll") for (int _i = 0; _i < 2; ++_i) \
        __builtin_amdgcn_global_load_lds((const unsigned*)((const char*)(gbase) + (voff)[_i]), (PG8_LAS unsigned*)(lds + (bufoff) + ldsw + _i * 8192), 16, 0, 0); } while (0)
#define PG8_LDA(dst, b, h) do { _Pragma("unroll") for (int m = 0; m < 4; ++m) _Pragma("unroll") for (int k = 0; k < 2; ++k) dst[m][k] = *(const PG8_LAS bf16x8*)(lds + PG8_SA(b, h) + aoff + m * 2048 + k * 1024); } while (0)
#define PG8_LDB(dst, b, h) do { _Pragma("unroll") for (int n = 0; n < 2; ++n) _Pragma("unroll") for (int k = 0; k < 2; ++k) dst[n][k] = *(const PG8_LAS bf16x8*)(lds + PG8_SB(b, h) + boff + n * 2048 + k * 1024); } while (0)
#define PG8_MMA(ai, bj, At, Bt) do { __builtin_amdgcn_s_setprio(1); _Pragma("unroll") for (int m = 0; m < 4; ++m) _Pragma("unroll") for (int n = 0; n < 2; ++n) _Pragma("unroll") for (int k = 0; k < 2; ++k) \
        acc[ai][bj][m][n] = __builtin_amdgcn_mfma_f32_16x16x32_bf16(Bt[n][k], At[m][k], acc[ai][bj][m][n], 0, 0, 0); __builtin_amdgcn_s_setprio(0); } while (0)
#define PG8_WAIT_V(n) asm volatile("s_waitcnt vmcnt(" #n ")" ::: "memory")
#define PG8_WAIT_L(n) asm volatile("s_waitcnt lgkmcnt(" #n ")" ::: "memory")
#define PG8_BAR __builtin_amdgcn_s_barrier()
#define PG8_SCHED __builtin_amdgcn_sched_barrier(0)
    Unit cur, nxt; int ui = 0;
    if (!S.next(0, cur)) return;
    f32x4 acc[2][2][4][2];
#pragma unroll
    for (int a = 0; a < 2; ++a)
#pragma unroll
        for (int b = 0; b < 2; ++b)
#pragma unroll
            for (int m = 0; m < 4; ++m)
#pragma unroll
                for (int n = 0; n < 2; ++n) acc[a][b][m][n] = (f32x4){0.f, 0.f, 0.f, 0.f};
    bf16x8 At[4][2], B0[2][2], B1[2][2];
    const char* cA = (const char*)g.A + (size_t)cur.pm * tstep; const char* cB = (const char*)g.Bt + (size_t)cur.pn * tstep;
    S.a_ready(cur);
    if constexpr (SP2) {
        PG8_STAGE(PG8_SB(0, 0), cB, voffB); PG8_STAGE(PG8_SB(0, 1), cB + hstep, voffB); PG8_STAGE(PG8_SA(0, 0), cA, voffA); PG8_STAGE(PG8_SA(0, 1), cA + hstep, voffA);
        if (wr == 1) PG8_BAR;
        PG8_WAIT_V(2); PG8_BAR;
        PG8_STAGE(PG8_SB(1, 0), cB + kstep, voffB); PG8_STAGE(PG8_SA(1, 0), cA + kstep, voffA); PG8_STAGE(PG8_SB(1, 1), cB + hstep + kstep, voffB);
        PG8_WAIT_V(6); PG8_BAR;
    } else {
        PG8_STAGE(PG8_SB(0, 0), cB, voffB); PG8_STAGE(PG8_SA(0, 0), cA, voffA); PG8_STAGE(PG8_SB(0, 1), cB + hstep, voffB); PG8_STAGE(PG8_SA(0, 1), cA + hstep, voffA);
        if (wr == 1) PG8_BAR;
        PG8_WAIT_V(4); PG8_BAR;
        PG8_STAGE(PG8_SB(1, 0), cB + kstep, voffB); PG8_STAGE(PG8_SA(1, 0), cA + kstep, voffA); PG8_STAGE(PG8_SB(1, 1), cB + hstep + kstep, voffB);
        PG8_WAIT_V(6); PG8_BAR;
    }
    for (;;) {
        const bool has_next = S.next(ui + 1, nxt);
        const char* nA = has_next ? (const char*)g.A + (size_t)nxt.pm * tstep : cA; const char* nB = has_next ? (const char*)g.Bt + (size_t)nxt.pn * tstep : cB;
        for (int t = 0; t < nt; t += 2) {
            const bool last = (t == nt - 2);
            const char* a1 = cA + (size_t)(t + 1) * kstep;
            const char* a2 = last ? nA : cA + (size_t)(t + 2) * kstep; const char* b2 = last ? nB : cB + (size_t)(t + 2) * kstep;
            const char* a3 = a2 + kstep; const char* b3 = b2 + kstep;
            if (last && has_next) S.a_ready(nxt);
            if constexpr (SP2) {
            PG8_LDB(B0, 0, 0); PG8_LDB(B1, 0, 1); PG8_SCHED; PG8_LDA(At, 0, 0); PG8_STAGE(PG8_SA(1, 1), a1 + hstep, voffA);
            PG8_WAIT_V(8); PG8_WAIT_L(0); PG8_BAR; PG8_MMA(0, 0, At, B0); PG8_MMA(0, 1, At, B1); PG8_BAR; PG8_SCHED;
            PG8_LDA(At, 0, 1); PG8_STAGE(PG8_SB(0, 0), b2, voffB); PG8_STAGE(PG8_SB(0, 1), b2 + hstep, voffB); PG8_STAGE(PG8_SA(0, 0), a2, voffA);
            PG8_WAIT_V(8); PG8_WAIT_L(0); PG8_BAR; PG8_MMA(1, 0, At, B0); PG8_MMA(1, 1, At, B1); PG8_BAR; PG8_SCHED;
            PG8_LDB(B0, 1, 0); PG8_LDB(B1, 1, 1); PG8_SCHED; PG8_LDA(At, 1, 0); PG8_STAGE(PG8_SA(0, 1), a2 + hstep, voffA);
            PG8_WAIT_V(8); PG8_WAIT_L(0); PG8_BAR; PG8_MMA(0, 0, At, B0); PG8_MMA(0, 1, At, B1); PG8_BAR; PG8_SCHED;
            PG8_LDA(At, 1, 1); PG8_STAGE(PG8_SB(1, 0), b3, voffB); PG8_STAGE(PG8_SB(1, 1), b3 + hstep, voffB); PG8_STAGE(PG8_SA(1, 0), a3, voffA);
            PG8_WAIT_V(8); PG8_WAIT_L(0); PG8_BAR; PG8_MMA(1, 0, At, B0); PG8_MMA(1, 1, At, B1); PG8_BAR; PG8_SCHED;
            } else {
            PG8_LDB(B0, 0, 0); PG8_SCHED; PG8_LDA(At, 0, 0); PG8_STAGE(PG8_SA(1, 1), a1 + hstep, voffA);
            PG8_WAIT_L(8); PG8_BAR; PG8_WAIT_L(0); PG8_MMA(0, 0, At, B0); PG8_BAR; PG8_SCHED;
            PG8_LDB(B1, 0, 1); PG8_STAGE(PG8_SB(0, 0), b2, voffB);
            PG8_BAR; PG8_WAIT_L(0); PG8_MMA(0, 1, At, B1); PG8_BAR;
            PG8_LDA(At, 0, 1); PG8_STAGE(PG8_SA(0, 0), a2, voffA);
            PG8_BAR; PG8_WAIT_L(0); PG8_MMA(1, 0, At, B0); PG8_BAR; PG8_SCHED;
            PG8_STAGE(PG8_SB(0, 1), b2 + hstep, voffB);
            PG8_WAIT_V(6); PG8_BAR; PG8_MMA(1, 1, At, B1); PG8_BAR;
            PG8_LDB(B0, 1, 0); PG8_SCHED; PG8_LDA(At, 1, 0); PG8_STAGE(PG8_SA(0, 1), a2 + hstep, voffA);
            PG8_WAIT_L(8); PG8_BAR; PG8_WAIT_L(0); PG8_MMA(0, 0, At, B0); PG8_BAR; PG8_SCHED;
            PG8_LDB(B1, 1, 1); PG8_STAGE(PG8_SB(1, 0), b3, voffB);
            PG8_BAR; PG8_WAIT_L(0); PG8_MMA(0, 1, At, B1); PG8_BAR;
            PG8_LDA(At, 1, 1); PG8_STAGE(PG8_SA(1, 0), a3, voffA);
            PG8_BAR; PG8_WAIT_L(0); PG8_MMA(1, 0, At, B0); PG8_BAR; PG8_SCHED;
            PG8_STAGE(PG8_SB(1, 1), b3 + hstep, voffB);
            PG8_WAIT_V(6); PG8_BAR; PG8_MMA(1, 1, At, B1); PG8_BAR;
            }
        }
        if constexpr (ALIGN_EPI) { if (wr == 0) PG8_BAR; }
        if constexpr (!Epi::AFTER_DRAIN) { E(acc, cur, wr, wc, fr, fq); S.done(cur); }
        if (!has_next) break;
#pragma unroll
        for (int a = 0; a < 2; ++a)
#pragma unroll
            for (int b = 0; b < 2; ++b)
#pragma unroll
                for (int m = 0; m < 4; ++m)
#pragma unroll
                    for (int n = 0; n < 2; ++n) acc[a][b][m][n] = (f32x4){0.f, 0.f, 0.f, 0.f};
        cur = nxt; cA = nA; cB = nB; ++ui;
        if constexpr (ALIGN_EPI) { if (wr == 1) PG8_BAR; }
    }
    PG8_WAIT_V(0);
    if constexpr (!ALIGN_EPI) { if (wr == 0) PG8_BAR; }
    PG8_BAR;
    if constexpr (Epi::AFTER_DRAIN) { E.fused(acc, cur, wr, wc, fr, fq, lds, wid, lane); S.done(cur); }
#undef PG8_SA
#undef PG8_SB
#undef PG8_STAGE
#undef PG8_LDA
#undef PG8_LDB
#undef PG8_MMA
#undef PG8_WAIT_V
#undef PG8_WAIT_L
#undef PG8_BAR
#undef PG8_SCHED
}
}

constexpr int DM = 4096, NB = 4, SEQ = 4096, CTXL = 256;
constexpr int MX = NB * SEQ, MC = NB * CTXL, MALL = MX + MC;
constexpr int S5W = 1024, QRANK = 1024, KVRANK = 512, ROPED = 64;
constexpr int INC = 2624, INCP = 2816;
constexpr int NH = 24, DQK = 192, DNOPE = 128, DV = 128;
constexpr int NQ = NH * DQK, NKV = NH * (DNOPE + DV);
constexpr int DFF = 11008, NMOD = 6 * DM;
constexpr float EPS = 1e-6f;
constexpr float QSCALE = 0.07216878364870322f * 1.4426950408889634f;
constexpr int NKT = (CTXL + SEQ) / 64;

constexpr size_t MiB = 1u << 20;
constexpr size_t WS_CTL = 0, CTL_ZERO_BYTES = 1 * MiB;
constexpr size_t WS_MOD = 1 * MiB;
constexpr size_t WS_S5A = 2 * MiB;
constexpr size_t WS_S5BR = 2 * MiB + 65536;
constexpr size_t WS_S5BI = WS_S5BR + 524288;
constexpr size_t WS_ROPE = 4 * MiB;
constexpr size_t WS_PART = 5 * MiB;
constexpr size_t WS_WIN = 16 * MiB, WS_WUQ = 38 * MiB, WS_WUKV = 47 * MiB, WS_WGLU = 53 * MiB, WS_WOUT = 55 * MiB, WS_WFIN = 87 * MiB, WS_WDOWN = 259 * MiB;
constexpr size_t WS_R1 = 345 * MiB, WS_R2 = 1033 * MiB, WS_END = 1377 * MiB;
constexpr size_t WS_H = WS_R1, WS_PX = WS_R1 + 136 * MiB, WS_QCN = WS_R1 + 230 * MiB, WS_KVCN = WS_R1 + 262 * MiB, WS_KROPE = WS_R1 + 279 * MiB, WS_Q = WS_R1 + 282 * MiB, WS_KV = WS_R1 + 426 * MiB;
constexpr size_t WS_MIX = WS_R1, WS_GU = WS_R1, WS_F = WS_R1;
constexpr size_t WS_MIXIN = WS_R2, WS_YG = WS_R2 + 128 * MiB, WS_YDIR = WS_R2 + 160 * MiB, WS_HX = WS_R2, WS_ACT = WS_R2;
static_assert(WS_KV + (size_t)MALL * NKV * 2 <= WS_R2 && WS_YDIR + (size_t)2 * MX * S5W * 4 <= WS_END && WS_GU + (size_t)MX * 2 * DFF * 2 <= WS_R2 && WS_ACT + (size_t)MX * DFF * 2 <= WS_END, "ws map");
static_assert(WS_WIN + (size_t)INCP * DM * 2 <= WS_WUQ && WS_WFIN + (size_t)2 * DFF * DM * 2 <= WS_WDOWN && WS_WDOWN + (size_t)DM * DFF * 2 <= WS_R1 && WS_PART + (size_t)16 * 5 * NMOD * 4 <= WS_WIN, "ws map (weights)");
constexpr int CW_BAR = 4096;

constexpr int RING_BYTES = 131072;
constexpr int LDSCTL_OFF = RING_BYTES, MISC_OFF = LDSCTL_OFF + 320;
constexpr int LDS_BYTES = 147456;
constexpr int NWAVES = 8;

#define GAS __attribute__((address_space(1)))
#define LAS __attribute__((address_space(3)))
typedef unsigned short bf16;
typedef unsigned v4u __attribute__((ext_vector_type(4)));
typedef unsigned v2u __attribute__((ext_vector_type(2)));
typedef float f32x4 __attribute__((ext_vector_type(4)));
#define LDS_WAIT() asm volatile("s_waitcnt lgkmcnt(0)" ::: "memory")
__device__ __forceinline__ unsigned f2bf(float f) { unsigned u = __builtin_bit_cast(unsigned, f); return (u + 0x7fffu + ((u >> 16) & 1u)) >> 16; }
__device__ __forceinline__ unsigned pk2(float lo, float hi) { return f2bf(lo) | (f2bf(hi) << 16); }
__device__ __forceinline__ float bflo(unsigned w) { return __uint_as_float(w << 16); }
__device__ __forceinline__ float bfhi(unsigned w) { return __uint_as_float(w & 0xffff0000u); }
__device__ __forceinline__ float wave_sum(float v) {
#pragma unroll
    for (int o = 1; o < 64; o <<= 1) v += __shfl_xor(v, o);
    return v;
}

#define XB_TMO      128
#define XB_XCNT(j)  (256  + 64 * (j))
#define XB_XSUB(j)  (1280 + 64 * (j))
#define XB_XGEN(j)  (2304 + 64 * (j))
#define XB_TOP      3328
#define XB_TOPGEN   3392
#define XCD_BAR_WORDS 3456
#define XB_SPIN_CAP (1u << 18)

__device__ __forceinline__ unsigned xb_ld(unsigned* p)              { return __hip_atomic_load(p, __ATOMIC_RELAXED, __HIP_MEMORY_SCOPE_AGENT); }
__device__ __forceinline__ unsigned xb_add(unsigned* p, unsigned v) { return __hip_atomic_fetch_add(p, v, __ATOMIC_RELAXED, __HIP_MEMORY_SCOPE_AGENT); }
__device__ __forceinline__ unsigned xb_xcc_id() { return (unsigned)__builtin_amdgcn_s_getreg((3 << 11) | 20) & 0xFu; }
#define XB_SPIN(cond, bar) do { unsigned _sp = 0; while (cond) { __builtin_amdgcn_s_sleep(1); \
    if ((++_sp & 255u) == 0u) { if (xb_ld(&(bar)[XB_TMO])) break; if (_sp > XB_SPIN_CAP) { atomicAdd(&(bar)[XB_TMO], 1u); break; } } } } while (0)

struct XcdBarrier {
    unsigned* bar; unsigned x;
    volatile LAS unsigned* st;
};

__device__ __forceinline__ XcdBarrier xcd_barrier_post(unsigned* bar, volatile LAS unsigned* st) {
    XcdBarrier b; b.bar = bar; b.x = xb_xcc_id(); b.st = st;
    if (threadIdx.x == 0) (void)xb_add(&bar[XB_XCNT(b.x)], 1u);
    return b;
}
__device__ __forceinline__ void xcd_barrier_complete(unsigned* bar, unsigned x, unsigned& nloc, unsigned& nx) {
    const unsigned G = gridDim.x * gridDim.y * gridDim.z;
    unsigned sum, cnt, mine, sp = 0u;
    for (;;) {
        sum = 0u; cnt = 0u; mine = 0u;
#pragma unroll
        for (unsigned j = 0; j < 16; ++j) { const unsigned c = xb_ld(&bar[XB_XCNT(j)]); sum += c; cnt += (c > 0u) ? 1u : 0u; mine = (j == x) ? c : mine; }
        if (sum == G) break;
        __builtin_amdgcn_s_sleep(1);
        if ((++sp & 255u) == 0u) { if (xb_ld(&bar[XB_TMO])) break; if (sp > XB_SPIN_CAP) { atomicAdd(&bar[XB_TMO], 1u); break; } }
    }
    nloc = mine > 0u ? mine : 1u; nx = cnt > 0u ? cnt : 1u;
}

__device__ __forceinline__ void xcd_barrier(const XcdBarrier& b) {
    asm volatile("s_waitcnt vmcnt(0)" ::: "memory");
    __syncthreads();
    if (threadIdx.x == 0) {
        unsigned* bar = b.bar;
        __builtin_amdgcn_s_waitcnt(0);
        unsigned nloc = b.st[0], nx = b.st[1];
        if (nloc == 0u) { xcd_barrier_complete(bar, b.x, nloc, nx); b.st[0] = nloc; b.st[1] = nx; }
        const unsigned old = xb_add(&bar[XB_XSUB(b.x)], 1u);
        const unsigned gen = old / nloc;
        if (old + 1u == (gen + 1u) * nloc) {
            __builtin_amdgcn_fence(__ATOMIC_RELEASE, "agent");
            asm volatile("s_waitcnt vmcnt(0)" ::: "memory");
            const unsigned og = xb_add(&bar[XB_TOP], 1u);
            const unsigned tg = og / nx;
            if (og + 1u == (tg + 1u) * nx) xb_add(&bar[XB_TOPGEN], 1u);
            else XB_SPIN(xb_ld(&bar[XB_TOPGEN]) == tg, bar);
            __builtin_amdgcn_fence(__ATOMIC_ACQUIRE, "agent");
            xb_add(&bar[XB_XGEN(b.x)], 1u);
            asm volatile("s_waitcnt vmcnt(0)" ::: "memory");
        } else {
            XB_SPIN(xb_ld(&bar[XB_XGEN(b.x)]) == gen, bar);
            __builtin_amdgcn_fence(__ATOMIC_ACQUIRE, "agent");
            asm volatile("s_waitcnt vmcnt(0)" ::: "memory");
        }
    }
    __syncthreads();
}

__device__ __forceinline__ void p0_transpose_item(const float* W, int K, int N, bf16* WT, LAS float* scr, int item, int lane) {
    const int nblk = N / 32, kb = item / nblk, nb = item % nblk, k0 = 64 * kb, n0 = 32 * nb;
#pragma unroll 8
    for (int i = 0; i < 32; ++i) { const int kk = 2 * i + (lane >> 5); scr[kk * 33 + (lane & 31)] = W[(size_t)(k0 + kk) * N + n0 + (lane & 31)]; }
    LDS_WAIT(); asm volatile("" ::: "memory");
    const int c = lane & 7;
#pragma unroll
    for (int j = 0; j < 4; ++j) { const int n = (lane >> 3) + 8 * j; const LAS float* s = scr + (8 * c) * 33 + n;
        v4u o; o.x = pk2(s[0 * 33], s[1 * 33]); o.y = pk2(s[2 * 33], s[3 * 33]); o.z = pk2(s[4 * 33], s[5 * 33]); o.w = pk2(s[6 * 33], s[7 * 33]);
        *(GAS v4u*)(WT + (size_t)(n0 + n) * K + k0 + 8 * c) = o; }
    LDS_WAIT(); asm volatile("" ::: "memory");
}
__device__ __forceinline__ void p0_ada_item(const float* c, const float* cctx, const float* w_ada, float* part, int item, int lane) {
    const int nb = item % 96, ks = item / 96, n0 = nb * 256 + lane * 4, k0 = ks * 256;
    f32x4 acc[5];
#pragma unroll
    for (int r = 0; r < 5; ++r) acc[r] = (f32x4){0.f, 0.f, 0.f, 0.f};
    for (int kk = 0; kk < 256; kk += 4) {
        f32x4 w[4];
#pragma unroll
        for (int j = 0; j < 4; ++j) w[j] = *(const GAS f32x4*)(w_ada + (size_t)(k0 + kk + j) * NMOD + n0);
#pragma unroll
        for (int j = 0; j < 4; ++j) {
#pragma unroll
            for (int r = 0; r < 5; ++r) { const float cv = (r < 4) ? c[r * DM + k0 + kk + j] : cctx[k0 + kk + j]; const float s = cv / (1.f + expf(-cv)); acc[r] += w[j] * s; }
        }
    }
#pragma unroll
    for (int r = 0; r < 5; ++r) *(GAS f32x4*)(part + (size_t)(ks * 5 + r) * NMOD + n0) = acc[r];
}

struct P {
    const float *x, *c, *ctx, *cctx, *w_ada, *b_ada, *g_pre_mix, *g_post_mix, *g_pre_ffn, *g_post_ffn, *w_in;
    const float *lam_re, *lam_im, *log_step, *b_re, *b_im, *c_re, *c_im, *s5d, *w_glu, *g_q, *w_uq, *g_kv, *w_ukv, *w_out, *ffn_w_in, *conv_w, *conv_b, *ffn_w_down;
    float* out;
    float *mod, *abar, *bbr, *bbi, *rope, *part, *mix, *f, *ydir;
    bf16 *WinT, *WuqT, *WukvT, *WgluT, *WoutT, *WfinT, *WdownT;
    bf16 *h, *px, *qcn, *kvcn, *krope, *q, *kv, *mixin, *yg, *hx, *gu, *act;
};

__device__ __forceinline__ void phase_prologue(const P& p, LAS unsigned char* lds, int gw, int NGW, int wave, int lane, int gtid, int NGT) {
    LAS float* scr = (LAS float*)(lds + wave * 16384);
    constexpr int I_IN = (DM / 64) * (INC / 32), I_UQ = (QRANK / 64) * (NQ / 32), I_UKV = (KVRANK / 64) * (NKV / 32), I_GLU = (S5W / 64) * (S5W / 32),
                  I_OUT = (DM / 64) * (DM / 32), I_FIN = (DM / 64) * (2 * DFF / 32), I_DOWN = (DFF / 64) * (DM / 32), I_ADA = 96 * 16;
    constexpr int NITEMS = I_ADA + I_IN + I_UQ + I_UKV + I_GLU + I_OUT + I_FIN + I_DOWN;
    for (int it = gw; it < NITEMS; it += NGW) {
        int r = it;
        if (r < I_ADA) { p0_ada_item(p.c, p.cctx, p.w_ada, p.part, r, lane); continue; } r -= I_ADA;
        if (r < I_IN) { p0_transpose_item(p.w_in, DM, INC, p.WinT, scr, r, lane); continue; } r -= I_IN;
        if (r < I_UQ) { p0_transpose_item(p.w_uq, QRANK, NQ, p.WuqT, scr, r, lane); continue; } r -= I_UQ;
        if (r < I_UKV) { p0_transpose_item(p.w_ukv, KVRANK, NKV, p.WukvT, scr, r, lane); continue; } r -= I_UKV;
        if (r < I_GLU) { p0_transpose_item(p.w_glu, S5W, S5W, p.WgluT, scr, r, lane); continue; } r -= I_GLU;
        if (r < I_OUT) { p0_transpose_item(p.w_out, DM, DM, p.WoutT, scr, r, lane); continue; } r -= I_OUT;
        if (r < I_FIN) { p0_transpose_item(p.ffn_w_in, DM, 2 * DFF, p.WfinT, scr, r, lane); continue; } r -= I_FIN;
        p0_transpose_item(p.ffn_w_down, DFF, DM, p.WdownT, scr, r, lane);
    }
    { GAS v4u* z = (GAS v4u*)(p.WinT + (size_t)INC * DM); const int n16 = (INCP - INC) * DM * 2 / 16; for (int i = gtid; i < n16; i += NGT) z[i] = (v4u){0u, 0u, 0u, 0u}; }
    for (int i = gtid; i < 2 * 64 * 64; i += NGT) {
        const int dg = i >> 6;
        const float lr = p.lam_re[i], li = p.lam_im[i], dt = expf(p.log_step[dg]);
        const float mag = expf(lr * dt); float sn, cs; sincosf(li * dt, &sn, &cs);
        const float ar = mag * cs, ai = mag * sn, den = lr * lr + li * li, nr = ar - 1.f, ni = ai;
        const float fr = (nr * lr + ni * li) / den, fi = (ni * lr - nr * li) / den;
        p.abar[2 * i] = ar; p.abar[2 * i + 1] = ai;
#pragma unroll
        for (int cc = 0; cc < 16; ++cc) { const float br = p.b_re[(size_t)i * 16 + cc], bi = p.b_im[(size_t)i * 16 + cc]; p.bbr[(size_t)i * 16 + cc] = fr * br - fi * bi; p.bbi[(size_t)i * 16 + cc] = fr * bi + fi * br; }
    }
    for (int i = gtid; i < SEQ * 32; i += NGT) {
        const int t = i >> 5, j = i & 31; const float pos = (float)((j < 16) ? (t >> 6) : (t & 63));
        const float inv = powf(10000.f, -(float)(j & 15) * (1.f / 16.f)); float sn, cs; sincosf(pos * inv, &sn, &cs);
        p.rope[2 * i] = cs; p.rope[2 * i + 1] = sn;
    }
}
__device__ __forceinline__ void phase_modreduce(const P& p, int gtid, int NGT) {
    for (int i = gtid; i < 5 * NMOD; i += NGT) { const int n = i % NMOD; float s = p.b_ada[n];
#pragma unroll
        for (int ks = 0; ks < 16; ++ks) s += p.part[(size_t)ks * 5 * NMOD + i];
        p.mod[i] = s; }
}
__device__ __forceinline__ void phase_norm1(const P& p, int gw, int NGW, int lane) {
    for (int row = gw; row < MALL; row += NGW) {
        const float* src = row < MX ? p.x + (size_t)row * DM : p.ctx + (size_t)(row - MX) * DM;
        const float* md = p.mod + (size_t)(row < MX ? row / SEQ : 4) * NMOD;
        const GAS f32x4* xr = (const GAS f32x4*)src + lane;
        f32x4 v[16]; float ss = 0.f;
#pragma unroll
        for (int j = 0; j < 16; ++j) { v[j] = xr[64 * j]; ss += (v[j].x * v[j].x + v[j].y * v[j].y) + (v[j].z * v[j].z + v[j].w * v[j].w); }
        const float rstd = rsqrtf(wave_sum(ss) * (1.f / DM) + EPS);
        GAS unsigned long long* o8 = (GAS unsigned long long*)(p.h + (size_t)row * DM) + lane;
#pragma unroll
        for (int j = 0; j < 16; ++j) { const f32x4 g = ((const GAS f32x4*)p.g_pre_mix)[lane + 64 * j], sh = ((const GAS f32x4*)md)[lane + 64 * j], sc = ((const GAS f32x4*)(md + DM))[lane + 64 * j];
            const f32x4 o = (v[j] * rstd) * g * (sc + 1.f) + sh;
            o8[64 * j] = (unsigned long long)pk2(o.x, o.y) | ((unsigned long long)pk2(o.z, o.w) << 32); }
    }
}
__device__ __forceinline__ void phase_postin(const P& p, int gw, int NGW, int lane) {
    for (int row = gw; row < MALL; row += NGW) {
        const bf16* pr = p.px + (size_t)row * INCP;
        { const v4u w = *(const GAS v4u*)(pr + 2048 + lane * 8);
          float v[8] = {bflo(w.x), bfhi(w.x), bflo(w.y), bfhi(w.y), bflo(w.z), bfhi(w.z), bflo(w.w), bfhi(w.w)}; float ss = 0.f;
#pragma unroll
          for (int j = 0; j < 8; ++j) ss += v[j] * v[j];
          const float rstd = rsqrtf(wave_sum(ss) * (1.f / KVRANK) + EPS);
          const f32x4 g0 = *(const GAS f32x4*)(p.g_kv + lane * 8), g1 = *(const GAS f32x4*)(p.g_kv + lane * 8 + 4);
          v4u o; o.x = pk2(v[0] * rstd * g0.x, v[1] * rstd * g0.y); o.y = pk2(v[2] * rstd * g0.z, v[3] * rstd * g0.w); o.z = pk2(v[4] * rstd * g1.x, v[5] * rstd * g1.y); o.w = pk2(v[6] * rstd * g1.z, v[7] * rstd * g1.w);
          *(GAS v4u*)(p.kvcn + (size_t)row * KVRANK + lane * 8) = o; }
        if (lane < 32) { const unsigned w = *(const GAS unsigned*)(pr + 2560 + lane * 2); float x1 = bflo(w), x2 = bfhi(w);
          if (row < MX) { const int t = row & (SEQ - 1); const float cs = p.rope[((size_t)t * 32 + lane) * 2], sn = p.rope[((size_t)t * 32 + lane) * 2 + 1]; const float a = x1 * cs - x2 * sn, b = x1 * sn + x2 * cs; x1 = a; x2 = b; }
          *(GAS unsigned*)(p.krope + (size_t)row * ROPED + lane * 2) = pk2(x1, x2); }
        if (row < MX) {
          const v4u w0 = *(const GAS v4u*)(pr + 1024 + lane * 8), w1 = *(const GAS v4u*)(pr + 1024 + 512 + lane * 8);
          float v[16] = {bflo(w0.x), bfhi(w0.x), bflo(w0.y), bfhi(w0.y), bflo(w0.z), bfhi(w0.z), bflo(w0.w), bfhi(w0.w), bflo(w1.x), bfhi(w1.x), bflo(w1.y), bfhi(w1.y), bflo(w1.z), bfhi(w1.z), bflo(w1.w), bfhi(w1.w)}; float ss = 0.f;
#pragma unroll
          for (int j = 0; j < 16; ++j) ss += v[j] * v[j];
          const float rstd = rsqrtf(wave_sum(ss) * (1.f / QRANK) + EPS);
#pragma unroll
          for (int hh = 0; hh < 2; ++hh) { const f32x4 g0 = *(const GAS f32x4*)(p.g_q + hh * 512 + lane * 8), g1 = *(const GAS f32x4*)(p.g_q + hh * 512 + lane * 8 + 4);
            v4u o; o.x = pk2(v[8 * hh + 0] * rstd * g0.x, v[8 * hh + 1] * rstd * g0.y); o.y = pk2(v[8 * hh + 2] * rstd * g0.z, v[8 * hh + 3] * rstd * g0.w);
            o.z = pk2(v[8 * hh + 4] * rstd * g1.x, v[8 * hh + 5] * rstd * g1.y); o.w = pk2(v[8 * hh + 6] * rstd * g1.z, v[8 * hh + 7] * rstd * g1.w);
            *(GAS v4u*)(p.qcn + (size_t)row * QRANK + hh * 512 + lane * 8) = o; }
        }
    }
}

__device__ __forceinline__ void phase_attn_v0(const P& p, LAS unsigned char* lds, int blk, int G) {
    constexpr int QS = 400, KS = 400, VS = 272, PS = 272;
    LAS unsigned char* Qs = lds; LAS unsigned char* Ks = lds + 128 * QS; LAS unsigned char* Vs = Ks + 64 * KS; LAS unsigned char* Ps = Vs + 64 * VS;
    const int tid = threadIdx.x, tq = tid >> 4, tk = tid & 15;
    for (int unit = blk; unit < NB * NH * (SEQ / 128); unit += G) {
        const int qt = unit % (SEQ / 128), bh = unit / (SEQ / 128), b = bh / NH, hd = bh % NH;
        const size_t qrow0 = (size_t)b * SEQ + qt * 128;
        __syncthreads();
        for (int c = tid; c < 128 * 24; c += 512) { const int r = c / 24, part = c % 24; *(LAS v4u*)(Qs + r * QS + part * 16) = *(const GAS v4u*)(p.q + (qrow0 + r) * NQ + hd * DQK + part * 8); }
        float m[4], l[4], o[4][8];
#pragma unroll
        for (int i = 0; i < 4; ++i) { m[i] = -INFINITY; l[i] = 0.f;
#pragma unroll
            for (int e = 0; e < 8; ++e) o[i][e] = 0.f; }
        for (int kt = 0; kt < NKT; ++kt) {
            __syncthreads();
            for (int c = tid; c < 64 * 24; c += 512) { const int kk = c / 24, part = c % 24; const int n = kt * 64 + kk; const size_t row = n < CTXL ? (size_t)MX + b * CTXL + n : (size_t)b * SEQ + (n - CTXL);
                const v4u w = part < 16 ? *(const GAS v4u*)(p.kv + row * NKV + hd * 256 + part * 8) : *(const GAS v4u*)(p.krope + row * ROPED + (part - 16) * 8);
                *(LAS v4u*)(Ks + kk * KS + part * 16) = w; }
            for (int c = tid; c < 64 * 16; c += 512) { const int kk = c / 16, part = c % 16; const int n = kt * 64 + kk; const size_t row = n < CTXL ? (size_t)MX + b * CTXL + n : (size_t)b * SEQ + (n - CTXL);
                *(LAS v4u*)(Vs + kk * VS + part * 16) = *(const GAS v4u*)(p.kv + row * NKV + hd * 256 + 128 + part * 8); }
            __syncthreads();
            float s[4][4];
#pragma unroll
            for (int i = 0; i < 4; ++i)
#pragma unroll
                for (int j = 0; j < 4; ++j) s[i][j] = 0.f;
            for (int d = 0; d < 24; ++d) {
                v4u qv[4], kv4[4];
#pragma unroll
                for (int i = 0; i < 4; ++i) { qv[i] = *(const LAS v4u*)(Qs + (4 * tq + i) * QS + d * 16); kv4[i] = *(const LAS v4u*)(Ks + (4 * tk + i) * KS + d * 16); }
#pragma unroll
                for (int i = 0; i < 4; ++i)
#pragma unroll
                    for (int j = 0; j < 4; ++j) {
                        s[i][j] += bflo(qv[i].x) * bflo(kv4[j].x) + bfhi(qv[i].x) * bfhi(kv4[j].x) + bflo(qv[i].y) * bflo(kv4[j].y) + bfhi(qv[i].y) * bfhi(kv4[j].y)
                                 + bflo(qv[i].z) * bflo(kv4[j].z) + bfhi(qv[i].z) * bfhi(kv4[j].z) + bflo(qv[i].w) * bflo(kv4[j].w) + bfhi(qv[i].w) * bfhi(kv4[j].w); }
            }
#pragma unroll
            for (int i = 0; i < 4; ++i) {
                float rm = fmaxf(fmaxf(s[i][0], s[i][1]), fmaxf(s[i][2], s[i][3]));
                rm = fmaxf(rm, __shfl_xor(rm, 1)); rm = fmaxf(rm, __shfl_xor(rm, 2)); rm = fmaxf(rm, __shfl_xor(rm, 4)); rm = fmaxf(rm, __shfl_xor(rm, 8));
                const float mn = fmaxf(m[i], rm), alpha = exp2f(m[i] - mn); m[i] = mn;
                float rs = 0.f;
#pragma unroll
                for (int j = 0; j < 4; ++j) { s[i][j] = exp2f(s[i][j] - mn); rs += s[i][j]; }
                rs += __shfl_xor(rs, 1); rs += __shfl_xor(rs, 2); rs += __shfl_xor(rs, 4); rs += __shfl_xor(rs, 8);
                l[i] = l[i] * alpha + rs;
#pragma unroll
                for (int e = 0; e < 8; ++e) o[i][e] *= alpha;
                *(LAS f32x4*)(Ps + (4 * tq + i) * PS + tk * 16) = (f32x4){s[i][0], s[i][1], s[i][2], s[i][3]};
            }
            __syncthreads();
            for (int j = 0; j < 64; ++j) {
                const v4u vv = *(const LAS v4u*)(Vs + j * VS + tk * 16);
                const float v8[8] = {bflo(vv.x), bfhi(vv.x), bflo(vv.y), bfhi(vv.y), bflo(vv.z), bfhi(vv.z), bflo(vv.w), bfhi(vv.w)};
#pragma unroll
                for (int i = 0; i < 4; ++i) { const float pj = *(const LAS float*)(Ps + (4 * tq + i) * PS + j * 4);
#pragma unroll
                    for (int e = 0; e < 8; ++e) o[i][e] += pj * v8[e]; }
            }
        }
#pragma unroll
        for (int i = 0; i < 4; ++i) { const float rl = 1.f / l[i];
            v4u w; w.x = pk2(o[i][0] * rl, o[i][1] * rl); w.y = pk2(o[i][2] * rl, o[i][3] * rl); w.z = pk2(o[i][4] * rl, o[i][5] * rl); w.w = pk2(o[i][6] * rl, o[i][7] * rl);
            *(GAS v4u*)(p.mixin + (qrow0 + 4 * tq + i) * DM + S5W + hd * DV + tk * 8) = w; }
    }
}

__device__ __forceinline__ void phase_s5_v0(const P& p, LAS unsigned char* lds, int blk, int G, int wave, int lane) {
    if (wave >= 2) return;
    LAS float* ul = (LAS float*)(lds + wave * 49152);
    LAS float* hbr = ul + 1024;
    LAS float* hbi = hbr + 64 * 65;
    LAS float* Cl = hbi + 64 * 65;
    for (int unit = blk + G * wave; unit < NB * 2 * 64; unit += 2 * G) {
        const int g = unit & 63, dir = (unit >> 6) & 1, b = unit >> 7;
        const int sidx = (dir * 64 + g) * 64 + lane;
        const float ar = p.abar[2 * sidx], ai = p.abar[2 * sidx + 1];
        float bbr[16], bbi[16];
#pragma unroll
        for (int cc = 0; cc < 16; ++cc) { bbr[cc] = p.bbr[(size_t)sidx * 16 + cc]; bbi[cc] = p.bbi[(size_t)sidx * 16 + cc]; }
        LDS_WAIT();
#pragma unroll
        for (int cc = 0; cc < 16; ++cc) { Cl[lane * 32 + cc] = p.c_re[((size_t)(dir * 64 + g) * 16 + cc) * 64 + lane]; Cl[lane * 32 + 16 + cc] = p.c_im[((size_t)(dir * 64 + g) * 16 + cc) * 64 + lane]; }
        float hr = 0.f, hi = 0.f;
        for (int k = 0; k < NKT; ++k) {
            { const int s = k * 64 + lane; size_t row;
              if (dir == 0) row = s < CTXL ? (size_t)MX + b * CTXL + s : (size_t)b * SEQ + (s - CTXL);
              else row = s < CTXL ? (size_t)MX + b * CTXL + (CTXL - 1 - s) : (size_t)b * SEQ + (SEQ - 1 - (s - CTXL));
              const v4u w0 = *(const GAS v4u*)(p.px + row * INCP + g * 16), w1 = *(const GAS v4u*)(p.px + row * INCP + g * 16 + 8);
              LDS_WAIT();
              *(LAS f32x4*)(ul + lane * 16) = (f32x4){bflo(w0.x), bfhi(w0.x), bflo(w0.y), bfhi(w0.y)}; *(LAS f32x4*)(ul + lane * 16 + 4) = (f32x4){bflo(w0.z), bfhi(w0.z), bflo(w0.w), bfhi(w0.w)};
              *(LAS f32x4*)(ul + lane * 16 + 8) = (f32x4){bflo(w1.x), bfhi(w1.x), bflo(w1.y), bfhi(w1.y)}; *(LAS f32x4*)(ul + lane * 16 + 12) = (f32x4){bflo(w1.z), bfhi(w1.z), bflo(w1.w), bfhi(w1.w)}; }
            LDS_WAIT();
#pragma unroll 4
            for (int j = 0; j < 64; ++j) {
                const f32x4 u0 = *(const LAS f32x4*)(ul + j * 16), u1 = *(const LAS f32x4*)(ul + j * 16 + 4), u2 = *(const LAS f32x4*)(ul + j * 16 + 8), u3 = *(const LAS f32x4*)(ul + j * 16 + 12);
                const float uu[16] = {u0.x, u0.y, u0.z, u0.w, u1.x, u1.y, u1.z, u1.w, u2.x, u2.y, u2.z, u2.w, u3.x, u3.y, u3.z, u3.w};
                float bur = 0.f, bui = 0.f;
#pragma unroll
                for (int cc = 0; cc < 16; ++cc) { bur += bbr[cc] * uu[cc]; bui += bbi[cc] * uu[cc]; }
                const float nhr = ar * hr - ai * hi + bur, nhi = ar * hi + ai * hr + bui; hr = nhr; hi = nhi;
                if (k >= CTXL / 64) { hbr[j * 65 + lane] = hr; hbi[j * 65 + lane] = hi; }
            }
            if (k >= CTXL / 64) {
                LDS_WAIT();
                float acc[16];
#pragma unroll
                for (int cc = 0; cc < 16; ++cc) acc[cc] = 0.f;
#pragma unroll 2
                for (int pp = 0; pp < 64; ++pp) {
                    const float xr = hbr[lane * 65 + pp], xi = hbi[lane * 65 + pp];
                    const f32x4 r0 = *(const LAS f32x4*)(Cl + pp * 32), r1 = *(const LAS f32x4*)(Cl + pp * 32 + 4), r2 = *(const LAS f32x4*)(Cl + pp * 32 + 8), r3 = *(const LAS f32x4*)(Cl + pp * 32 + 12);
                    const f32x4 i0 = *(const LAS f32x4*)(Cl + pp * 32 + 16), i1 = *(const LAS f32x4*)(Cl + pp * 32 + 20), i2 = *(const LAS f32x4*)(Cl + pp * 32 + 24), i3 = *(const LAS f32x4*)(Cl + pp * 32 + 28);
                    const float cr[16] = {r0.x, r0.y, r0.z, r0.w, r1.x, r1.y, r1.z, r1.w, r2.x, r2.y, r2.z, r2.w, r3.x, r3.y, r3.z, r3.w};
                    const float ci[16] = {i0.x, i0.y, i0.z, i0.w, i1.x, i1.y, i1.z, i1.w, i2.x, i2.y, i2.z, i2.w, i3.x, i3.y, i3.z, i3.w};
#pragma unroll
                    for (int cc = 0; cc < 16; ++cc) acc[cc] += cr[cc] * xr - ci[cc] * xi;
                }
                const int s = k * 64 + lane - CTXL; const int t = dir == 0 ? s : SEQ - 1 - s;
                GAS f32x4* yo = (GAS f32x4*)(p.ydir + ((size_t)dir * MX + (size_t)b * SEQ + t) * S5W + g * 16);
                yo[0] = (f32x4){acc[0], acc[1], acc[2], acc[3]}; yo[1] = (f32x4){acc[4], acc[5], acc[6], acc[7]}; yo[2] = (f32x4){acc[8], acc[9], acc[10], acc[11]}; yo[3] = (f32x4){acc[12], acc[13], acc[14], acc[15]};
            }
        }
    }
}
__device__ __forceinline__ void phase_s5gelu(const P& p, int gtid, int NGT) {
    for (int i = gtid; i < MX * (S5W / 8); i += NGT) {
        const int row = i >> 7, c0 = (i & 127) * 8;
        const v4u uw = *(const GAS v4u*)(p.px + (size_t)row * INCP + c0);
        const float u[8] = {bflo(uw.x), bfhi(uw.x), bflo(uw.y), bfhi(uw.y), bflo(uw.z), bfhi(uw.z), bflo(uw.w), bfhi(uw.w)};
        const f32x4 a0 = *(const GAS f32x4*)(p.ydir + (size_t)row * S5W + c0), a1 = *(const GAS f32x4*)(p.ydir + (size_t)row * S5W + c0 + 4);
        const f32x4 b0 = *(const GAS f32x4*)(p.ydir + ((size_t)MX + row) * S5W + c0), b1 = *(const GAS f32x4*)(p.ydir + ((size_t)MX + row) * S5W + c0 + 4);
        const f32x4 d0 = *(const GAS f32x4*)(p.s5d + c0), d1 = *(const GAS f32x4*)(p.s5d + c0 + 4);
        const float y[8] = {d0.x * u[0] + a0.x + b0.x, d0.y * u[1] + a0.y + b0.y, d0.z * u[2] + a0.z + b0.z, d0.w * u[3] + a0.w + b0.w, d1.x * u[4] + a1.x + b1.x, d1.y * u[5] + a1.y + b1.y, d1.z * u[6] + a1.z + b1.z, d1.w * u[7] + a1.w + b1.w};
        float gl[8];
#pragma unroll
        for (int j = 0; j < 8; ++j) { const float v = y[j]; gl[j] = 0.5f * v * (1.f + tanhf(0.7978845608028654f * (v + 0.044715f * v * v * v))); }
        v4u o; o.x = pk2(gl[0], gl[1]); o.y = pk2(gl[2], gl[3]); o.z = pk2(gl[4], gl[5]); o.w = pk2(gl[6], gl[7]);
        *(GAS v4u*)(p.yg + (size_t)row * S5W + c0) = o;
    }
}
__device__ __forceinline__ void phase_mid(const P& p, int gw, int NGW, int lane) {
    for (int row = gw; row < MX; row += NGW) {
        const float* md = p.mod + (size_t)(row / SEQ) * NMOD;
        const GAS f32x4* mr = (const GAS f32x4*)(p.mix + (size_t)row * DM) + lane; const GAS f32x4* xr = (const GAS f32x4*)(p.x + (size_t)row * DM) + lane;
        f32x4 v[16]; float ss = 0.f;
#pragma unroll
        for (int j = 0; j < 16; ++j) { v[j] = mr[64 * j]; ss += (v[j].x * v[j].x + v[j].y * v[j].y) + (v[j].z * v[j].z + v[j].w * v[j].w); }
        const float rstd = rsqrtf(wave_sum(ss) * (1.f / DM) + EPS); float s2 = 0.f;
        GAS f32x4* xo = (GAS f32x4*)(p.out + (size_t)row * DM) + lane;
#pragma unroll
        for (int j = 0; j < 16; ++j) { const f32x4 g = ((const GAS f32x4*)p.g_post_mix)[lane + 64 * j], ga = ((const GAS f32x4*)(md + 2 * DM))[lane + 64 * j];
            v[j] = xr[64 * j] + ga * ((v[j] * rstd) * g); xo[64 * j] = v[j]; s2 += (v[j].x * v[j].x + v[j].y * v[j].y) + (v[j].z * v[j].z + v[j].w * v[j].w); }
        const float rstd2 = rsqrtf(wave_sum(s2) * (1.f / DM) + EPS);
        GAS unsigned long long* o8 = (GAS unsigned long long*)(p.hx + (size_t)row * DM) + lane;
#pragma unroll
        for (int j = 0; j < 16; ++j) { const f32x4 g = ((const GAS f32x4*)p.g_pre_ffn)[lane + 64 * j], sh = ((const GAS f32x4*)(md + 3 * DM))[lane + 64 * j], sc = ((const GAS f32x4*)(md + 4 * DM))[lane + 64 * j];
            const f32x4 o = (v[j] * rstd2) * g * (sc + 1.f) + sh;
            o8[64 * j] = (unsigned long long)pk2(o.x, o.y) | ((unsigned long long)pk2(o.z, o.w) << 32); }
    }
}
__device__ __forceinline__ void phase_convact(const P& p, int gtid, int NGT) {
    constexpr int CB = DFF / 8;
    for (int it = gtid; it < (MX / 16) * CB; it += NGT) {
        const int cb = it % CB, rb = it / CB, c0 = cb * 8, r0 = rb * 16;
        float w0[8], w1[8], w2[8], bb[8];
#pragma unroll
        for (int j = 0; j < 8; ++j) { w0[j] = p.conv_w[c0 + j]; w1[j] = p.conv_w[DFF + c0 + j]; w2[j] = p.conv_w[2 * DFF + c0 + j]; bb[j] = p.conv_b[c0 + j]; }
        float gp[8], gc[8], gn[8];
        { const bool has = (r0 & (SEQ - 1)) != 0; v4u w = (v4u){0u, 0u, 0u, 0u}; if (has) w = *(const GAS v4u*)(p.gu + (size_t)(r0 - 1) * (2 * DFF) + c0);
          gp[0] = bflo(w.x); gp[1] = bfhi(w.x); gp[2] = bflo(w.y); gp[3] = bfhi(w.y); gp[4] = bflo(w.z); gp[5] = bfhi(w.z); gp[6] = bflo(w.w); gp[7] = bfhi(w.w); }
        { const v4u w = *(const GAS v4u*)(p.gu + (size_t)r0 * (2 * DFF) + c0);
          gc[0] = bflo(w.x); gc[1] = bfhi(w.x); gc[2] = bflo(w.y); gc[3] = bfhi(w.y); gc[4] = bflo(w.z); gc[5] = bfhi(w.z); gc[6] = bflo(w.w); gc[7] = bfhi(w.w); }
        for (int r = 0; r < 16; ++r) {
            const int row = r0 + r; const bool has = ((row + 1) & (SEQ - 1)) != 0; v4u w = (v4u){0u, 0u, 0u, 0u}; if (has) w = *(const GAS v4u*)(p.gu + (size_t)(row + 1) * (2 * DFF) + c0);
            gn[0] = bflo(w.x); gn[1] = bfhi(w.x); gn[2] = bflo(w.y); gn[3] = bfhi(w.y); gn[4] = bflo(w.z); gn[5] = bfhi(w.z); gn[6] = bflo(w.w); gn[7] = bfhi(w.w);
            const v4u uw = *(const GAS v4u*)(p.gu + (size_t)row * (2 * DFF) + DFF + c0);
            const float up[8] = {bflo(uw.x), bfhi(uw.x), bflo(uw.y), bfhi(uw.y), bflo(uw.z), bfhi(uw.z), bflo(uw.w), bfhi(uw.w)};
            float a[8];
#pragma unroll
            for (int j = 0; j < 8; ++j) { const float cv = w0[j] * gp[j] + w1[j] * gc[j] + w2[j] * gn[j] + bb[j]; a[j] = cv / (1.f + __expf(-cv)) * up[j]; gp[j] = gc[j]; gc[j] = gn[j]; }
            v4u o; o.x = pk2(a[0], a[1]); o.y = pk2(a[2], a[3]); o.z = pk2(a[4], a[5]); o.w = pk2(a[6], a[7]);
            *(GAS v4u*)(p.act + (size_t)row * DFF + c0) = o;
        }
    }
}
__device__ __forceinline__ void phase_final(const P& p, int gw, int NGW, int lane) {
    for (int row = gw; row < MX; row += NGW) {
        const float* md = p.mod + (size_t)(row / SEQ) * NMOD;
        const GAS f32x4* fr = (const GAS f32x4*)(p.f + (size_t)row * DM) + lane;
        f32x4 v[16]; float ss = 0.f;
#pragma unroll
        for (int j = 0; j < 16; ++j) { v[j] = fr[64 * j]; ss += (v[j].x * v[j].x + v[j].y * v[j].y) + (v[j].z * v[j].z + v[j].w * v[j].w); }
        const float rstd = rsqrtf(wave_sum(ss) * (1.f / DM) + EPS);
        GAS f32x4* xo = (GAS f32x4*)(p.out + (size_t)row * DM) + lane;
#pragma unroll
        for (int j = 0; j < 16; ++j) { const f32x4 g = ((const GAS f32x4*)p.g_post_ffn)[lane + 64 * j], ga = ((const GAS f32x4*)(md + 5 * DM))[lane + 64 * j];
            xo[64 * j] = xo[64 * j] + ga * ((v[j] * rstd) * g); }
    }
}

constexpr int N_PHASES = 16;
struct Args { const float* in[29]; float* out; unsigned char* ws; int ph_lo, ph_hi, li, pad; };
__global__ void __launch_bounds__(NWAVES * 64, 2) skel_fwd(Args args) {
    extern __shared__ __attribute__((aligned(16))) unsigned char lds_raw[];
    LAS unsigned char* lds = (LAS unsigned char*)lds_raw;
    volatile LAS unsigned* MISC = (volatile LAS unsigned*)(lds + MISC_OFF);
    const int tid = threadIdx.x, lane = tid & 63, wave = __builtin_amdgcn_readfirstlane(tid >> 6);
    const int G = gridDim.x, blk = blockIdx.x;
    const int vcu = (G % 8 == 0) ? (blk % 8) * (G / 8) + blk / 8 : blk;
    const int gw = vcu * NWAVES + wave, NGW = G * NWAVES, gtid = blk * (NWAVES * 64) + tid, NGT = G * NWAVES * 64;
    unsigned char* ws = args.ws;
    P p;
    p.x = args.in[0]; p.c = args.in[1]; p.ctx = args.in[2]; p.cctx = args.in[3]; p.w_ada = args.in[4]; p.b_ada = args.in[5];
    p.g_pre_mix = args.in[6]; p.g_post_mix = args.in[7]; p.g_pre_ffn = args.in[8]; p.g_post_ffn = args.in[9]; p.w_in = args.in[10];
    p.lam_re = args.in[11]; p.lam_im = args.in[12]; p.log_step = args.in[13]; p.b_re = args.in[14]; p.b_im = args.in[15]; p.c_re = args.in[16]; p.c_im = args.in[17];
    p.s5d = args.in[18]; p.w_glu = args.in[19]; p.g_q = args.in[20]; p.w_uq = args.in[21]; p.g_kv = args.in[22]; p.w_ukv = args.in[23]; p.w_out = args.in[24];
    p.ffn_w_in = args.in[25]; p.conv_w = args.in[26]; p.conv_b = args.in[27]; p.ffn_w_down = args.in[28];
    p.out = args.out;
    p.mod = (float*)(ws + WS_MOD); p.abar = (float*)(ws + WS_S5A); p.bbr = (float*)(ws + WS_S5BR); p.bbi = (float*)(ws + WS_S5BI); p.rope = (float*)(ws + WS_ROPE); p.part = (float*)(ws + WS_PART);
    p.mix = (float*)(ws + WS_MIX); p.f = (float*)(ws + WS_F); p.ydir = (float*)(ws + WS_YDIR);
    p.WinT = (bf16*)(ws + WS_WIN); p.WuqT = (bf16*)(ws + WS_WUQ); p.WukvT = (bf16*)(ws + WS_WUKV); p.WgluT = (bf16*)(ws + WS_WGLU); p.WoutT = (bf16*)(ws + WS_WOUT); p.WfinT = (bf16*)(ws + WS_WFIN); p.WdownT = (bf16*)(ws + WS_WDOWN);
    p.h = (bf16*)(ws + WS_H); p.px = (bf16*)(ws + WS_PX); p.qcn = (bf16*)(ws + WS_QCN); p.kvcn = (bf16*)(ws + WS_KVCN); p.krope = (bf16*)(ws + WS_KROPE); p.q = (bf16*)(ws + WS_Q); p.kv = (bf16*)(ws + WS_KV);
    p.mixin = (bf16*)(ws + WS_MIXIN); p.yg = (bf16*)(ws + WS_YG); p.hx = (bf16*)(ws + WS_HX); p.gu = (bf16*)(ws + WS_GU); p.act = (bf16*)(ws + WS_ACT);

    for (int u = tid; u < (LDS_BYTES - LDSCTL_OFF) / 4; u += NWAVES * 64) ((LAS unsigned*)(lds + LDSCTL_OFF))[u] = 0u;
    __syncthreads();
#if MK_ONE_LAUNCH
    XcdBarrier bar = xcd_barrier_post((unsigned*)(ws + WS_CTL) + CW_BAR, MISC + 8);
#define GRID_BAR() xcd_barrier(bar)
#else
    (void)MISC;
#define GRID_BAR() do { } while (0)
#endif
    const int lo = args.ph_lo, hi = args.ph_hi;
#define IN(k) (lo <= (k) && (k) < hi)
#define SEAM(k) do { if (IN(k) && IN((k) + 1)) GRID_BAR(); } while (0)
    typedef pg8::StaticOrder SO;

    if (IN(0)) { phase_prologue(p, lds, gw, NGW, wave, lane, gtid, NGT); } SEAM(0);
    if (IN(1)) { phase_modreduce(p, gtid, NGT); } SEAM(1);
    if (IN(2)) { phase_norm1(p, gw, NGW, lane); } SEAM(2);
    if (IN(3)) { pg8::Gemm g{p.h, p.WinT, MALL, INCP, DM}; SO S; S.init(MALL, INCP, G, blk); pg8::EpiBf16P E{p.px, INCP};
                 pg8::gemm_phase<pg8::EpiBf16P, SO, true, true>(lds, g, S, E); } SEAM(3);
    if (IN(4)) { phase_postin(p, gw, NGW, lane); } SEAM(4);
    if (IN(5)) { { pg8::Gemm g{p.qcn, p.WuqT, MX, NQ, QRANK}; SO S; S.init(MX, NQ, G, blk); pg8::EpiQ E{p.q, p.rope, QSCALE};
                   pg8::gemm_phase<pg8::EpiQ, SO, true, true>(lds, g, S, E); }
                 { pg8::Gemm g{p.kvcn, p.WukvT, MALL, NKV, KVRANK}; SO S; S.init(MALL, NKV, G, blk); pg8::EpiBf16P E{p.kv, NKV};
                   pg8::gemm_phase<pg8::EpiBf16P, SO, true, true>(lds, g, S, E); } } SEAM(5);
    if (IN(6)) { phase_attn_v0(p, lds, blk, G); } SEAM(6);
    if (IN(7)) { phase_s5_v0(p, lds, blk, G, wave, lane); } SEAM(7);
    if (IN(8)) { phase_s5gelu(p, gtid, NGT); } SEAM(8);
    if (IN(9)) { pg8::Gemm g{p.yg, p.WgluT, MX, S5W, S5W}; SO S; S.init(MX, S5W, G, blk); pg8::EpiGlu E{p.yg, p.mixin, DM};
                 pg8::gemm_phase<pg8::EpiGlu, SO, true, true>(lds, g, S, E); } SEAM(9);
    if (IN(10)) { pg8::Gemm g{p.mixin, p.WoutT, MX, DM, DM}; SO S; S.init(MX, DM, G, blk); pg8::EpiF32P E{p.mix, DM};
                  pg8::gemm_phase<pg8::EpiF32P, SO, true, true>(lds, g, S, E); } SEAM(10);
    if (IN(11)) { phase_mid(p, gw, NGW, lane); } SEAM(11);
    if (IN(12)) { pg8::Gemm g{p.hx, p.WfinT, MX, 2 * DFF, DM}; SO S; S.init(MX, 2 * DFF, G, blk); pg8::EpiBf16P E{p.gu, 2 * DFF};
                  pg8::gemm_phase<pg8::EpiBf16P, SO, true, true>(lds, g, S, E); } SEAM(12);
    if (IN(13)) { phase_convact(p, gtid, NGT); } SEAM(13);
    if (IN(14)) { pg8::Gemm g{p.act, p.WdownT, MX, DM, DFF}; SO S; S.init(MX, DM, G, blk); pg8::EpiF32P E{p.f, DM};
                  pg8::gemm_phase<pg8::EpiF32P, SO, true, true>(lds, g, S, E); } SEAM(14);
    if (IN(15)) { phase_final(p, gw, NGW, lane); }
#undef IN
#undef SEAM
}

extern "C" void kernel_launch(void* const* d_in, const int* in_sizes, int n_in, void* d_out, int out_size, void* d_ws, size_t ws_size, hipStream_t stream) {
    static int grid = 0;
    if (grid == 0) {
        if (n_in != 29 || out_size != MX * DM || ws_size < WS_END) { fprintf(stderr, "kernel_launch: unexpected shapes: n_in %d out %d ws %zu (need %zu)\n", n_in, out_size, ws_size, (size_t)WS_END); grid = -1; return; }
        int dev = 0, cus = 0;
        if (hipGetDevice(&dev) != hipSuccess || hipDeviceGetAttribute(&cus, hipDeviceAttributeMultiprocessorCount, dev) != hipSuccess) { grid = -1; return; }
        if (hipFuncSetAttribute((const void*)skel_fwd, hipFuncAttributeMaxDynamicSharedMemorySize, LDS_BYTES) != hipSuccess) { fprintf(stderr, "kernel_launch: hipFuncSetAttribute failed\n"); grid = -1; return; }
        int per_cu = 0;
        if (hipOccupancyMaxActiveBlocksPerMultiprocessor(&per_cu, (const void*)skel_fwd, NWAVES * 64, LDS_BYTES) != hipSuccess || per_cu < 1) fprintf(stderr, "kernel_launch: occupancy query says %d\n", per_cu);
        (void)hipGetLastError();
        grid = cus;
    }
    if (grid < 0) return;
    (void)hipMemsetAsync((char*)d_ws + WS_CTL, 0, CTL_ZERO_BYTES, stream);
    Args a{};
    for (int i = 0; i < 29; ++i) a.in[i] = (const float*)d_in[i];
    a.out = (float*)d_out; a.ws = (unsigned char*)d_ws;
#if MK_ONE_LAUNCH
    a.ph_lo = 0; a.ph_hi = N_PHASES; a.li = 0;
    hipLaunchKernelGGL(skel_fwd, dim3(grid), dim3(NWAVES * 64), LDS_BYTES, stream, a);
#else
    for (int ph = 0; ph < N_PHASES; ++ph) { a.ph_lo = ph; a.ph_hi = ph + 1; a.li = ph; hipLaunchKernelGGL(skel_fwd, dim3(grid), dim3(NWAVES * 64), LDS_BYTES, stream, a); }
#endif
    const hipError_t le = hipPeekAtLastError();
    if (le != hipSuccess) fprintf(stderr, "kernel_launch: launch failed: %s\n", hipGetErrorName(le));
}
```

```cpp
#include <hip/hip_runtime.h>
#include <cstdio>
#include <cstdint>
#include <cmath>

#ifndef MK_ONE_LAUNCH
#define MK_ONE_LAUNCH 1
#endif

namespace pg8 {
#define PG8_LAS __attribute__((address_space(3)))
typedef unsigned short bf16_t;
typedef short bf16x8 __attribute__((ext_vector_type(8)));
typedef float f32x4 __attribute__((ext_vector_type(4)));
typedef float f32x2 __attribute__((ext_vector_type(2)));
typedef unsigned u32x4 __attribute__((ext_vector_type(4)));
constexpr int BM = 256, BK = 64, HALF = 128, HTB = HALF * BK * 2  , STAGE_BYTES = 8 * HTB, NXCD = 8, WGM = 8;

__host__ __device__ __forceinline__ int lds_byte(int r, int c) { const int st = (r >> 4) * 2 + (c >> 5), rr = r & 15, cc = c & 31, ob = rr * 64 + cc * 2; return st * 1024 + (ob ^ (((ob >> 9) & 1) << 5)); }
__host__ __device__ __forceinline__ void stage_rc(int b, int& R, int& C) { const int st = b / 1024, sb = b % 1024, swz = sb ^ (((sb >> 9) & 1) << 5); R = (st >> 1) * 16 + swz / 64; C = (st & 1) * 32 + (swz % 64) / 2; }
__host__ __device__ __forceinline__ int perm32(int rho) { const int n = rho >> 4, i = rho & 15; return 8 * (i >> 2) + 4 * n + (i & 3); }

struct Unit { int pm, pn; };
struct Gemm { const bf16_t* A; const bf16_t* Bt; int M, N, K; };

struct StaticOrder {
    int nM, nN, nwg, G, c;
    __host__ __device__ void init(int M, int N, int G_, int c_) { nM = M / BM; nN = N / BM; nwg = nM * nN; G = G_; c = c_; }
    __host__ __device__ bool next(int i, Unit& u) const {
        const long L = (long)i * G + c; if (L >= nwg) return false;
        int wgid = (int)L; { const int q = nwg / NXCD, r = nwg % NXCD, xcd = wgid % NXCD, off = wgid / NXCD; wgid = (xcd < r ? xcd * (q + 1) : r * (q + 1) + (xcd - r) * q) + off; }
        const int nig = WGM * nN, gid = wgid / nig, fm = gid * WGM, gsz = (nM - fm) < WGM ? (nM - fm) : WGM;
        u.pm = fm + ((wgid % nig) % gsz); u.pn = (wgid % nig) / gsz; return true;
    }
    __device__ __forceinline__ void a_ready(const Unit&) const {}
    __device__ __forceinline__ void done(const Unit&) const {}
};

__device__ __forceinline__ unsigned cvt_pk_bf16(float lo, float hi) { unsigned r; asm volatile("v_cvt_pk_bf16_f32 %0, %1, %2" : "=v"(r) : "v"(lo), "v"(hi)); return r; }
__device__ __forceinline__ float bf_lo(unsigned w) { return __uint_as_float(w << 16); }
__device__ __forceinline__ float bf_hi(unsigned w) { return __uint_as_float(w & 0xffff0000u); }

struct EpiBf16P {
    static constexpr bool PERM = true, AFTER_DRAIN = false;
    bf16_t* O; int ldc;
    __device__ __forceinline__ void operator()(const f32x4 (&acc)[2][2][4][2], const Unit& u, int wr, int wc, int fr, int fq) const {
        const int row0 = u.pm * BM + wr * 64 + fr, col0 = u.pn * BM + wc * 32 + 8 * fq;
#pragma unroll
        for (int ai = 0; ai < 2; ++ai)
#pragma unroll
            for (int m = 0; m < 4; ++m) { bf16_t* rowp = O + (size_t)(row0 + ai * HALF + m * 16) * ldc + col0;
#pragma unroll
                for (int bj = 0; bj < 2; ++bj) { const f32x4 v0 = acc[ai][bj][m][0], v1 = acc[ai][bj][m][1];
                    u32x4 w; w.x = cvt_pk_bf16(v0[0], v0[1]); w.y = cvt_pk_bf16(v0[2], v0[3]); w.z = cvt_pk_bf16(v1[0], v1[1]); w.w = cvt_pk_bf16(v1[2], v1[3]);
                    *(u32x4*)(rowp + bj * HALF) = w; } }
    }
};
struct EpiF32P {
    static constexpr bool PERM = false, AFTER_DRAIN = false;
    float* C; int ldc;
    __device__ __forceinline__ void operator()(const f32x4 (&acc)[2][2][4][2], const Unit& u, int wr, int wc, int fr, int fq) const {
        const int row0 = u.pm * BM + wr * 64 + fr, col0 = u.pn * BM + wc * 32 + 4 * fq;
#pragma unroll
        for (int ai = 0; ai < 2; ++ai)
#pragma unroll
            for (int m = 0; m < 4; ++m) { float* rowp = C + (size_t)(row0 + ai * HALF + m * 16) * ldc + col0;
#pragma unroll
                for (int bj = 0; bj < 2; ++bj)
#pragma unroll
                    for (int n = 0; n < 2; ++n) *(f32x4*)(rowp + bj * HALF + n * 16) = acc[ai][bj][m][n]; }
    }
};
struct EpiQ {
    static constexpr bool PERM = true, AFTER_DRAIN = false;
    bf16_t* O; const float* rope; float scale;
    __device__ __forceinline__ void operator()(const f32x4 (&acc)[2][2][4][2], const Unit& u, int wr, int wc, int fr, int fq) const {
        const int row0 = u.pm * BM + wr * 64 + fr, col0 = u.pn * BM + wc * 32 + 8 * fq;
#pragma unroll
        for (int ai = 0; ai < 2; ++ai)
#pragma unroll
            for (int m = 0; m < 4; ++m) { const int row = row0 + ai * HALF + m * 16; const int t = row & 4095; bf16_t* rowp = O + (size_t)row * 4608 + col0;
#pragma unroll
                for (int bj = 0; bj < 2; ++bj) { f32x4 v0 = acc[ai][bj][m][0] * scale, v1 = acc[ai][bj][m][1] * scale;
                    const int col = col0 + bj * HALF; const int within = col % 192;
                    if (within >= 128) { const float* cs = rope + ((size_t)t * 32 + ((within - 128) >> 1)) * 2; const f32x4 c01 = *(const f32x4*)cs, c23 = *(const f32x4*)(cs + 4);
                        const float a0 = v0[0], a1 = v0[1], a2 = v0[2], a3 = v0[3], b0 = v1[0], b1 = v1[1], b2 = v1[2], b3 = v1[3];
                        v0[0] = a0 * c01[0] - a1 * c01[1]; v0[1] = a0 * c01[1] + a1 * c01[0]; v0[2] = a2 * c01[2] - a3 * c01[3]; v0[3] = a2 * c01[3] + a3 * c01[2];
                        v1[0] = b0 * c23[0] - b1 * c23[1]; v1[1] = b0 * c23[1] + b1 * c23[0]; v1[2] = b2 * c23[2] - b3 * c23[3]; v1[3] = b2 * c23[3] + b3 * c23[2]; }
                    u32x4 w; w.x = cvt_pk_bf16(v0[0], v0[1]); w.y = cvt_pk_bf16(v0[2], v0[3]); w.z = cvt_pk_bf16(v1[0], v1[1]); w.w = cvt_pk_bf16(v1[2], v1[3]);
                    *(u32x4*)(rowp + bj * HALF) = w; } }
    }
};
struct EpiGlu {
    static constexpr bool PERM = true, AFTER_DRAIN = false;
    const bf16_t* YG; bf16_t* O; int ldo;
    __device__ __forceinline__ void operator()(const f32x4 (&acc)[2][2][4][2], const Unit& u, int wr, int wc, int fr, int fq) const {
        const int row0 = u.pm * BM + wr * 64 + fr, col0 = u.pn * BM + wc * 32 + 8 * fq;
#pragma unroll
        for (int ai = 0; ai < 2; ++ai)
#pragma unroll
            for (int m = 0; m < 4; ++m) { const int row = row0 + ai * HALF + m * 16;
#pragma unroll
                for (int bj = 0; bj < 2; ++bj) { const int col = col0 + bj * HALF; const u32x4 y = *(const u32x4*)(YG + (size_t)row * 1024 + col);
                    const f32x4 v0 = acc[ai][bj][m][0], v1 = acc[ai][bj][m][1];
                    float o[8]; const float yv[8] = {bf_lo(y.x), bf_hi(y.x), bf_lo(y.y), bf_hi(y.y), bf_lo(y.z), bf_hi(y.z), bf_lo(y.w), bf_hi(y.w)};
#pragma unroll
                    for (int j = 0; j < 4; ++j) { o[j] = yv[j] / (1.f + __expf(-v0[j])); o[4 + j] = yv[4 + j] / (1.f + __expf(-v1[j])); }
                    u32x4 w; w.x = cvt_pk_bf16(o[0], o[1]); w.y = cvt_pk_bf16(o[2], o[3]); w.z = cvt_pk_bf16(o[4], o[5]); w.w = cvt_pk_bf16(o[6], o[7]);
                    *(u32x4*)(O + (size_t)row * ldo + col) = w; } }
    }
};

template <class Epi, class Sched, bool ALIGN_EPI = false, bool SP2 = false>
__device__ __forceinline__ void gemm_phase(PG8_LAS unsigned char* lds, const Gemm g, const Sched& S, const Epi& E) {
    const int tid = threadIdx.x, wid = __builtin_amdgcn_readfirstlane(tid >> 6), lane = tid & 63, wr = wid >> 2, wc = wid & 3, fr = lane & 15, fq = lane >> 4;
    const int K = g.K, nt = K / BK;
    unsigned voffA[2], voffB[2];
#pragma unroll
    for (int i = 0; i < 2; ++i) { int R, C; stage_rc(tid * 16 + i * 8192, R, C); const int Rb = Epi::PERM ? ((R & ~31) + perm32(R & 31)) : R;
        voffA[i] = (unsigned)(R * K + C) * 2u; voffB[i] = (unsigned)(Rb * K + C) * 2u; }
    const size_t kstep = (size_t)(BK * 2);
    const size_t hstep = (size_t)HALF * K * 2;
    const size_t tstep = 2 * hstep;
    const unsigned ldsw = (unsigned)wid * 1024u;
    const int aoff = lds_byte(wr * 64 + fr, fq * 8), boff = lds_byte(wc * 32 + fr, fq * 8);
#define PG8_SA(b, h) (((b) * 2 + (h)) * HTB)
#define PG8_SB(b, h) ((4 + (b) * 2 + (h)) * HTB)
#define PG8_STAGE(bufoff, gbase, voff) do { _Pragma("unroll") for (int _i = 0; _i < 2; ++_i) \
        __builtin_amdgcn_global_load_lds((const unsigned*)((const char*)(gbase) + (voff)[_i]), (PG8_LAS unsigned*)(lds + (bufoff) + ldsw + _i * 8192), 16, 0, 0); } while (0)
#define PG8_LDA(dst, b, h) do { _Pragma("unroll") for (int m = 0; m < 4; ++m) _Pragma("unroll") for (int k = 0; k < 2; ++k) dst[m][k] = *(const PG8_LAS bf16x8*)(lds + PG8_SA(b, h) + aoff + m * 2048 + k * 1024); } while (0)
#define PG8_LDB(dst, b, h) do { _Pragma("unroll") for (int n = 0; n < 2; ++n) _Pragma("unroll") for (int k = 0; k < 2; ++k) dst[n][k] = *(const PG8_LAS bf16x8*)(lds + PG8_SB(b, h) + boff + n * 2048 + k * 1024); } while (0)
#define PG8_MMA(ai, bj, At, Bt) do { __builtin_amdgcn_s_setprio(1); _Pragma("unroll") for (int m = 0; m < 4; ++m) _Pragma("unroll") for (int n = 0; n < 2; ++n) _Pragma("unroll") for (int k = 0; k < 2; ++k) \
        acc[ai][bj][m][n] = __builtin_amdgcn_mfma_f32_16x16x32_bf16(Bt[n][k], At[m][k], acc[ai][bj][m][n], 0, 0, 0); __builtin_amdgcn_s_setprio(0); } while (0)
#define PG8_WAIT_V(n) asm volatile("s_waitcnt vmcnt(" #n ")" ::: "memory")
#define PG8_WAIT_L(n) asm volatile("s_waitcnt lgkmcnt(" #n ")" ::: "memory")
#define PG8_BAR __builtin_amdgcn_s_barrier()
#define PG8_SCHED __builtin_amdgcn_sched_barrier(0)
    Unit cur, nxt; int ui = 0;
    if (!S.next(0, cur)) return;
    f32x4 acc[2][2][4][2];
#pragma unroll
    for (int a = 0; a < 2; ++a)
#pragma unroll
        for (int b = 0; b < 2; ++b)
#pragma unroll
            for (int m = 0; m < 4; ++m)
#pragma unroll
                for (int n = 0; n < 2; ++n) acc[a][b][m][n] = (f32x4){0.f, 0.f, 0.f, 0.f};
    bf16x8 At[4][2], B0[2][2], B1[2][2];
    const char* cA = (const char*)g.A + (size_t)cur.pm * tstep; const char* cB = (const char*)g.Bt + (size_t)cur.pn * tstep;
    S.a_ready(cur);
    if constexpr (SP2) {
        PG8_STAGE(PG8_SB(0, 0), cB, voffB); PG8_STAGE(PG8_SB(0, 1), cB + hstep, voffB); PG8_STAGE(PG8_SA(0, 0), cA, voffA); PG8_STAGE(PG8_SA(0, 1), cA + hstep, voffA);
        if (wr == 1) PG8_BAR;
        PG8_WAIT_V(2); PG8_BAR;
        PG8_STAGE(PG8_SB(1, 0), cB + kstep, voffB); PG8_STAGE(PG8_SA(1, 0), cA + kstep, voffA); PG8_STAGE(PG8_SB(1, 1), cB + hstep + kstep, voffB);
        PG8_WAIT_V(6); PG8_BAR;
    } else {
        PG8_STAGE(PG8_SB(0, 0), cB, voffB); PG8_STAGE(PG8_SA(0, 0), cA, voffA); PG8_STAGE(PG8_SB(0, 1), cB + hstep, voffB); PG8_STAGE(PG8_SA(0, 1), cA + hstep, voffA);
        if (wr == 1) PG8_BAR;
        PG8_WAIT_V(4); PG8_BAR;
        PG8_STAGE(PG8_SB(1, 0), cB + kstep, voffB); PG8_STAGE(PG8_SA(1, 0), cA + kstep, voffA); PG8_STAGE(PG8_SB(1, 1), cB + hstep + kstep, voffB);
        PG8_WAIT_V(6); PG8_BAR;
    }
    for (;;) {
        const bool has_next = S.next(ui + 1, nxt);
        const char* nA = has_next ? (const char*)g.A + (size_t)nxt.pm * tstep : cA; const char* nB = has_next ? (const char*)g.Bt + (size_t)nxt.pn * tstep : cB;
        for (int t = 0; t < nt; t += 2) {
            const bool last = (t == nt - 2);
            const char* a1 = cA + (size_t)(t + 1) * kstep;
            const char* a2 = last ? nA : cA + (size_t)(t + 2) * kstep; const char* b2 = last ? nB : cB + (size_t)(t + 2) * kstep;
            const char* a3 = a2 + kstep; const char* b3 = b2 + kstep;
            if (last && has_next) S.a_ready(nxt);
            if constexpr (SP2) {
            PG8_LDB(B0, 0, 0); PG8_LDB(B1, 0, 1); PG8_SCHED; PG8_LDA(At, 0, 0); PG8_STAGE(PG8_SA(1, 1), a1 + hstep, voffA);
            PG8_WAIT_V(8); PG8_WAIT_L(0); PG8_BAR; PG8_MMA(0, 0, At, B0); PG8_MMA(0, 1, At, B1); PG8_BAR; PG8_SCHED;
            PG8_LDA(At, 0, 1); PG8_STAGE(PG8_SB(0, 0), b2, voffB); PG8_STAGE(PG8_SB(0, 1), b2 + hstep, voffB); PG8_STAGE(PG8_SA(0, 0), a2, voffA);
            PG8_WAIT_V(8); PG8_WAIT_L(0); PG8_BAR; PG8_MMA(1, 0, At, B0); PG8_MMA(1, 1, At, B1); PG8_BAR; PG8_SCHED;
            PG8_LDB(B0, 1, 0); PG8_LDB(B1, 1, 1); PG8_SCHED; PG8_LDA(At, 1, 0); PG8_STAGE(PG8_SA(0, 1), a2 + hstep, voffA);
            PG8_WAIT_V(8); PG8_WAIT_L(0); PG8_BAR; PG8_MMA(0, 0, At, B0); PG8_MMA(0, 1, At, B1); PG8_BAR; PG8_SCHED;
            PG8_LDA(At, 1, 1); PG8_STAGE(PG8_SB(1, 0), b3, voffB); PG8_STAGE(PG8_SB(1, 1), b3 + hstep, voffB); PG8_STAGE(PG8_SA(1, 0), a3, voffA);
            PG8_WAIT_V(8); PG8_WAIT_L(0); PG8_BAR; PG8_MMA(1, 0, At, B0); PG8_MMA(1, 1, At, B1); PG8_BAR; PG8_SCHED;
            } else {
            PG8_LDB(B0, 0, 0); PG8_SCHED; PG8_LDA(At, 0, 0); PG8_STAGE(PG8_SA(1, 1), a1 + hstep, voffA);
            PG8_WAIT_L(8); PG8_BAR; PG8_WAIT_L(0); PG8_MMA(0, 0, At, B0); PG8_BAR; PG8_SCHED;
            PG8_LDB(B1, 0, 1); PG8_STAGE(PG8_SB(0, 0), b2, voffB);
            PG8_BAR; PG8_WAIT_L(0); PG8_MMA(0, 1, At, B1); PG8_BAR;
            PG8_LDA(At, 0, 1); PG8_STAGE(PG8_SA(0, 0), a2, voffA);
            PG8_BAR; PG8_WAIT_L(0); PG8_MMA(1, 0, At, B0); PG8_BAR; PG8_SCHED;
            PG8_STAGE(PG8_SB(0, 1), b2 + hstep, voffB);
            PG8_WAIT_V(6); PG8_BAR; PG8_MMA(1, 1, At, B1); PG8_BAR;
            PG8_LDB(B0, 1, 0); PG8_SCHED; PG8_LDA(At, 1, 0); PG8_STAGE(PG8_SA(0, 1), a2 + hstep, voffA);
            PG8_WAIT_L(8); PG8_BAR; PG8_WAIT_L(0); PG8_MMA(0, 0, At, B0); PG8_BAR; PG8_SCHED;
            PG8_LDB(B1, 1, 1); PG8_STAGE(PG8_SB(1, 0), b3, voffB);
            PG8_BAR; PG8_WAIT_L(0); PG8_MMA(0, 1, At, B1); PG8_BAR;
            PG8_LDA(At, 1, 1); PG8_STAGE(PG8_SA(1, 0), a3, voffA);
            PG8_BAR; PG8_WAIT_L(0); PG8_MMA(1, 0, At, B0); PG8_BAR; PG8_SCHED;
            PG8_STAGE(PG8_SB(1, 1), b3 + hstep, voffB);
            PG8_WAIT_V(6); PG8_BAR; PG8_MMA(1, 1, At, B1); PG8_BAR;
            }
        }
        if constexpr (ALIGN_EPI) { if (wr == 0) PG8_BAR; }
        if constexpr (!Epi::AFTER_DRAIN) { E(acc, cur, wr, wc, fr, fq); S.done(cur); }
        if (!has_next) break;
#pragma unroll
        for (int a = 0; a < 2; ++a)
#pragma unroll
            for (int b = 0; b < 2; ++b)
#pragma unroll
                for (int m = 0; m < 4; ++m)
#pragma unroll
                    for (int n = 0; n < 2; ++n) acc[a][b][m][n] = (f32x4){0.f, 0.f, 0.f, 0.f};
        cur = nxt; cA = nA; cB = nB; ++ui;
        if constexpr (ALIGN_EPI) { if (wr == 1) PG8_BAR; }
    }
    PG8_WAIT_V(0);
    if constexpr (!ALIGN_EPI) { if (wr == 0) PG8_BAR; }
    PG8_BAR;
    if constexpr (Epi::AFTER_DRAIN) { E.fused(acc, cur, wr, wc, fr, fq, lds, wid, lane); S.done(cur); }
#undef PG8_SA
#undef PG8_SB
#undef PG8_STAGE
#undef PG8_LDA
#undef PG8_LDB
#undef PG8_MMA
#undef PG8_WAIT_V
#undef PG8_WAIT_L
#undef PG8_BAR
#undef PG8_SCHED
}
}

constexpr int DM = 4096, NB = 4, SEQ = 4096, CTXL = 256;
constexpr int MX = NB * SEQ, MC = NB * CTXL, MALL = MX + MC;
constexpr int S5W = 1024, QRANK = 1024, KVRANK = 512, ROPED = 64;
constexpr int INC = 2624, INCP = 2816;
constexpr int NH = 24, DQK = 192, DNOPE = 128, DV = 128;
constexpr int NQ = NH * DQK, NKV = NH * (DNOPE + DV);
constexpr int DFF = 11008, NMOD = 6 * DM;
constexpr float EPS = 1e-6f;
constexpr float QSCALE = 0.07216878364870322f * 1.4426950408889634f;
constexpr int NKT = (CTXL + SEQ) / 64;

constexpr size_t MiB = 1u << 20;
constexpr size_t WS_CTL = 0, CTL_ZERO_BYTES = 1 * MiB;
constexpr size_t WS_MOD = 1 * MiB;
constexpr size_t WS_S5A = 2 * MiB;
constexpr size_t WS_S5BR = 2 * MiB + 65536;
constexpr size_t WS_S5BI = WS_S5BR + 524288;
constexpr size_t WS_ROPE = 4 * MiB;
constexpr size_t WS_PART = 5 * MiB;
constexpr size_t WS_WIN = 16 * MiB, WS_WUQ = 38 * MiB, WS_WUKV = 47 * MiB, WS_WGLU = 53 * MiB, WS_WOUT = 55 * MiB, WS_WFIN = 87 * MiB, WS_WDOWN = 259 * MiB;
constexpr size_t WS_R1 = 345 * MiB, WS_R2 = 1033 * MiB, WS_END = 1377 * MiB;
constexpr size_t WS_H = WS_R1, WS_PX = WS_R1 + 136 * MiB, WS_QCN = WS_R1 + 230 * MiB, WS_KVCN = WS_R1 + 262 * MiB, WS_KROPE = WS_R1 + 279 * MiB, WS_Q = WS_R1 + 282 * MiB, WS_KV = WS_R1 + 426 * MiB;
constexpr size_t WS_MIX = WS_R1, WS_GU = WS_R1, WS_F = WS_R1;
constexpr size_t WS_MIXIN = WS_R2, WS_YG = WS_R2 + 128 * MiB, WS_YDIR = WS_R2 + 160 * MiB, WS_HX = WS_R2, WS_ACT = WS_R2;
static_assert(WS_KV + (size_t)MALL * NKV * 2 <= WS_R2 && WS_YDIR + (size_t)2 * MX * S5W * 4 <= WS_END && WS_GU + (size_t)MX * 2 * DFF * 2 <= WS_R2 && WS_ACT + (size_t)MX * DFF * 2 <= WS_END, "ws map");
static_assert(WS_WIN + (size_t)INCP * DM * 2 <= WS_WUQ && WS_WFIN + (size_t)2 * DFF * DM * 2 <= WS_WDOWN && WS_WDOWN + (size_t)DM * DFF * 2 <= WS_R1 && WS_PART + (size_t)16 * 5 * NMOD * 4 <= WS_WIN, "ws map (weights)");
constexpr int CW_BAR = 4096;

constexpr int RING_BYTES = 131072;
constexpr int LDSCTL_OFF = RING_BYTES, MISC_OFF = LDSCTL_OFF + 320;
constexpr int LDS_BYTES = 147456;
constexpr int NWAVES = 8;

#define GAS __attribute__((address_space(1)))
#define LAS __attribute__((address_space(3)))
typedef unsigned short bf16;
typedef unsigned v4u __attribute__((ext_vector_type(4)));
typedef unsigned v2u __attribute__((ext_vector_type(2)));
typedef float f32x4 __attribute__((ext_vector_type(4)));
#define LDS_WAIT() asm volatile("s_waitcnt lgkmcnt(0)" ::: "memory")
__device__ __forceinline__ unsigned f2bf(float f) { unsigned u = __builtin_bit_cast(unsigned, f); return (u + 0x7fffu + ((u >> 16) & 1u)) >> 16; }
__device__ __forceinline__ unsigned pk2(float lo, float hi) { return f2bf(lo) | (f2bf(hi) << 16); }
__device__ __forceinline__ float bflo(unsigned w) { return __uint_as_float(w << 16); }
__device__ __forceinline__ float bfhi(unsigned w) { return __uint_as_float(w & 0xffff0000u); }
__device__ __forceinline__ float wave_sum(float v) {
#pragma unroll
    for (int o = 1; o < 64; o <<= 1) v += __shfl_xor(v, o);
    return v;
}

#define XB_TMO      128
#define XB_XCNT(j)  (256  + 64 * (j))
#define XB_XSUB(j)  (1280 + 64 * (j))
#define XB_XGEN(j)  (2304 + 64 * (j))
#define XB_TOP      3328
#define XB_TOPGEN   3392
#define XCD_BAR_WORDS 3456
#define XB_SPIN_CAP (1u << 18)

__device__ __forceinline__ unsigned xb_ld(unsigned* p)              { return __hip_atomic_load(p, __ATOMIC_RELAXED, __HIP_MEMORY_SCOPE_AGENT); }
__device__ __forceinline__ unsigned xb_add(unsigned* p, unsigned v) { return __hip_atomic_fetch_add(p, v, __ATOMIC_RELAXED, __HIP_MEMORY_SCOPE_AGENT); }
__device__ __forceinline__ unsigned xb_xcc_id() { return (unsigned)__builtin_amdgcn_s_getreg((3 << 11) | 20) & 0xFu; }
#define XB_SPIN(cond, bar) do { unsigned _sp = 0; while (cond) { __builtin_amdgcn_s_sleep(1); \
    if ((++_sp & 255u) == 0u) { if (xb_ld(&(bar)[XB_TMO])) break; if (_sp > XB_SPIN_CAP) { atomicAdd(&(bar)[XB_TMO], 1u); break; } } } } while (0)

struct XcdBarrier {
    unsigned* bar; unsigned x;
    volatile LAS unsigned* st;
};

__device__ __forceinline__ XcdBarrier xcd_barrier_post(unsigned* bar, volatile LAS unsigned* st) {
    XcdBarrier b; b.bar = bar; b.x = xb_xcc_id(); b.st = st;
    if (threadIdx.x == 0) (void)xb_add(&bar[XB_XCNT(b.x)], 1u);
    return b;
}
__device__ __forceinline__ void xcd_barrier_complete(unsigned* bar, unsigned x, unsigned& nloc, unsigned& nx) {
    const unsigned G = gridDim.x * gridDim.y * gridDim.z;
    unsigned sum, cnt, mine, sp = 0u;
    for (;;) {
        sum = 0u; cnt = 0u; mine = 0u;
#pragma unroll
        for (unsigned j = 0; j < 16; ++j) { const unsigned c = xb_ld(&bar[XB_XCNT(j)]); sum += c; cnt += (c > 0u) ? 1u : 0u; mine = (j == x) ? c : mine; }
        if (sum == G) break;
        __builtin_amdgcn_s_sleep(1);
        if ((++sp & 255u) == 0u) { if (xb_ld(&bar[XB_TMO])) break; if (sp > XB_SPIN_CAP) { atomicAdd(&bar[XB_TMO], 1u); break; } }
    }
    nloc = mine > 0u ? mine : 1u; nx = cnt > 0u ? cnt : 1u;
}

__device__ __forceinline__ void xcd_barrier(const XcdBarrier& b) {
    asm volatile("s_waitcnt vmcnt(0)" ::: "memory");
    __syncthreads();
    if (threadIdx.x == 0) {
        unsigned* bar = b.bar;
        __builtin_amdgcn_s_waitcnt(0);
        unsigned nloc = b.st[0], nx = b.st[1];
        if (nloc == 0u) { xcd_barrier_complete(bar, b.x, nloc, nx); b.st[0] = nloc; b.st[1] = nx; }
        const unsigned old = xb_add(&bar[XB_XSUB(b.x)], 1u);
        const unsigned gen = old / nloc;
        if (old + 1u == (gen + 1u) * nloc) {
            __builtin_amdgcn_fence(__ATOMIC_RELEASE, "agent");
            asm volatile("s_waitcnt vmcnt(0)" ::: "memory");
            const unsigned og = xb_add(&bar[XB_TOP], 1u);
            const unsigned tg = og / nx;
            if (og + 1u == (tg + 1u) * nx) xb_add(&bar[XB_TOPGEN], 1u);
            else XB_SPIN(xb_ld(&bar[XB_TOPGEN]) == tg, bar);
            __builtin_amdgcn_fence(__ATOMIC_ACQUIRE, "agent");
            xb_add(&bar[XB_XGEN(b.x)], 1u);
            asm volatile("s_waitcnt vmcnt(0)" ::: "memory");
        } else {
            XB_SPIN(xb_ld(&bar[XB_XGEN(b.x)]) == gen, bar);
            __builtin_amdgcn_fence(__ATOMIC_ACQUIRE, "agent");
            asm volatile("s_waitcnt vmcnt(0)" ::: "memory");
        }
    }
    __syncthreads();
}

__device__ __forceinline__ void p0_transpose_item(const float* W, int K, int N, bf16* WT, LAS float* scr, int item, int lane) {
    const int nblk = N / 32, kb = item / nblk, nb = item % nblk, k0 = 64 * kb, n0 = 32 * nb;
#pragma unroll 8
    for (int i = 0; i < 32; ++i) { const int kk = 2 * i + (lane >> 5); scr[kk * 33 + (lane & 31)] = W[(size_t)(k0 + kk) * N + n0 + (lane & 31)]; }
    LDS_WAIT(); asm volatile("" ::: "memory");
    const int c = lane & 7;
#pragma unroll
    for (int j = 0; j < 4; ++j) { const int n = (lane >> 3) + 8 * j; const LAS float* s = scr + (8 * c) * 33 + n;
        v4u o; o.x = pk2(s[0 * 33], s[1 * 33]); o.y = pk2(s[2 * 33], s[3 * 33]); o.z = pk2(s[4 * 33], s[5 * 33]); o.w = pk2(s[6 * 33], s[7 * 33]);
        *(GAS v4u*)(WT + (size_t)(n0 + n) * K + k0 + 8 * c) = o; }
    LDS_WAIT(); asm volatile("" ::: "memory");
}
__device__ __forceinline__ void p0_ada_item(const float* c, const float* cctx, const float* w_ada, float* part, int item, int lane) {
    const int nb = item % 96, ks = item / 96, n0 = nb * 256 + lane * 4, k0 = ks * 256;
    f32x4 acc[5];
#pragma unroll
    for (int r = 0; r < 5; ++r) acc[r] = (f32x4){0.f, 0.f, 0.f, 0.f};
    for (int kk = 0; kk < 256; kk += 4) {
        f32x4 w[4];
#pragma unroll
        for (int j = 0; j < 4; ++j) w[j] = *(const GAS f32x4*)(w_ada + (size_t)(k0 + kk + j) * NMOD + n0);
#pragma unroll
        for (int j = 0; j < 4; ++j) {
#pragma unroll
            for (int r = 0; r < 5; ++r) { const float cv = (r < 4) ? c[r * DM + k0 + kk + j] : cctx[k0 + kk + j]; const float s = cv / (1.f + expf(-cv)); acc[r] += w[j] * s; }
        }
    }
#pragma unroll
    for (int r = 0; r < 5; ++r) *(GAS f32x4*)(part + (size_t)(ks * 5 + r) * NMOD + n0) = acc[r];
}

struct P {
    const float *x, *c, *ctx, *cctx, *w_ada, *b_ada, *g_pre_mix, *g_post_mix, *g_pre_ffn, *g_post_ffn, *w_in;
    const float *lam_re, *lam_im, *log_step, *b_re, *b_im, *c_re, *c_im, *s5d, *w_glu, *g_q, *w_uq, *g_kv, *w_ukv, *w_out, *ffn_w_in, *conv_w, *conv_b, *ffn_w_down;
    float* out;
    float *mod, *abar, *bbr, *bbi, *rope, *part, *mix, *f, *ydir;
    bf16 *WinT, *WuqT, *WukvT, *WgluT, *WoutT, *WfinT, *WdownT;
    bf16 *h, *px, *qcn, *kvcn, *krope, *q, *kv, *mixin, *yg, *hx, *gu, *act;
};

__device__ __forceinline__ void phase_prologue(const P& p, LAS unsigned char* lds, int gw, int NGW, int wave, int lane, int gtid, int NGT) {
    LAS float* scr = (LAS float*)(lds + wave * 16384);
    constexpr int I_IN = (DM / 64) * (INC / 32), I_UQ = (QRANK / 64) * (NQ / 32), I_UKV = (KVRANK / 64) * (NKV / 32), I_GLU = (S5W / 64) * (S5W / 32),
                  I_OUT = (DM / 64) * (DM / 32), I_FIN = (DM / 64) * (2 * DFF / 32), I_DOWN = (DFF / 64) * (DM / 32), I_ADA = 96 * 16;
    constexpr int NITEMS = I_ADA + I_IN + I_UQ + I_UKV + I_GLU + I_OUT + I_FIN + I_DOWN;
    for (int it = gw; it < NITEMS; it += NGW) {
        int r = it;
        if (r < I_ADA) { p0_ada_item(p.c, p.cctx, p.w_ada, p.part, r, lane); continue; } r -= I_ADA;
        if (r < I_IN) { p0_transpose_item(p.w_in, DM, INC, p.WinT, scr, r, lane); continue; } r -= I_IN;
        if (r < I_UQ) { p0_transpose_item(p.w_uq, QRANK, NQ, p.WuqT, scr, r, lane); continue; } r -= I_UQ;
        if (r < I_UKV) { p0_transpose_item(p.w_ukv, KVRANK, NKV, p.WukvT, scr, r, lane); continue; } r -= I_UKV;
        if (r < I_GLU) { p0_transpose_item(p.w_glu, S5W, S5W, p.WgluT, scr, r, lane); continue; } r -= I_GLU;
        if (r < I_OUT) { p0_transpose_item(p.w_out, DM, DM, p.WoutT, scr, r, lane); continue; } r -= I_OUT;
        if (r < I_FIN) { p0_transpose_item(p.ffn_w_in, DM, 2 * DFF, p.WfinT, scr, r, lane); continue; } r -= I_FIN;
        p0_transpose_item(p.ffn_w_down, DFF, DM, p.WdownT, scr, r, lane);
    }
    { GAS v4u* z = (GAS v4u*)(p.WinT + (size_t)INC * DM); const int n16 = (INCP - INC) * DM * 2 / 16; for (int i = gtid; i < n16; i += NGT) z[i] = (v4u){0u, 0u, 0u, 0u}; }
    for (int i = gtid; i < 2 * 64 * 64; i += NGT) {
        const int dg = i >> 6;
        const float lr = p.lam_re[i], li = p.lam_im[i], dt = expf(p.log_step[dg]);
        const float mag = expf(lr * dt); float sn, cs; sincosf(li * dt, &sn, &cs);
        const float ar = mag * cs, ai = mag * sn, den = lr * lr + li * li, nr = ar - 1.f, ni = ai;
        const float fr = (nr * lr + ni * li) / den, fi = (ni * lr - nr * li) / den;
        p.abar[2 * i] = ar; p.abar[2 * i + 1] = ai;
#pragma unroll
        for (int cc = 0; cc < 16; ++cc) { const float br = p.b_re[(size_t)i * 16 + cc], bi = p.b_im[(size_t)i * 16 + cc]; p.bbr[(size_t)i * 16 + cc] = fr * br - fi * bi; p.bbi[(size_t)i * 16 + cc] = fr * bi + fi * br; }
    }
    for (int i = gtid; i < SEQ * 32; i += NGT) {
        const int t = i >> 5, j = i & 31; const float pos = (float)((j < 16) ? (t >> 6) : (t & 63));
        const float inv = powf(10000.f, -(float)(j & 15) * (1.f / 16.f)); float sn, cs; sincosf(pos * inv, &sn, &cs);
        p.rope[2 * i] = cs; p.rope[2 * i + 1] = sn;
    }
}
__device__ __forceinline__ void phase_modreduce(const P& p, int gtid, int NGT) {
    for (int i = gtid; i < 5 * NMOD; i += NGT) { const int n = i % NMOD; float s = p.b_ada[n];
#pragma unroll
        for (int ks = 0; ks < 16; ++ks) s += p.part[(size_t)ks * 5 * NMOD + i];
        p.mod[i] = s; }
}
__device__ __forceinline__ void phase_norm1(const P& p, int gw, int NGW, int lane) {
    for (int row = gw; row < MALL; row += NGW) {
        const float* src = row < MX ? p.x + (size_t)row * DM : p.ctx + (size_t)(row - MX) * DM;
        const float* md = p.mod + (size_t)(row < MX ? row / SEQ : 4) * NMOD;
        const GAS f32x4* xr = (const GAS f32x4*)src + lane;
        f32x4 v[16]; float ss = 0.f;
#pragma unroll
        for (int j = 0; j < 16; ++j) { v[j] = xr[64 * j]; ss += (v[j].x * v[j].x + v[j].y * v[j].y) + (v[j].z * v[j].z + v[j].w * v[j].w); }
        const float rstd = rsqrtf(wave_sum(ss) * (1.f / DM) + EPS);
        GAS unsigned long long* o8 = (GAS unsigned long long*)(p.h + (size_t)row * DM) + lane;
#pragma unroll
        for (int j = 0; j < 16; ++j) { const f32x4 g = ((const GAS f32x4*)p.g_pre_mix)[lane + 64 * j], sh = ((const GAS f32x4*)md)[lane + 64 * j], sc = ((const GAS f32x4*)(md + DM))[lane + 64 * j];
            const f32x4 o = (v[j] * rstd) * g * (sc + 1.f) + sh;
            o8[64 * j] = (unsigned long long)pk2(o.x, o.y) | ((unsigned long long)pk2(o.z, o.w) << 32); }
    }
}
__device__ __forceinline__ void phase_postin(const P& p, int gw, int NGW, int lane) {
    for (int row = gw; row < MALL; row += NGW) {
        const bf16* pr = p.px + (size_t)row * INCP;
        { const v4u w = *(const GAS v4u*)(pr + 2048 + lane * 8);
          float v[8] = {bflo(w.x), bfhi(w.x), bflo(w.y), bfhi(w.y), bflo(w.z), bfhi(w.z), bflo(w.w), bfhi(w.w)}; float ss = 0.f;
#pragma unroll
          for (int j = 0; j < 8; ++j) ss += v[j] * v[j];
          const float rstd = rsqrtf(wave_sum(ss) * (1.f / KVRANK) + EPS);
          const f32x4 g0 = *(const GAS f32x4*)(p.g_kv + lane * 8), g1 = *(const GAS f32x4*)(p.g_kv + lane * 8 + 4);
          v4u o; o.x = pk2(v[0] * rstd * g0.x, v[1] * rstd * g0.y); o.y = pk2(v[2] * rstd * g0.z, v[3] * rstd * g0.w); o.z = pk2(v[4] * rstd * g1.x, v[5] * rstd * g1.y); o.w = pk2(v[6] * rstd * g1.z, v[7] * rstd * g1.w);
          *(GAS v4u*)(p.kvcn + (size_t)row * KVRANK + lane * 8) = o; }
        if (lane < 32) { const unsigned w = *(const GAS unsigned*)(pr + 2560 + lane * 2); float x1 = bflo(w), x2 = bfhi(w);
          if (row < MX) { const int t = row & (SEQ - 1); const float cs = p.rope[((size_t)t * 32 + lane) * 2], sn = p.rope[((size_t)t * 32 + lane) * 2 + 1]; const float a = x1 * cs - x2 * sn, b = x1 * sn + x2 * cs; x1 = a; x2 = b; }
          *(GAS unsigned*)(p.krope + (size_t)row * ROPED + lane * 2) = pk2(x1, x2); }
        if (row < MX) {
          const v4u w0 = *(const GAS v4u*)(pr + 1024 + lane * 8), w1 = *(const GAS v4u*)(pr + 1024 + 512 + lane * 8);
          float v[16] = {bflo(w0.x), bfhi(w0.x), bflo(w0.y), bfhi(w0.y), bflo(w0.z), bfhi(w0.z), bflo(w0.w), bfhi(w0.w), bflo(w1.x), bfhi(w1.x), bflo(w1.y), bfhi(w1.y), bflo(w1.z), bfhi(w1.z), bflo(w1.w), bfhi(w1.w)}; float ss = 0.f;
#pragma unroll
          for (int j = 0; j < 16; ++j) ss += v[j] * v[j];
          const float rstd = rsqrtf(wave_sum(ss) * (1.f / QRANK) + EPS);
#pragma unroll
          for (int hh = 0; hh < 2; ++hh) { const f32x4 g0 = *(const GAS f32x4*)(p.g_q + hh * 512 + lane * 8), g1 = *(const GAS f32x4*)(p.g_q + hh * 512 + lane * 8 + 4);
            v4u o; o.x = pk2(v[8 * hh + 0] * rstd * g0.x, v[8 * hh + 1] * rstd * g0.y); o.y = pk2(v[8 * hh + 2] * rstd * g0.z, v[8 * hh + 3] * rstd * g0.w);
            o.z = pk2(v[8 * hh + 4] * rstd * g1.x, v[8 * hh + 5] * rstd * g1.y); o.w = pk2(v[8 * hh + 6] * rstd * g1.z, v[8 * hh + 7] * rstd * g1.w);
            *(GAS v4u*)(p.qcn + (size_t)row * QRANK + hh * 512 + lane * 8) = o; }
        }
    }
}

__device__ __forceinline__ void phase_attn_v0(const P& p, LAS unsigned char* lds, int blk, int G) {
    constexpr int QS = 400, KS = 400, VS = 272, PS = 272;
    LAS unsigned char* Qs = lds; LAS unsigned char* Ks = lds + 128 * QS; LAS unsigned char* Vs = Ks + 64 * KS; LAS unsigned char* Ps = Vs + 64 * VS;
    const int tid = threadIdx.x, tq = tid >> 4, tk = tid & 15;
    for (int unit = blk; unit < NB * NH * (SEQ / 128); unit += G) {
        const int qt = unit % (SEQ / 128), bh = unit / (SEQ / 128), b = bh / NH, hd = bh % NH;
        const size_t qrow0 = (size_t)b * SEQ + qt * 128;
        __syncthreads();
        for (int c = tid; c < 128 * 24; c += 512) { const int r = c / 24, part = c % 24; *(LAS v4u*)(Qs + r * QS + part * 16) = *(const GAS v4u*)(p.q + (qrow0 + r) * NQ + hd * DQK + part * 8); }
        float m[4], l[4], o[4][8];
#pragma unroll
        for (int i = 0; i < 4; ++i) { m[i] = -INFINITY; l[i] = 0.f;
#pragma unroll
            for (int e = 0; e < 8; ++e) o[i][e] = 0.f; }
        for (int kt = 0; kt < NKT; ++kt) {
            __syncthreads();
            for (int c = tid; c < 64 * 24; c += 512) { const int kk = c / 24, part = c % 24; const int n = kt * 64 + kk; const size_t row = n < CTXL ? (size_t)MX + b * CTXL + n : (size_t)b * SEQ + (n - CTXL);
                const v4u w = part < 16 ? *(const GAS v4u*)(p.kv + row * NKV + hd * 256 + part * 8) : *(const GAS v4u*)(p.krope + row * ROPED + (part - 16) * 8);
                *(LAS v4u*)(Ks + kk * KS + part * 16) = w; }
            for (int c = tid; c < 64 * 16; c += 512) { const int kk = c / 16, part = c % 16; const int n = kt * 64 + kk; const size_t row = n < CTXL ? (size_t)MX + b * CTXL + n : (size_t)b * SEQ + (n - CTXL);
                *(LAS v4u*)(Vs + kk * VS + part * 16) = *(const GAS v4u*)(p.kv + row * NKV + hd * 256 + 128 + part * 8); }
            __syncthreads();
            float s[4][4];
#pragma unroll
            for (int i = 0; i < 4; ++i)
#pragma unroll
                for (int j = 0; j < 4; ++j) s[i][j] = 0.f;
            for (int d = 0; d < 24; ++d) {
                v4u qv[4], kv4[4];
#pragma unroll
                for (int i = 0; i < 4; ++i) { qv[i] = *(const LAS v4u*)(Qs + (4 * tq + i) * QS + d * 16); kv4[i] = *(const LAS v4u*)(Ks + (4 * tk + i) * KS + d * 16); }
#pragma unroll
                for (int i = 0; i < 4; ++i)
#pragma unroll
                    for (int j = 0; j < 4; ++j) {
                        s[i][j] += bflo(qv[i].x) * bflo(kv4[j].x) + bfhi(qv[i].x) * bfhi(kv4[j].x) + bflo(qv[i].y) * bflo(kv4[j].y) + bfhi(qv[i].y) * bfhi(kv4[j].y)
                                 + bflo(qv[i].z) * bflo(kv4[j].z) + bfhi(qv[i].z) * bfhi(kv4[j].z) + bflo(qv[i].w) * bflo(kv4[j].w) + bfhi(qv[i].w) * bfhi(kv4[j].w); }
            }
#pragma unroll
            for (int i = 0; i < 4; ++i) {
                float rm = fmaxf(fmaxf(s[i][0], s[i][1]), fmaxf(s[i][2], s[i][3]));
                rm = fmaxf(rm, __shfl_xor(rm, 1)); rm = fmaxf(rm, __shfl_xor(rm, 2)); rm = fmaxf(rm, __shfl_xor(rm, 4)); rm = fmaxf(rm, __shfl_xor(rm, 8));
                const float mn = fmaxf(m[i], rm), alpha = exp2f(m[i] - mn); m[i] = mn;
                float rs = 0.f;
#pragma unroll
                for (int j = 0; j < 4; ++j) { s[i][j] = exp2f(s[i][j] - mn); rs += s[i][j]; }
                rs += __shfl_xor(rs, 1); rs += __shfl_xor(rs, 2); rs += __shfl_xor(rs, 4); rs += __shfl_xor(rs, 8);
                l[i] = l[i] * alpha + rs;
#pragma unroll
                for (int e = 0; e < 8; ++e) o[i][e] *= alpha;
                *(LAS f32x4*)(Ps + (4 * tq + i) * PS + tk * 16) = (f32x4){s[i][0], s[i][1], s[i][2], s[i][3]};
            }
            __syncthreads();
            for (int j = 0; j < 64; ++j) {
                const v4u vv = *(const LAS v4u*)(Vs + j * VS + tk * 16);
                const float v8[8] = {bflo(vv.x), bfhi(vv.x), bflo(vv.y), bfhi(vv.y), bflo(vv.z), bfhi(vv.z), bflo(vv.w), bfhi(vv.w)};
#pragma unroll
                for (int i = 0; i < 4; ++i) { const float pj = *(const LAS float*)(Ps + (4 * tq + i) * PS + j * 4);
#pragma unroll
                    for (int e = 0; e < 8; ++e) o[i][e] += pj * v8[e]; }
            }
        }
#pragma unroll
        for (int i = 0; i < 4; ++i) { const float rl = 1.f / l[i];
            v4u w; w.x = pk2(o[i][0] * rl, o[i][1] * rl); w.y = pk2(o[i][2] * rl, o[i][3] * rl); w.z = pk2(o[i][4] * rl, o[i][5] * rl); w.w = pk2(o[i][6] * rl, o[i][7] * rl);
            *(GAS v4u*)(p.mixin + (qrow0 + 4 * tq + i) * DM + S5W + hd * DV + tk * 8) = w; }
    }
}

__device__ __forceinline__ void phase_s5_v0(const P& p, LAS unsigned char* lds, int blk, int G, int wave, int lane) {
    if (wave >= 2) return;
    LAS float* ul = (LAS float*)(lds + wave * 49152);
    LAS float* hbr = ul + 1024;
    LAS float* hbi = hbr + 64 * 65;
    LAS float* Cl = hbi + 64 * 65;
    for (int unit = blk + G * wave; unit < NB * 2 * 64; unit += 2 * G) {
        const int g = unit & 63, dir = (unit >> 6) & 1, b = unit >> 7;
        const int sidx = (dir * 64 + g) * 64 + lane;
        const float ar = p.abar[2 * sidx], ai = p.abar[2 * sidx + 1];
        float bbr[16], bbi[16];
#pragma unroll
        for (int cc = 0; cc < 16; ++cc) { bbr[cc] = p.bbr[(size_t)sidx * 16 + cc]; bbi[cc] = p.bbi[(size_t)sidx * 16 + cc]; }
        LDS_WAIT();
#pragma unroll
        for (int cc = 0; cc < 16; ++cc) { Cl[lane * 32 + cc] = p.c_re[((size_t)(dir * 64 + g) * 16 + cc) * 64 + lane]; Cl[lane * 32 + 16 + cc] = p.c_im[((size_t)(dir * 64 + g) * 16 + cc) * 64 + lane]; }
        float hr = 0.f, hi = 0.f;
        for (int k = 0; k < NKT; ++k) {
            { const int s = k * 64 + lane; size_t row;
              if (dir == 0) row = s < CTXL ? (size_t)MX + b * CTXL + s : (size_t)b * SEQ + (s - CTXL);
              else row = s < CTXL ? (size_t)MX + b * CTXL + (CTXL - 1 - s) : (size_t)b * SEQ + (SEQ - 1 - (s - CTXL));
              const v4u w0 = *(const GAS v4u*)(p.px + row * INCP + g * 16), w1 = *(const GAS v4u*)(p.px + row * INCP + g * 16 + 8);
              LDS_WAIT();
              *(LAS f32x4*)(ul + lane * 16) = (f32x4){bflo(w0.x), bfhi(w0.x), bflo(w0.y), bfhi(w0.y)}; *(LAS f32x4*)(ul + lane * 16 + 4) = (f32x4){bflo(w0.z), bfhi(w0.z), bflo(w0.w), bfhi(w0.w)};
              *(LAS f32x4*)(ul + lane * 16 + 8) = (f32x4){bflo(w1.x), bfhi(w1.x), bflo(w1.y), bfhi(w1.y)}; *(LAS f32x4*)(ul + lane * 16 + 12) = (f32x4){bflo(w1.z), bfhi(w1.z), bflo(w1.w), bfhi(w1.w)}; }
            LDS_WAIT();
#pragma unroll 4
            for (int j = 0; j < 64; ++j) {
                const f32x4 u0 = *(const LAS f32x4*)(ul + j * 16), u1 = *(const LAS f32x4*)(ul + j * 16 + 4), u2 = *(const LAS f32x4*)(ul + j * 16 + 8), u3 = *(const LAS f32x4*)(ul + j * 16 + 12);
                const float uu[16] = {u0.x, u0.y, u0.z, u0.w, u1.x, u1.y, u1.z, u1.w, u2.x, u2.y, u2.z, u2.w, u3.x, u3.y, u3.z, u3.w};
                float bur = 0.f, bui = 0.f;
#pragma unroll
                for (int cc = 0; cc < 16; ++cc) { bur += bbr[cc] * uu[cc]; bui += bbi[cc] * uu[cc]; }
                const float nhr = ar * hr - ai * hi + bur, nhi = ar * hi + ai * hr + bui; hr = nhr; hi = nhi;
                if (k >= CTXL / 64) { hbr[j * 65 + lane] = hr; hbi[j * 65 + lane] = hi; }
            }
            if (k >= CTXL / 64) {
                LDS_WAIT();
                float acc[16];
#pragma unroll
                for (int cc = 0; cc < 16; ++cc) acc[cc] = 0.f;
#pragma unroll 2
                for (int pp = 0; pp < 64; ++pp) {
                    const float xr = hbr[lane * 65 + pp], xi = hbi[lane * 65 + pp];
                    const f32x4 r0 = *(const LAS f32x4*)(Cl + pp * 32), r1 = *(const LAS f32x4*)(Cl + pp * 32 + 4), r2 = *(const LAS f32x4*)(Cl + pp * 32 + 8), r3 = *(const LAS f32x4*)(Cl + pp * 32 + 12);
                    const f32x4 i0 = *(const LAS f32x4*)(Cl + pp * 32 + 16), i1 = *(const LAS f32x4*)(Cl + pp * 32 + 20), i2 = *(const LAS f32x4*)(Cl + pp * 32 + 24), i3 = *(const LAS f32x4*)(Cl + pp * 32 + 28);
                    const float cr[16] = {r0.x, r0.y, r0.z, r0.w, r1.x, r1.y, r1.z, r1.w, r2.x, r2.y, r2.z, r2.w, r3.x, r3.y, r3.z, r3.w};
                    const float ci[16] = {i0.x, i0.y, i0.z, i0.w, i1.x, i1.y, i1.z, i1.w, i2.x, i2.y, i2.z, i2.w, i3.x, i3.y, i3.z, i3.w};
#pragma unroll
                    for (int cc = 0; cc < 16; ++cc) acc[cc] += cr[cc] * xr - ci[cc] * xi;
                }
                const int s = k * 64 + lane - CTXL; const int t = dir == 0 ? s : SEQ - 1 - s;
                GAS f32x4* yo = (GAS f32x4*)(p.ydir + ((size_t)dir * MX + (size_t)b * SEQ + t) * S5W + g * 16);
                yo[0] = (f32x4){acc[0], acc[1], acc[2], acc[3]}; yo[1] = (f32x4){acc[4], acc[5], acc[6], acc[7]}; yo[2] = (f32x4){acc[8], acc[9], acc[10], acc[11]}; yo[3] = (f32x4){acc[12], acc[13], acc[14], acc[15]};
            }
        }
    }
}
__device__ __forceinline__ void phase_s5gelu(const P& p, int gtid, int NGT) {
    for (int i = gtid; i < MX * (S5W / 8); i += NGT) {
        const int row = i >> 7, c0 = (i & 127) * 8;
        const v4u uw = *(const GAS v4u*)(p.px + (size_t)row * INCP + c0);
        const float u[8] = {bflo(uw.x), bfhi(uw.x), bflo(uw.y), bfhi(uw.y), bflo(uw.z), bfhi(uw.z), bflo(uw.w), bfhi(uw.w)};
        const f32x4 a0 = *(const GAS f32x4*)(p.ydir + (size_t)row * S5W + c0), a1 = *(const GAS f32x4*)(p.ydir + (size_t)row * S5W + c0 + 4);
        const f32x4 b0 = *(const GAS f32x4*)(p.ydir + ((size_t)MX + row) * S5W + c0), b1 = *(const GAS f32x4*)(p.ydir + ((size_t)MX + row) * S5W + c0 + 4);
        const f32x4 d0 = *(const GAS f32x4*)(p.s5d + c0), d1 = *(const GAS f32x4*)(p.s5d + c0 + 4);
        const float y[8] = {d0.x * u[0] + a0.x + b0.x, d0.y * u[1] + a0.y + b0.y, d0.z * u[2] + a0.z + b0.z, d0.w * u[3] + a0.w + b0.w, d1.x * u[4] + a1.x + b1.x, d1.y * u[5] + a1.y + b1.y, d1.z * u[6] + a1.z + b1.z, d1.w * u[7] + a1.w + b1.w};
        float gl[8];
#pragma unroll
        for (int j = 0; j < 8; ++j) { const float v = y[j]; gl[j] = 0.5f * v * (1.f + tanhf(0.7978845608028654f * (v + 0.044715f * v * v * v))); }
        v4u o; o.x = pk2(gl[0], gl[1]); o.y = pk2(gl[2], gl[3]); o.z = pk2(gl[4], gl[5]); o.w = pk2(gl[6], gl[7]);
        *(GAS v4u*)(p.yg + (size_t)row * S5W + c0) = o;
    }
}
__device__ __forceinline__ void phase_mid(const P& p, int gw, int NGW, int lane) {
    for (int row = gw; row < MX; row += NGW) {
        const float* md = p.mod + (size_t)(row / SEQ) * NMOD;
        const GAS f32x4* mr = (const GAS f32x4*)(p.mix + (size_t)row * DM) + lane; const GAS f32x4* xr = (const GAS f32x4*)(p.x + (size_t)row * DM) + lane;
        f32x4 v[16]; float ss = 0.f;
#pragma unroll
        for (int j = 0; j < 16; ++j) { v[j] = mr[64 * j]; ss += (v[j].x * v[j].x + v[j].y * v[j].y) + (v[j].z * v[j].z + v[j].w * v[j].w); }
        const float rstd = rsqrtf(wave_sum(ss) * (1.f / DM) + EPS); float s2 = 0.f;
        GAS f32x4* xo = (GAS f32x4*)(p.out + (size_t)row * DM) + lane;
#pragma unroll
        for (int j = 0; j < 16; ++j) { const f32x4 g = ((const GAS f32x4*)p.g_post_mix)[lane + 64 * j], ga = ((const GAS f32x4*)(md + 2 * DM))[lane + 64 * j];
            v[j] = xr[64 * j] + ga * ((v[j] * rstd) * g); xo[64 * j] = v[j]; s2 += (v[j].x * v[j].x + v[j].y * v[j].y) + (v[j].z * v[j].z + v[j].w * v[j].w); }
        const float rstd2 = rsqrtf(wave_sum(s2) * (1.f / DM) + EPS);
        GAS unsigned long long* o8 = (GAS unsigned long long*)(p.hx + (size_t)row * DM) + lane;
#pragma unroll
        for (int j = 0; j < 16; ++j) { const f32x4 g = ((const GAS f32x4*)p.g_pre_ffn)[lane + 64 * j], sh = ((const GAS f32x4*)(md + 3 * DM))[lane + 64 * j], sc = ((const GAS f32x4*)(md + 4 * DM))[lane + 64 * j];
            const f32x4 o = (v[j] * rstd2) * g * (sc + 1.f) + sh;
            o8[64 * j] = (unsigned long long)pk2(o.x, o.y) | ((unsigned long long)pk2(o.z, o.w) << 32); }
    }
}
__device__ __forceinline__ void phase_convact(const P& p, int gtid, int NGT) {
    constexpr int CB = DFF / 8;
    for (int it = gtid; it < (MX / 16) * CB; it += NGT) {
        const int cb = it % CB, rb = it / CB, c0 = cb * 8, r0 = rb * 16;
        float w0[8], w1[8], w2[8], bb[8];
#pragma unroll
        for (int j = 0; j < 8; ++j) { w0[j] = p.conv_w[c0 + j]; w1[j] = p.conv_w[DFF + c0 + j]; w2[j] = p.conv_w[2 * DFF + c0 + j]; bb[j] = p.conv_b[c0 + j]; }
        float gp[8], gc[8], gn[8];
        { const bool has = (r0 & (SEQ - 1)) != 0; v4u w = (v4u){0u, 0u, 0u, 0u}; if (has) w = *(const GAS v4u*)(p.gu + (size_t)(r0 - 1) * (2 * DFF) + c0);
          gp[0] = bflo(w.x); gp[1] = bfhi(w.x); gp[2] = bflo(w.y); gp[3] = bfhi(w.y); gp[4] = bflo(w.z); gp[5] = bfhi(w.z); gp[6] = bflo(w.w); gp[7] = bfhi(w.w); }
        { const v4u w = *(const GAS v4u*)(p.gu + (size_t)r0 * (2 * DFF) + c0);
          gc[0] = bflo(w.x); gc[1] = bfhi(w.x); gc[2] = bflo(w.y); gc[3] = bfhi(w.y); gc[4] = bflo(w.z); gc[5] = bfhi(w.z); gc[6] = bflo(w.w); gc[7] = bfhi(w.w); }
        for (int r = 0; r < 16; ++r) {
            const int row = r0 + r; const bool has = ((row + 1) & (SEQ - 1)) != 0; v4u w = (v4u){0u, 0u, 0u, 0u}; if (has) w = *(const GAS v4u*)(p.gu + (size_t)(row + 1) * (2 * DFF) + c0);
            gn[0] = bflo(w.x); gn[1] = bfhi(w.x); gn[2] = bflo(w.y); gn[3] = bfhi(w.y); gn[4] = bflo(w.z); gn[5] = bfhi(w.z); gn[6] = bflo(w.w); gn[7] = bfhi(w.w);
            const v4u uw = *(const GAS v4u*)(p.gu + (size_t)row * (2 * DFF) + DFF + c0);
            const float up[8] = {bflo(uw.x), bfhi(uw.x), bflo(uw.y), bfhi(uw.y), bflo(uw.z), bfhi(uw.z), bflo(uw.w), bfhi(uw.w)};
            float a[8];
#pragma unroll
            for (int j = 0; j < 8; ++j) { const float cv = w0[j] * gp[j] + w1[j] * gc[j] + w2[j] * gn[j] + bb[j]; a[j] = cv / (1.f + __expf(-cv)) * up[j]; gp[j] = gc[j]; gc[j] = gn[j]; }
            v4u o; o.x = pk2(a[0], a[1]); o.y = pk2(a[2], a[3]); o.z = pk2(a[4], a[5]); o.w = pk2(a[6], a[7]);
            *(GAS v4u*)(p.act + (size_t)row * DFF + c0) = o;
        }
    }
}
__device__ __forceinline__ void phase_final(const P& p, int gw, int NGW, int lane) {
    for (int row = gw; row < MX; row += NGW) {
        const float* md = p.mod + (size_t)(row / SEQ) * NMOD;
        const GAS f32x4* fr = (const GAS f32x4*)(p.f + (size_t)row * DM) + lane;
        f32x4 v[16]; float ss = 0.f;
#pragma unroll
        for (int j = 0; j < 16; ++j) { v[j] = fr[64 * j]; ss += (v[j].x * v[j].x + v[j].y * v[j].y) + (v[j].z * v[j].z + v[j].w * v[j].w); }
        const float rstd = rsqrtf(wave_sum(ss) * (1.f / DM) + EPS);
        GAS f32x4* xo = (GAS f32x4*)(p.out + (size_t)row * DM) + lane;
#pragma unroll
        for (int j = 0; j < 16; ++j) { const f32x4 g = ((const GAS f32x4*)p.g_post_ffn)[lane + 64 * j], ga = ((const GAS f32x4*)(md + 5 * DM))[lane + 64 * j];
            xo[64 * j] = xo[64 * j] + ga * ((v[j] * rstd) * g); }
    }
}

namespace att {
typedef short bf16x8 __attribute__((ext_vector_type(8)));
typedef short s16x4 __attribute__((ext_vector_type(4)));
typedef float f32x16 __attribute__((ext_vector_type(16)));
typedef unsigned u32x4 __attribute__((ext_vector_type(4)));
constexpr int KROWB = 384, KSLOT = 64 * KROWB, VSLOT = 16384, NSLOT = 3;
constexpr int L_K = 0, L_V = NSLOT * KSLOT, L_WS = L_V + NSLOT * VSLOT, L_END = L_WS + 8 * 256;
constexpr int OST_STRIDE = 272, OST_WAVE = 32 * OST_STRIDE;
static_assert(L_END <= 131072 && 8 * OST_WAVE <= L_V, "attention LDS map");
constexpr float THR2 = 8.f;
#define ATT_SBAR() __builtin_amdgcn_sched_barrier(0)
__device__ __forceinline__ int crow(int r, int hi) { return (r & 3) + 8 * (r >> 2) + 4 * hi; }
__device__ __forceinline__ unsigned cvtpk(float lo, float hi) { unsigned r; asm volatile("v_cvt_pk_bf16_f32 %0, %1, %2" : "=v"(r) : "v"(lo), "v"(hi)); return r; }
__device__ __forceinline__ void glds16(const void* gsrc, unsigned lds_dst) { unsigned keep;
    asm volatile("s_mov_b32 %0, m0\n\ts_mov_b32 m0, %2\n\ts_nop 0\n\tglobal_load_lds_dwordx4 %1, off\n\ts_mov_b32 m0, %0" : "=&s"(keep) : "v"(gsrc), "s"(lds_dst) : "memory"); }
#define ATT_WAITBAR(N) asm volatile("s_waitcnt vmcnt(" #N ") lgkmcnt(0)\n\ts_barrier" ::: "memory")

__device__ __forceinline__ void partialSM(f32x16& p0, f32x16& p1, float& m_reg, float& alpha) {
    float pmax = p0[0];
#pragma unroll
    for (int r = 1; r < 16; ++r) pmax = fmaxf(pmax, p0[r]);
#pragma unroll
    for (int r = 0; r < 16; ++r) pmax = fmaxf(pmax, p1[r]);
    { auto rr = __builtin_amdgcn_permlane32_swap(__float_as_uint(pmax), __float_as_uint(pmax), false, false); pmax = fmaxf(__uint_as_float(rr[0]), __uint_as_float(rr[1])); }
    float mn;
    if (__builtin_expect(__all(pmax - m_reg <= THR2), 1)) { mn = m_reg; alpha = 1.f; }
    else { mn = fmaxf(m_reg, pmax); alpha = __builtin_amdgcn_exp2f(m_reg - mn); m_reg = mn; }
#pragma unroll
    for (int r = 0; r < 16; ++r) { p0[r] -= mn; p1[r] -= mn; }
#pragma unroll
    for (int r = 0; r < 16; ++r) p0[r] = __builtin_amdgcn_exp2f(p0[r]);
}
__device__ __forceinline__ void finishSM(f32x16& p0, f32x16& p1, float alpha, float& l_reg, bf16x8& pa0, bf16x8& pa1, bf16x8& pa2, bf16x8& pa3) {
#pragma unroll
    for (int r = 0; r < 16; ++r) p1[r] = __builtin_amdgcn_exp2f(p1[r]);
    float ps = 0.f;
#pragma unroll
    for (int r = 0; r < 16; ++r) ps += p0[r];
#pragma unroll
    for (int r = 0; r < 16; ++r) ps += p1[r];
    { auto rr = __builtin_amdgcn_permlane32_swap(__float_as_uint(ps), __float_as_uint(ps), false, false); ps = __uint_as_float(rr[0]) + __uint_as_float(rr[1]); }
    l_reg = l_reg * alpha + ps;
#define ATT_PK4(P, BASE, OUT) do { unsigned a0 = cvtpk(P[BASE + 0], P[BASE + 1]), a1 = cvtpk(P[BASE + 2], P[BASE + 3]);   \
    unsigned b0 = cvtpk(P[BASE + 4], P[BASE + 5]), b1 = cvtpk(P[BASE + 6], P[BASE + 7]);                              \
    auto r0 = __builtin_amdgcn_permlane32_swap(a0, b0, false, false); auto r1 = __builtin_amdgcn_permlane32_swap(a1, b1, false, false); \
    u32x4 w = {r0[0], r1[0], r0[1], r1[1]}; OUT = __builtin_bit_cast(bf16x8, w); } while (0)
    ATT_PK4(p0, 0, pa0); ATT_PK4(p0, 8, pa1); ATT_PK4(p1, 0, pa2); ATT_PK4(p1, 8, pa3);
#undef ATT_PK4
}
__device__ __forceinline__ void qkt(f32x16& p0, f32x16& p1, const LAS unsigned char* Ks, const bf16x8 (&qr)[12], int r32, int hi) {
    p0 = f32x16{}; p1 = f32x16{};
    const int sw = (r32 & 7) << 4; const LAS unsigned char* ra = Ks + r32 * KROWB; const LAS unsigned char* rb = ra + 32 * KROWB;
    int lo[4];
#pragma unroll
    for (int q = 0; q < 4; ++q) lo[q] = (q * 32 + hi * 16) ^ sw;
#pragma unroll
    for (int d0 = 0; d0 < 12; ++d0) { const int off = lo[d0 & 3] + (d0 >> 2) * 128;
        const bf16x8 b0 = *(const LAS bf16x8*)(ra + off), b1 = *(const LAS bf16x8*)(rb + off);
        p0 = __builtin_amdgcn_mfma_f32_32x32x16_bf16(b0, qr[d0], p0, 0, 0, 0);
        p1 = __builtin_amdgcn_mfma_f32_32x32x16_bf16(b1, qr[d0], p1, 0, 0, 0); }
}
__device__ __forceinline__ int v_rd_base(int lane) { return ((lane & 3) << 3) | (((lane >> 2) & 3) << 6) | (((lane >> 4) & 1) << 5) | (((lane >> 5) & 1) << 8); }
constexpr int v_rd_off(int d0, int ks, int half) { return d0 * 512 + ks * 4096 + half * 2048; }
template <int OFF> __device__ __forceinline__ s16x4 tr_read(int vb) { s16x4 r; asm volatile("ds_read_b64_tr_b16 %0, %1 offset:%2" : "=&v"(r) : "v"(vb), "i"(OFF) : "memory"); return r; }
template <int D0> __device__ __forceinline__ void pv_one(f32x16& od, int vb, bf16x8 pa0, bf16x8 pa1, bf16x8 pa2, bf16x8 pa3) {
    const s16x4 l0 = tr_read<v_rd_off(D0, 0, 0)>(vb), h0 = tr_read<v_rd_off(D0, 0, 1)>(vb), l1 = tr_read<v_rd_off(D0, 1, 0)>(vb), h1 = tr_read<v_rd_off(D0, 1, 1)>(vb);
    const s16x4 l2 = tr_read<v_rd_off(D0, 2, 0)>(vb), h2 = tr_read<v_rd_off(D0, 2, 1)>(vb), l3 = tr_read<v_rd_off(D0, 3, 0)>(vb), h3 = tr_read<v_rd_off(D0, 3, 1)>(vb);
    asm volatile("s_waitcnt lgkmcnt(0)" ::: "memory"); ATT_SBAR();
#define ATT_PK(Lo, Hi) (bf16x8){Lo[0], Lo[1], Lo[2], Lo[3], Hi[0], Hi[1], Hi[2], Hi[3]}
    od = __builtin_amdgcn_mfma_f32_32x32x16_bf16(pa0, ATT_PK(l0, h0), od, 0, 0, 0);
    od = __builtin_amdgcn_mfma_f32_32x32x16_bf16(pa1, ATT_PK(l1, h1), od, 0, 0, 0);
    od = __builtin_amdgcn_mfma_f32_32x32x16_bf16(pa2, ATT_PK(l2, h2), od, 0, 0, 0);
    od = __builtin_amdgcn_mfma_f32_32x32x16_bf16(pa3, ATT_PK(l3, h3), od, 0, 0, 0);
#undef ATT_PK
}
__device__ __forceinline__ void pv_d0(f32x16 (&o)[4], int vb, bf16x8 pa0, bf16x8 pa1, bf16x8 pa2, bf16x8 pa3) {
    pv_one<0>(o[0], vb, pa0, pa1, pa2, pa3); pv_one<1>(o[1], vb, pa0, pa1, pa2, pa3); pv_one<2>(o[2], vb, pa0, pa1, pa2, pa3); pv_one<3>(o[3], vb, pa0, pa1, pa2, pa3);
}
}

__device__ __forceinline__ void phase_attn(const P& p, LAS unsigned char* L, int blk, int G) {
    using namespace att;
    const int tid = threadIdx.x, lane = tid & 63, wid = __builtin_amdgcn_readfirstlane(tid >> 6), r32 = lane & 31, hi = lane >> 5;
    const unsigned lds0 = (unsigned)(uintptr_t)L;
    unsigned koff[3], voff[2]; bool krp[3];
#pragma unroll
    for (int i = 0; i < 3; ++i) { const int o = (wid + 8 * i) * 1024 + lane * 16; const int row = o / KROWB; const int cbs = o - row * KROWB; const int colB = cbs ^ ((row & 7) << 4);
        krp[i] = colB >= 256; koff[i] = krp[i] ? (unsigned)(row * (ROPED * 2) + (colB - 256)) : (unsigned)(row * (NKV * 2) + colB); }
#pragma unroll
    for (int i = 0; i < 2; ++i) { const int st = 2 * (wid + 8 * i) + (lane >> 5); const int kk = ((st >> 2) << 3) | ((lane & 31) >> 2); const int k = (kk & ~0xC) | ((kk & 4) << 1) | ((kk & 8) >> 1);
        const int c = (st & 3) * 32 + 8 * (lane & 3); voff[i] = (unsigned)(k * (NKV * 2) + (128 + c) * 2); }
    LAS float* wsf = (LAS float*)(L + L_WS) + wid * 64; LAS float* li_l = wsf; LAS float* al_l = wsf + 32;
    const int vb0 = (int)(lds0 + L_V) + v_rd_base(lane);
    const LAS unsigned char* Kb = L + L_K;
    const int NU = NB * NH * (SEQ / 256);
    for (int it = 0;; ++it) {
        int bh, qb;
        if (G == 256) { if (it >= 6) break; const int xcd = blk & 7, idx = blk >> 3; bh = it * 16 + xcd * 2 + (idx >> 4); qb = idx & 15; }
        else { const int unit = blk + G * it; if (unit >= NU) break; bh = unit >> 4; qb = unit & 15; }
        const int b = bh / NH, h = bh % NH;
        const size_t qrow0 = (size_t)b * SEQ + qb * 256 + wid * 32;
#define ATT_RB(t) ((t) < 4 ? (size_t)MX + (size_t)b * CTXL + (size_t)(t) * 64 : (size_t)b * SEQ + (size_t)((t) - 4) * 64)
#define ATT_DMA_K(t, slot) do { const size_t rb_ = ATT_RB(t); const char* kvt_ = (const char*)(p.kv + rb_ * NKV + h * 256); const char* krt_ = (const char*)(p.krope + rb_ * ROPED); \
        _Pragma("unroll") for (int i_ = 0; i_ < 3; ++i_) glds16((krp[i_] ? krt_ : kvt_) + koff[i_], (unsigned)__builtin_amdgcn_readfirstlane(lds0 + L_K + (slot) * KSLOT + (wid + 8 * i_) * 1024)); } while (0)
#define ATT_DMA_V(t, slot) do { const size_t rb_ = ATT_RB(t); const char* kvt_ = (const char*)(p.kv + rb_ * NKV + h * 256); \
        _Pragma("unroll") for (int i_ = 0; i_ < 2; ++i_) glds16(kvt_ + voff[i_], (unsigned)__builtin_amdgcn_readfirstlane(lds0 + L_V + (slot) * VSLOT + (wid + 8 * i_) * 1024)); } while (0)
        ATT_DMA_K(0, 0); ATT_DMA_V(0, 0); ATT_DMA_K(1, 1);
        bf16x8 qr[12];
        { const bf16* qp = p.q + (qrow0 + r32) * NQ + h * DQK + hi * 8;
#pragma unroll
          for (int d0 = 0; d0 < 12; ++d0) qr[d0] = *(const GAS bf16x8*)(qp + d0 * 16); }
        float m_reg = -1e30f, l_reg = 0.f; f32x16 o[4] = {};
        f32x16 pA0, pA1, pB0, pB1; float alA, alB; bf16x8 pa0, pa1, pa2, pa3;
#define ATT_RESC(a) do { if (__any((a) < 1.f)) { if (hi == 0) al_l[r32] = (a); asm volatile("s_waitcnt lgkmcnt(0)" ::: "memory"); \
        _Pragma("unroll") for (int d_ = 0; d_ < 4; ++d_) _Pragma("unroll") for (int r_ = 0; r_ < 16; ++r_) o[d_][r_] *= al_l[crow(r_, hi)]; } } while (0)
        ATT_DMA_V(1, 1); ATT_DMA_K(2, 2);
        ATT_WAITBAR(5);
        qkt(pA0, pA1, Kb, qr, r32, hi); partialSM(pA0, pA1, m_reg, alA);
        ATT_WAITBAR(5);
#define ATT_STEP(j, C0, C1, ALC, P0, P1, ALP) do { const int j_ = (j); \
        if (j_ + 1 < NKT) ATT_DMA_V(j_ + 1, (j_ + 1) % 3); if (j_ + 2 < NKT) ATT_DMA_K(j_ + 2, (j_ + 2) % 3); \
        ATT_SBAR(); qkt(C0, C1, Kb + (j_ % 3) * KSLOT, qr, r32, hi); \
        finishSM(P0, P1, ALP, l_reg, pa0, pa1, pa2, pa3); ATT_SBAR(); \
        pv_d0(o, vb0 + ((j_ - 1) % 3) * VSLOT, pa0, pa1, pa2, pa3); partialSM(C0, C1, m_reg, ALC); \
        ATT_RESC(ALC); \
        if (j_ + 2 < NKT) ATT_WAITBAR(5); else ATT_WAITBAR(0); } while (0)
        for (int j = 1; j + 1 < NKT; j += 2) {
            ATT_STEP(j, pB0, pB1, alB, pA0, pA1, alA);
            ATT_STEP(j + 1, pA0, pA1, alA, pB0, pB1, alB);
        }
        ATT_STEP(NKT - 1, pB0, pB1, alB, pA0, pA1, alA);
        finishSM(pB0, pB1, alB, l_reg, pa0, pa1, pa2, pa3); ATT_SBAR();
        pv_d0(o, vb0 + ((NKT - 1) % 3) * VSLOT, pa0, pa1, pa2, pa3);
        if (hi == 0) li_l[r32] = l_reg; asm volatile("s_waitcnt lgkmcnt(0)" ::: "memory");
        float rli[16];
#pragma unroll
        for (int r = 0; r < 16; ++r) rli[r] = __builtin_amdgcn_rcpf(li_l[crow(r, hi)]);
        LAS unsigned char* Os = L + L_K + wid * OST_WAVE;
#pragma unroll
        for (int r = 0; r < 16; ++r) { const int orow = crow(r, hi);
#pragma unroll
            for (int d0 = 0; d0 < 4; ++d0) *(LAS unsigned short*)(Os + orow * OST_STRIDE + (d0 * 32 + r32) * 2) = (unsigned short)cvtpk(o[d0][r] * rli[r], 0.f); }
        asm volatile("s_waitcnt lgkmcnt(0)" ::: "memory");
        { bf16* Ow = p.mixin + qrow0 * DM + S5W + h * DV;
#pragma unroll
          for (int i = 0; i < 8; ++i) { const int row = i * 4 + (lane >> 4), ch = lane & 15; const u32x4 v = *(const LAS u32x4*)(Os + row * OST_STRIDE + ch * 16); *(GAS u32x4*)(Ow + (size_t)row * DM + ch * 8) = v; } }
        ATT_WAITBAR(0);
#undef ATT_STEP
#undef ATT_RESC
#undef ATT_DMA_K
#undef ATT_DMA_V
#undef ATT_RB
    }
}

constexpr int N_PHASES = 16;
struct Args { const float* in[29]; float* out; unsigned char* ws; int ph_lo, ph_hi, li, pad; };
__global__ void __launch_bounds__(NWAVES * 64, 2) skel_fwd(Args args) {
    extern __shared__ __attribute__((aligned(16))) unsigned char lds_raw[];
    LAS unsigned char* lds = (LAS unsigned char*)lds_raw;
    volatile LAS unsigned* MISC = (volatile LAS unsigned*)(lds + MISC_OFF);
    const int tid = threadIdx.x, lane = tid & 63, wave = __builtin_amdgcn_readfirstlane(tid >> 6);
    const int G = gridDim.x, blk = blockIdx.x;
    const int vcu = (G % 8 == 0) ? (blk % 8) * (G / 8) + blk / 8 : blk;
    const int gw = vcu * NWAVES + wave, NGW = G * NWAVES, gtid = blk * (NWAVES * 64) + tid, NGT = G * NWAVES * 64;
    unsigned char* ws = args.ws;
    P p;
    p.x = args.in[0]; p.c = args.in[1]; p.ctx = args.in[2]; p.cctx = args.in[3]; p.w_ada = args.in[4]; p.b_ada = args.in[5];
    p.g_pre_mix = args.in[6]; p.g_post_mix = args.in[7]; p.g_pre_ffn = args.in[8]; p.g_post_ffn = args.in[9]; p.w_in = args.in[10];
    p.lam_re = args.in[11]; p.lam_im = args.in[12]; p.log_step = args.in[13]; p.b_re = args.in[14]; p.b_im = args.in[15]; p.c_re = args.in[16]; p.c_im = args.in[17];
    p.s5d = args.in[18]; p.w_glu = args.in[19]; p.g_q = args.in[20]; p.w_uq = args.in[21]; p.g_kv = args.in[22]; p.w_ukv = args.in[23]; p.w_out = args.in[24];
    p.ffn_w_in = args.in[25]; p.conv_w = args.in[26]; p.conv_b = args.in[27]; p.ffn_w_down = args.in[28];
    p.out = args.out;
    p.mod = (float*)(ws + WS_MOD); p.abar = (float*)(ws + WS_S5A); p.bbr = (float*)(ws + WS_S5BR); p.bbi = (float*)(ws + WS_S5BI); p.rope = (float*)(ws + WS_ROPE); p.part = (float*)(ws + WS_PART);
    p.mix = (float*)(ws + WS_MIX); p.f = (float*)(ws + WS_F); p.ydir = (float*)(ws + WS_YDIR);
    p.WinT = (bf16*)(ws + WS_WIN); p.WuqT = (bf16*)(ws + WS_WUQ); p.WukvT = (bf16*)(ws + WS_WUKV); p.WgluT = (bf16*)(ws + WS_WGLU); p.WoutT = (bf16*)(ws + WS_WOUT); p.WfinT = (bf16*)(ws + WS_WFIN); p.WdownT = (bf16*)(ws + WS_WDOWN);
    p.h = (bf16*)(ws + WS_H); p.px = (bf16*)(ws + WS_PX); p.qcn = (bf16*)(ws + WS_QCN); p.kvcn = (bf16*)(ws + WS_KVCN); p.krope = (bf16*)(ws + WS_KROPE); p.q = (bf16*)(ws + WS_Q); p.kv = (bf16*)(ws + WS_KV);
    p.mixin = (bf16*)(ws + WS_MIXIN); p.yg = (bf16*)(ws + WS_YG); p.hx = (bf16*)(ws + WS_HX); p.gu = (bf16*)(ws + WS_GU); p.act = (bf16*)(ws + WS_ACT);

    for (int u = tid; u < (LDS_BYTES - LDSCTL_OFF) / 4; u += NWAVES * 64) ((LAS unsigned*)(lds + LDSCTL_OFF))[u] = 0u;
    __syncthreads();
#if MK_ONE_LAUNCH
    XcdBarrier bar = xcd_barrier_post((unsigned*)(ws + WS_CTL) + CW_BAR, MISC + 8);
#define GRID_BAR() xcd_barrier(bar)
#else
    (void)MISC;
#define GRID_BAR() do { } while (0)
#endif
    const int lo = args.ph_lo, hi = args.ph_hi;
#define IN(k) (lo <= (k) && (k) < hi)
#define SEAM(k) do { if (IN(k) && IN((k) + 1)) GRID_BAR(); } while (0)
    typedef pg8::StaticOrder SO;

    if (IN(0)) { phase_prologue(p, lds, gw, NGW, wave, lane, gtid, NGT); } SEAM(0);
    if (IN(1)) { phase_modreduce(p, gtid, NGT); } SEAM(1);
    if (IN(2)) { phase_norm1(p, gw, NGW, lane); } SEAM(2);
    if (IN(3)) { pg8::Gemm g{p.h, p.WinT, MALL, INCP, DM}; SO S; S.init(MALL, INCP, G, blk); pg8::EpiBf16P E{p.px, INCP};
                 pg8::gemm_phase<pg8::EpiBf16P, SO, true, true>(lds, g, S, E); } SEAM(3);
    if (IN(4)) { phase_postin(p, gw, NGW, lane); } SEAM(4);
    if (IN(5)) { { pg8::Gemm g{p.qcn, p.WuqT, MX, NQ, QRANK}; SO S; S.init(MX, NQ, G, blk); pg8::EpiQ E{p.q, p.rope, QSCALE};
                   pg8::gemm_phase<pg8::EpiQ, SO, true, true>(lds, g, S, E); }
                 { pg8::Gemm g{p.kvcn, p.WukvT, MALL, NKV, KVRANK}; SO S; S.init(MALL, NKV, G, blk); pg8::EpiBf16P E{p.kv, NKV};
                   pg8::gemm_phase<pg8::EpiBf16P, SO, true, true>(lds, g, S, E); } } SEAM(5);
    if (IN(6)) { phase_attn(p, lds, blk, G); } SEAM(6);
    if (IN(7)) { phase_s5_v0(p, lds, blk, G, wave, lane); } SEAM(7);
    if (IN(8)) { phase_s5gelu(p, gtid, NGT); } SEAM(8);
    if (IN(9)) { pg8::Gemm g{p.yg, p.WgluT, MX, S5W, S5W}; SO S; S.init(MX, S5W, G, blk); pg8::EpiGlu E{p.yg, p.mixin, DM};
                 pg8::gemm_phase<pg8::EpiGlu, SO, true, true>(lds, g, S, E); } SEAM(9);
    if (IN(10)) { pg8::Gemm g{p.mixin, p.WoutT, MX, DM, DM}; SO S; S.init(MX, DM, G, blk); pg8::EpiF32P E{p.mix, DM};
                  pg8::gemm_phase<pg8::EpiF32P, SO, true, true>(lds, g, S, E); } SEAM(10);
    if (IN(11)) { phase_mid(p, gw, NGW, lane); } SEAM(11);
    if (IN(12)) { pg8::Gemm g{p.hx, p.WfinT, MX, 2 * DFF, DM}; SO S; S.init(MX, 2 * DFF, G, blk); pg8::EpiBf16P E{p.gu, 2 * DFF};
                  pg8::gemm_phase<pg8::EpiBf16P, SO, true, true>(lds, g, S, E); } SEAM(12);
    if (IN(13)) { phase_convact(p, gtid, NGT); } SEAM(13);
    if (IN(14)) { pg8::Gemm g{p.act, p.WdownT, MX, DM, DFF}; SO S; S.init(MX, DM, G, blk); pg8::EpiF32P E{p.f, DM};
                  pg8::gemm_phase<pg8::EpiF32P, SO, true, true>(lds, g, S, E); } SEAM(14);
    if (IN(15)) { phase_final(p, gw, NGW, lane); }
#undef IN
#undef SEAM
}

extern "C" void kernel_launch(void* const* d_in, const int* in_sizes, int n_in, void* d_out, int out_size, void* d_ws, size_t ws_size, hipStream_t stream) {
    static int grid = 0;
    if (grid == 0) {
        if (n_in != 29 || out_size != MX * DM || ws_size < WS_END) { fprintf(stderr, "kernel_launch: unexpected shapes: n_in %d out %d ws %zu (need %zu)\n", n_in, out_size, ws_size, (size_t)WS_END); grid = -1; return; }
        int dev = 0, cus = 0;
        if (hipGetDevice(&dev) != hipSuccess || hipDeviceGetAttribute(&cus, hipDeviceAttributeMultiprocessorCount, dev) != hipSuccess) { grid = -1; return; }
        if (hipFuncSetAttribute((const void*)skel_fwd, hipFuncAttributeMaxDynamicSharedMemorySize, LDS_BYTES) != hipSuccess) { fprintf(stderr, "kernel_launch: hipFuncSetAttribute failed\n"); grid = -1; return; }
        int per_cu = 0;
        if (hipOccupancyMaxActiveBlocksPerMultiprocessor(&per_cu, (const void*)skel_fwd, NWAVES * 64, LDS_BYTES) != hipSuccess || per_cu < 1) fprintf(stderr, "kernel_launch: occupancy query says %d\n", per_cu);
        (void)hipGetLastError();
        grid = cus;
    }
    if (grid < 0) return;
    (void)hipMemsetAsync((char*)d_ws + WS_CTL, 0, CTL_ZERO_BYTES, stream);
    Args a{};
    for (int i = 0; i < 29; ++i) a.in[i] = (const float*)d_in[i];
    a.out = (float*)d_out; a.ws = (unsigned char*)d_ws;
#if MK_ONE_LAUNCH
    a.ph_lo = 0; a.ph_hi = N_PHASES; a.li = 0;
    hipLaunchKernelGGL(skel_fwd, dim3(grid), dim3(NWAVES * 64), LDS_BYTES, stream, a);
#else
    for (int ph = 0; ph < N_PHASES; ++ph) { a.ph_lo = ph; a.ph_hi = ph + 1; a.li = ph; hipLaunchKernelGGL(skel_fwd, dim3(grid), dim3(NWAVES * 64), LDS_BYTES, stream, a); }
#endif
    const hipError_t le = hipPeekAtLastError();
    if (le != hipSuccess) fprintf(stderr, "kernel_launch: launch failed: %s\n", hipGetErrorName(le));
}
```

```cpp
#include <hip/hip_runtime.h>
#include <cstdio>
#include <cstdint>
#include <cmath>

#ifndef MK_ONE_LAUNCH
#define MK_ONE_LAUNCH 1
#endif

__device__ __forceinline__ int ltid() { int t = threadIdx.x; asm volatile("" : "+v"(t)); return t; }

namespace pg8 {
#define PG8_LAS __attribute__((address_space(3)))
typedef unsigned short bf16_t;
typedef short bf16x8 __attribute__((ext_vector_type(8)));
typedef float f32x4 __attribute__((ext_vector_type(4)));
typedef float f32x2 __attribute__((ext_vector_type(2)));
typedef unsigned u32x4 __attribute__((ext_vector_type(4)));
constexpr int BM = 256, BK = 64, HALF = 128, HTB = HALF * BK * 2  , STAGE_BYTES = 8 * HTB, NXCD = 8, WGM = 8;

__host__ __device__ __forceinline__ int lds_byte(int r, int c) { const int st = (r >> 4) * 2 + (c >> 5), rr = r & 15, cc = c & 31, ob = rr * 64 + cc * 2; return st * 1024 + (ob ^ (((ob >> 9) & 1) << 5)); }
__host__ __device__ __forceinline__ void stage_rc(int b, int& R, int& C) { const int st = b / 1024, sb = b % 1024, swz = sb ^ (((sb >> 9) & 1) << 5); R = (st >> 1) * 16 + swz / 64; C = (st & 1) * 32 + (swz % 64) / 2; }
__host__ __device__ __forceinline__ int perm32(int rho) { const int n = rho >> 4, i = rho & 15; return 8 * (i >> 2) + 4 * n + (i & 3); }

struct Unit { int pm, pn; };
struct Gemm { const bf16_t* A; const bf16_t* Bt; int M, N, K; };

struct StaticOrder {
    int nM, nN, nwg, G, c;
    __host__ __device__ void init(int M, int N, int G_, int c_) { nM = M / BM; nN = N / BM; nwg = nM * nN; G = G_; c = c_; }
    __host__ __device__ bool next(int i, Unit& u) const {
        const long L = (long)i * G + c; if (L >= nwg) return false;
        int wgid = (int)L; { const int q = nwg / NXCD, r = nwg % NXCD, xcd = wgid % NXCD, off = wgid / NXCD; wgid = (xcd < r ? xcd * (q + 1) : r * (q + 1) + (xcd - r) * q) + off; }
        const int nig = WGM * nN, gid = wgid / nig, fm = gid * WGM, gsz = (nM - fm) < WGM ? (nM - fm) : WGM;
        u.pm = fm + ((wgid % nig) % gsz); u.pn = (wgid % nig) / gsz; return true;
    }
    __device__ __forceinline__ void a_ready(const Unit&) const {}
    __device__ __forceinline__ void done(const Unit&) const {}
};

__device__ __forceinline__ unsigned cvt_pk_bf16(float lo, float hi) { unsigned r; asm volatile("v_cvt_pk_bf16_f32 %0, %1, %2" : "=v"(r) : "v"(lo), "v"(hi)); return r; }
__device__ __forceinline__ float bf_lo(unsigned w) { return __uint_as_float(w << 16); }
__device__ __forceinline__ float bf_hi(unsigned w) { return __uint_as_float(w & 0xffff0000u); }

struct EpiBf16P {
    static constexpr bool PERM = true, AFTER_DRAIN = false;
    bf16_t* O; int ldc;
    __device__ __forceinline__ void operator()(const f32x4 (&acc)[2][2][4][2], const Unit& u, int wr, int wc, int fr, int fq) const {
        const int row0 = u.pm * BM + wr * 64 + fr, col0 = u.pn * BM + wc * 32 + 8 * fq;
#pragma unroll
        for (int ai = 0; ai < 2; ++ai)
#pragma unroll
            for (int m = 0; m < 4; ++m) { bf16_t* rowp = O + (size_t)(row0 + ai * HALF + m * 16) * ldc + col0;
#pragma unroll
                for (int bj = 0; bj < 2; ++bj) { const f32x4 v0 = acc[ai][bj][m][0], v1 = acc[ai][bj][m][1];
                    u32x4 w; w.x = cvt_pk_bf16(v0[0], v0[1]); w.y = cvt_pk_bf16(v0[2], v0[3]); w.z = cvt_pk_bf16(v1[0], v1[1]); w.w = cvt_pk_bf16(v1[2], v1[3]);
                    *(u32x4*)(rowp + bj * HALF) = w; } }
    }
};
struct EpiF32P {
    static constexpr bool PERM = false, AFTER_DRAIN = false;
    float* C; int ldc;
    __device__ __forceinline__ void operator()(const f32x4 (&acc)[2][2][4][2], const Unit& u, int wr, int wc, int fr, int fq) const {
        const int row0 = u.pm * BM + wr * 64 + fr, col0 = u.pn * BM + wc * 32 + 4 * fq;
#pragma unroll
        for (int ai = 0; ai < 2; ++ai)
#pragma unroll
            for (int m = 0; m < 4; ++m) { float* rowp = C + (size_t)(row0 + ai * HALF + m * 16) * ldc + col0;
#pragma unroll
                for (int bj = 0; bj < 2; ++bj)
#pragma unroll
                    for (int n = 0; n < 2; ++n) *(f32x4*)(rowp + bj * HALF + n * 16) = acc[ai][bj][m][n]; }
    }
};
struct EpiQ {
    static constexpr bool PERM = true, AFTER_DRAIN = false;
    bf16_t* O; const float* rope; float scale;
    __device__ __forceinline__ void operator()(const f32x4 (&acc)[2][2][4][2], const Unit& u, int wr, int wc, int fr, int fq) const {
        const int row0 = u.pm * BM + wr * 64 + fr, col0 = u.pn * BM + wc * 32 + 8 * fq;
#pragma unroll
        for (int ai = 0; ai < 2; ++ai)
#pragma unroll
            for (int m = 0; m < 4; ++m) { const int row = row0 + ai * HALF + m * 16; const int t = row & 4095; bf16_t* rowp = O + (size_t)row * 4608 + col0;
#pragma unroll
                for (int bj = 0; bj < 2; ++bj) { f32x4 v0 = acc[ai][bj][m][0] * scale, v1 = acc[ai][bj][m][1] * scale;
                    const int col = col0 + bj * HALF; const int within = col % 192;
                    if (within >= 128) { const float* cs = rope + ((size_t)t * 32 + ((within - 128) >> 1)) * 2; const f32x4 c01 = *(const f32x4*)cs, c23 = *(const f32x4*)(cs + 4);
                        const float a0 = v0[0], a1 = v0[1], a2 = v0[2], a3 = v0[3], b0 = v1[0], b1 = v1[1], b2 = v1[2], b3 = v1[3];
                        v0[0] = a0 * c01[0] - a1 * c01[1]; v0[1] = a0 * c01[1] + a1 * c01[0]; v0[2] = a2 * c01[2] - a3 * c01[3]; v0[3] = a2 * c01[3] + a3 * c01[2];
                        v1[0] = b0 * c23[0] - b1 * c23[1]; v1[1] = b0 * c23[1] + b1 * c23[0]; v1[2] = b2 * c23[2] - b3 * c23[3]; v1[3] = b2 * c23[3] + b3 * c23[2]; }
                    u32x4 w; w.x = cvt_pk_bf16(v0[0], v0[1]); w.y = cvt_pk_bf16(v0[2], v0[3]); w.z = cvt_pk_bf16(v1[0], v1[1]); w.w = cvt_pk_bf16(v1[2], v1[3]);
                    *(u32x4*)(rowp + bj * HALF) = w; } }
    }
};
struct EpiGlu {
    static constexpr bool PERM = true, AFTER_DRAIN = false;
    const bf16_t* YG; bf16_t* O; int ldo;
    __device__ __forceinline__ void operator()(const f32x4 (&acc)[2][2][4][2], const Unit& u, int wr, int wc, int fr, int fq) const {
        const int row0 = u.pm * BM + wr * 64 + fr, col0 = u.pn * BM + wc * 32 + 8 * fq;
#pragma unroll
        for (int ai = 0; ai < 2; ++ai)
#pragma unroll
            for (int m = 0; m < 4; ++m) { const int row = row0 + ai * HALF + m * 16;
#pragma unroll
                for (int bj = 0; bj < 2; ++bj) { const int col = col0 + bj * HALF; const u32x4 y = *(const u32x4*)(YG + (size_t)row * 1024 + col);
                    const f32x4 v0 = acc[ai][bj][m][0], v1 = acc[ai][bj][m][1];
                    float o[8]; const float yv[8] = {bf_lo(y.x), bf_hi(y.x), bf_lo(y.y), bf_hi(y.y), bf_lo(y.z), bf_hi(y.z), bf_lo(y.w), bf_hi(y.w)};
#pragma unroll
                    for (int j = 0; j < 4; ++j) { o[j] = yv[j] / (1.f + __expf(-v0[j])); o[4 + j] = yv[4 + j] / (1.f + __expf(-v1[j])); }
                    u32x4 w; w.x = cvt_pk_bf16(o[0], o[1]); w.y = cvt_pk_bf16(o[2], o[3]); w.z = cvt_pk_bf16(o[4], o[5]); w.w = cvt_pk_bf16(o[6], o[7]);
                    *(u32x4*)(O + (size_t)row * ldo + col) = w; } }
    }
};

template <class Epi, class Sched, bool ALIGN_EPI = false, bool SP2 = false>
__device__ __forceinline__ void gemm_phase(PG8_LAS unsigned char* lds, const Gemm g, const Sched& S, const Epi& E) {
    const int tid = ltid(), wid = __builtin_amdgcn_readfirstlane(tid >> 6), lane = tid & 63, wr = wid >> 2, wc = wid & 3, fr = lane & 15, fq = lane >> 4;
    const int K = g.K, nt = K / BK;
    unsigned voffA[2], voffB[2];
#pragma unroll
    for (int i = 0; i < 2; ++i) { int R, C; stage_rc(tid * 16 + i * 8192, R, C); const int Rb = Epi::PERM ? ((R & ~31) + perm32(R & 31)) : R;
        voffA[i] = (unsigned)(R * K + C) * 2u; voffB[i] = (unsigned)(Rb * K + C) * 2u; }
    const size_t kstep = (size_t)(BK * 2);
    const size_t hstep = (size_t)HALF * K * 2;
    const size_t tstep = 2 * hstep;
    const unsigned ldsw = (unsigned)wid * 1024u;
    const int aoff = lds_byte(wr * 64 + fr, fq * 8), boff = lds_byte(wc * 32 + fr, fq * 8);
#define PG8_SA(b, h) (((b) * 2 + (h)) * HTB)
#define PG8_SB(b, h) ((4 + (b) * 2 + (h)) * HTB)
#define PG8_STAGE(bufoff, gbase, voff) do { _Pragma("unroll") for (int _i = 0; _i < 2; ++_i) \
        __builtin_amdgcn_global_load_lds((const unsigned*)((const char*)(gbase) + (voff)[_i]), (PG8_LAS unsigned*)(lds + (bufoff) + ldsw + _i * 8192), 16, 0, 0); } while (0)
#define PG8_LDA(dst, b, h) do { _Pragma("unroll") for (int m = 0; m < 4; ++m) _Pragma("unroll") for (int k = 0; k < 2; ++k) dst[m][k] = *(const PG8_LAS bf16x8*)(lds + PG8_SA(b, h) + aoff + m * 2048 + k * 1024); } while (0)
#define PG8_LDB(dst, b, h) do { _Pragma("unroll") for (int n = 0; n < 2; ++n) _Pragma("unroll") for (int k = 0; k < 2; ++k) dst[n][k] = *(const PG8_LAS bf16x8*)(lds + PG8_SB(b, h) + boff + n * 2048 + k * 1024); } while (0)
#define PG8_MMA(ai, bj, At, Bt) do { __builtin_amdgcn_s_setprio(1); _Pragma("unroll") for (int m = 0; m < 4; ++m) _Pragma("unroll") for (int n = 0; n < 2; ++n) _Pragma("unroll") for (int k = 0; k < 2; ++k) \
        acc[ai][bj][m][n] = __builtin_amdgcn_mfma_f32_16x16x32_bf16(Bt[n][k], At[m][k], acc[ai][bj][m][n], 0, 0, 0); __builtin_amdgcn_s_setprio(0); } while (0)
#define PG8_WAIT_V(n) asm volatile("s_waitcnt vmcnt(" #n ")" ::: "memory")
#define PG8_WAIT_L(n) asm volatile("s_waitcnt lgkmcnt(" #n ")" ::: "memory")
#define PG8_BAR __builtin_amdgcn_s_barrier()
#define PG8_SCHED __builtin_amdgcn_sched_barrier(0)
    Unit cur, nxt; int ui = 0;
    if (!S.next(0, cur)) return;
    f32x4 acc[2][2][4][2];
#pragma unroll
    for (int a = 0; a < 2; ++a)
#pragma unroll
        for (int b = 0; b < 2; ++b)
#pragma unroll
            for (int m = 0; m < 4; ++m)
#pragma unroll
                for (int n = 0; n < 2; ++n) acc[a][b][m][n] = (f32x4){0.f, 0.f, 0.f, 0.f};
    bf16x8 At[4][2], B0[2][2], B1[2][2];
    const char* cA = (const char*)g.A + (size_t)cur.pm * tstep; const char* cB = (const char*)g.Bt + (size_t)cur.pn * tstep;
    S.a_ready(cur);
    if constexpr (SP2) {
        PG8_STAGE(PG8_SB(0, 0), cB, voffB); PG8_STAGE(PG8_SB(0, 1), cB + hstep, voffB); PG8_STAGE(PG8_SA(0, 0), cA, voffA); PG8_STAGE(PG8_SA(0, 1), cA + hstep, voffA);
        if (wr == 1) PG8_BAR;
        PG8_WAIT_V(2); PG8_BAR;
        PG8_STAGE(PG8_SB(1, 0), cB + kstep, voffB); PG8_STAGE(PG8_SA(1, 0), cA + kstep, voffA); PG8_STAGE(PG8_SB(1, 1), cB + hstep + kstep, voffB);
        PG8_WAIT_V(6); PG8_BAR;
    } else {
        PG8_STAGE(PG8_SB(0, 0), cB, voffB); PG8_STAGE(PG8_SA(0, 0), cA, voffA); PG8_STAGE(PG8_SB(0, 1), cB + hstep, voffB); PG8_STAGE(PG8_SA(0, 1), cA + hstep, voffA);
        if (wr == 1) PG8_BAR;
        PG8_WAIT_V(4); PG8_BAR;
        PG8_STAGE(PG8_SB(1, 0), cB + kstep, voffB); PG8_STAGE(PG8_SA(1, 0), cA + kstep, voffA); PG8_STAGE(PG8_SB(1, 1), cB + hstep + kstep, voffB);
        PG8_WAIT_V(6); PG8_BAR;
    }
    for (;;) {
        const bool has_next = S.next(ui + 1, nxt);
        const char* nA = has_next ? (const char*)g.A + (size_t)nxt.pm * tstep : cA; const char* nB = has_next ? (const char*)g.Bt + (size_t)nxt.pn * tstep : cB;
        for (int t = 0; t < nt; t += 2) {
            const bool last = (t == nt - 2);
            const char* a1 = cA + (size_t)(t + 1) * kstep;
            const char* a2 = last ? nA : cA + (size_t)(t + 2) * kstep; const char* b2 = last ? nB : cB + (size_t)(t + 2) * kstep;
            const char* a3 = a2 + kstep; const char* b3 = b2 + kstep;
            if (last && has_next) S.a_ready(nxt);
            if constexpr (SP2) {
            PG8_LDB(B0, 0, 0); PG8_LDB(B1, 0, 1); PG8_SCHED; PG8_LDA(At, 0, 0); PG8_STAGE(PG8_SA(1, 1), a1 + hstep, voffA);
            PG8_WAIT_V(8); PG8_WAIT_L(0); PG8_BAR; PG8_MMA(0, 0, At, B0); PG8_MMA(0, 1, At, B1); PG8_BAR; PG8_SCHED;
            PG8_LDA(At, 0, 1); PG8_STAGE(PG8_SB(0, 0), b2, voffB); PG8_STAGE(PG8_SB(0, 1), b2 + hstep, voffB); PG8_STAGE(PG8_SA(0, 0), a2, voffA);
            PG8_WAIT_V(8); PG8_WAIT_L(0); PG8_BAR; PG8_MMA(1, 0, At, B0); PG8_MMA(1, 1, At, B1); PG8_BAR; PG8_SCHED;
            PG8_LDB(B0, 1, 0); PG8_LDB(B1, 1, 1); PG8_SCHED; PG8_LDA(At, 1, 0); PG8_STAGE(PG8_SA(0, 1), a2 + hstep, voffA);
            PG8_WAIT_V(8); PG8_WAIT_L(0); PG8_BAR; PG8_MMA(0, 0, At, B0); PG8_MMA(0, 1, At, B1); PG8_BAR; PG8_SCHED;
            PG8_LDA(At, 1, 1); PG8_STAGE(PG8_SB(1, 0), b3, voffB); PG8_STAGE(PG8_SB(1, 1), b3 + hstep, voffB); PG8_STAGE(PG8_SA(1, 0), a3, voffA);
            PG8_WAIT_V(8); PG8_WAIT_L(0); PG8_BAR; PG8_MMA(1, 0, At, B0); PG8_MMA(1, 1, At, B1); PG8_BAR; PG8_SCHED;
            } else {
            PG8_LDB(B0, 0, 0); PG8_SCHED; PG8_LDA(At, 0, 0); PG8_STAGE(PG8_SA(1, 1), a1 + hstep, voffA);
            PG8_WAIT_L(8); PG8_BAR; PG8_WAIT_L(0); PG8_MMA(0, 0, At, B0); PG8_BAR; PG8_SCHED;
            PG8_LDB(B1, 0, 1); PG8_STAGE(PG8_SB(0, 0), b2, voffB);
            PG8_BAR; PG8_WAIT_L(0); PG8_MMA(0, 1, At, B1); PG8_BAR;
            PG8_LDA(At, 0, 1); PG8_STAGE(PG8_SA(0, 0), a2, voffA);
            PG8_BAR; PG8_WAIT_L(0); PG8_MMA(1, 0, At, B0); PG8_BAR; PG8_SCHED;
            PG8_STAGE(PG8_SB(0, 1), b2 + hstep, voffB);
            PG8_WAIT_V(6); PG8_BAR; PG8_MMA(1, 1, At, B1); PG8_BAR;
            PG8_LDB(B0, 1, 0); PG8_SCHED; PG8_LDA(At, 1, 0); PG8_STAGE(PG8_SA(0, 1), a2 + hstep, voffA);
            PG8_WAIT_L(8); PG8_BAR; PG8_WAIT_L(0); PG8_MMA(0, 0, At, B0); PG8_BAR; PG8_SCHED;
            PG8_LDB(B1, 1, 1); PG8_STAGE(PG8_SB(1, 0), b3, voffB);
            PG8_BAR; PG8_WAIT_L(0); PG8_MMA(0, 1, At, B1); PG8_BAR;
            PG8_LDA(At, 1, 1); PG8_STAGE(PG8_SA(1, 0), a3, voffA);
            PG8_BAR; PG8_WAIT_L(0); PG8_MMA(1, 0, At, B0); PG8_BAR; PG8_SCHED;
            PG8_STAGE(PG8_SB(1, 1), b3 + hstep, voffB);
            PG8_WAIT_V(6); PG8_BAR; PG8_MMA(1, 1, At, B1); PG8_BAR;
            }
        }
        if constexpr (ALIGN_EPI) { if (wr == 0) PG8_BAR; }
        if constexpr (!Epi::AFTER_DRAIN) { E(acc, cur, wr, wc, fr, fq); S.done(cur); }
        if (!has_next) break;
#pragma unroll
        for (int a = 0; a < 2; ++a)
#pragma unroll
            for (int b = 0; b < 2; ++b)
#pragma unroll
                for (int m = 0; m < 4; ++m)
#pragma unroll
                    for (int n = 0; n < 2; ++n) acc[a][b][m][n] = (f32x4){0.f, 0.f, 0.f, 0.f};
        cur = nxt; cA = nA; cB = nB; ++ui;
        if constexpr (ALIGN_EPI) { if (wr == 1) PG8_BAR; }
    }
    PG8_WAIT_V(0);
    if constexpr (!ALIGN_EPI) { if (wr == 0) PG8_BAR; }
    PG8_BAR;
    if constexpr (Epi::AFTER_DRAIN) { E.fused(acc, cur, wr, wc, fr, fq, lds, wid, lane); S.done(cur); }
#undef PG8_SA
#undef PG8_SB
#undef PG8_STAGE
#undef PG8_LDA
#undef PG8_LDB
#undef PG8_MMA
#undef PG8_WAIT_V
#undef PG8_WAIT_L
#undef PG8_BAR
#undef PG8_SCHED
}
}

constexpr int DM = 4096, NB = 4, SEQ = 4096, CTXL = 256;
constexpr int MX = NB * SEQ, MC = NB * CTXL, MALL = MX + MC;
constexpr int S5W = 1024, QRANK = 1024, KVRANK = 512, ROPED = 64;
constexpr int INC = 2624, INCP = 2816;
constexpr int NH = 24, DQK = 192, DNOPE = 128, DV = 128;
constexpr int NQ = NH * DQK, NKV = NH * (DNOPE + DV);
constexpr int DFF = 11008, NMOD = 6 * DM;
constexpr float EPS = 1e-6f;
constexpr float QSCALE = 0.07216878364870322f * 1.4426950408889634f;
constexpr int NKT = (CTXL + SEQ) / 64;

constexpr size_t MiB = 1u << 20;
constexpr size_t WS_CTL = 0, CTL_ZERO_BYTES = 1 * MiB;
constexpr size_t WS_MOD = 1 * MiB;
constexpr size_t WS_S5A = 2 * MiB;
constexpr size_t WS_S5BR = 2 * MiB + 65536;
constexpr size_t WS_S5BI = WS_S5BR + 524288;
constexpr size_t WS_ROPE = 4 * MiB;
constexpr size_t WS_PART = 5 * MiB;
constexpr size_t WS_WIN = 16 * MiB, WS_WUQ = 38 * MiB, WS_WUKV = 47 * MiB, WS_WGLU = 53 * MiB, WS_WOUT = 55 * MiB, WS_WFIN = 87 * MiB, WS_WDOWN = 259 * MiB;
constexpr size_t WS_R1 = 345 * MiB, WS_R2 = 1033 * MiB, WS_END = 1377 * MiB;
constexpr size_t WS_H = WS_R1, WS_PX = WS_R1 + 136 * MiB, WS_QCN = WS_R1 + 230 * MiB, WS_KVCN = WS_R1 + 262 * MiB, WS_KROPE = WS_R1 + 279 * MiB, WS_Q = WS_R1 + 282 * MiB, WS_KV = WS_R1 + 426 * MiB;
constexpr size_t WS_MIX = WS_R1, WS_GU = WS_R1, WS_F = WS_R1;
constexpr size_t WS_MIXIN = WS_R2, WS_YG = WS_R2 + 128 * MiB, WS_YDIR = WS_R2 + 160 * MiB, WS_HX = WS_R2, WS_ACT = WS_R2;
constexpr size_t WS_S5W1 = WS_R2 + 288 * MiB, WS_S5LAG = WS_R2 + 320 * MiB, WS_S5PW = WS_R2 + 325 * MiB, WS_S5AT = WS_R2 + 330 * MiB, WS_S5W3 = WS_R1 + 630 * MiB;
static_assert(WS_KV + (size_t)MALL * NKV * 2 <= WS_S5W3 && WS_S5W3 + 32 * MiB <= WS_R2 && WS_S5AT + 65536 <= WS_END && (size_t)128 * 65 * 64 * 8 <= 5 * MiB, "ws map (s5)");
static_assert(WS_KV + (size_t)MALL * NKV * 2 <= WS_R2 && WS_YDIR + (size_t)2 * MX * S5W * 4 <= WS_END && WS_GU + (size_t)MX * 2 * DFF * 2 <= WS_R2 && WS_ACT + (size_t)MX * DFF * 2 <= WS_END, "ws map");
static_assert(WS_WIN + (size_t)INCP * DM * 2 <= WS_WUQ && WS_WFIN + (size_t)2 * DFF * DM * 2 <= WS_WDOWN && WS_WDOWN + (size_t)DM * DFF * 2 <= WS_R1 && WS_PART + (size_t)16 * 5 * NMOD * 4 <= WS_WIN, "ws map (weights)");
constexpr int CW_BAR = 4096;

constexpr int RING_BYTES = 131072;
constexpr int LDSCTL_OFF = RING_BYTES, MISC_OFF = LDSCTL_OFF + 320;
constexpr int LDS_BYTES = 147456;
constexpr int NWAVES = 8;

#define GAS __attribute__((address_space(1)))
#define LAS __attribute__((address_space(3)))
typedef unsigned short bf16;
typedef unsigned v4u __attribute__((ext_vector_type(4)));
typedef unsigned v2u __attribute__((ext_vector_type(2)));
typedef float f32x4 __attribute__((ext_vector_type(4)));
#define LDS_WAIT() asm volatile("s_waitcnt lgkmcnt(0)" ::: "memory")
__device__ __forceinline__ unsigned f2bf(float f) { unsigned u = __builtin_bit_cast(unsigned, f); return (u + 0x7fffu + ((u >> 16) & 1u)) >> 16; }
__device__ __forceinline__ unsigned pk2(float lo, float hi) { return f2bf(lo) | (f2bf(hi) << 16); }
__device__ __forceinline__ float bflo(unsigned w) { return __uint_as_float(w << 16); }
__device__ __forceinline__ float bfhi(unsigned w) { return __uint_as_float(w & 0xffff0000u); }
__device__ __forceinline__ float wave_sum(float v) {
#pragma unroll
    for (int o = 1; o < 64; o <<= 1) v += __shfl_xor(v, o);
    return v;
}

#define XB_TMO      128
#define XB_XCNT(j)  (256  + 64 * (j))
#define XB_XSUB(j)  (1280 + 64 * (j))
#define XB_XGEN(j)  (2304 + 64 * (j))
#define XB_TOP      3328
#define XB_TOPGEN   3392
#define XCD_BAR_WORDS 3456
#define XB_SPIN_CAP (1u << 18)

__device__ __forceinline__ unsigned xb_ld(unsigned* p)              { return __hip_atomic_load(p, __ATOMIC_RELAXED, __HIP_MEMORY_SCOPE_AGENT); }
__device__ __forceinline__ unsigned xb_add(unsigned* p, unsigned v) { return __hip_atomic_fetch_add(p, v, __ATOMIC_RELAXED, __HIP_MEMORY_SCOPE_AGENT); }
__device__ __forceinline__ unsigned xb_xcc_id() { return (unsigned)__builtin_amdgcn_s_getreg((3 << 11) | 20) & 0xFu; }
#define XB_SPIN(cond, bar) do { unsigned _sp = 0; while (cond) { __builtin_amdgcn_s_sleep(1); \
    if ((++_sp & 255u) == 0u) { if (xb_ld(&(bar)[XB_TMO])) break; if (_sp > XB_SPIN_CAP) { atomicAdd(&(bar)[XB_TMO], 1u); break; } } } } while (0)

struct XcdBarrier {
    unsigned* bar; unsigned x;
    volatile LAS unsigned* st;
};

__device__ __forceinline__ XcdBarrier xcd_barrier_post(unsigned* bar, volatile LAS unsigned* st) {
    XcdBarrier b; b.bar = bar; b.x = xb_xcc_id(); b.st = st;
    if (threadIdx.x == 0) (void)xb_add(&bar[XB_XCNT(b.x)], 1u);
    return b;
}
__device__ __forceinline__ void xcd_barrier_complete(unsigned* bar, unsigned x, unsigned& nloc, unsigned& nx) {
    const unsigned G = gridDim.x * gridDim.y * gridDim.z;
    unsigned sum, cnt, mine, sp = 0u;
    for (;;) {
        sum = 0u; cnt = 0u; mine = 0u;
#pragma unroll
        for (unsigned j = 0; j < 16; ++j) { const unsigned c = xb_ld(&bar[XB_XCNT(j)]); sum += c; cnt += (c > 0u) ? 1u : 0u; mine = (j == x) ? c : mine; }
        if (sum == G) break;
        __builtin_amdgcn_s_sleep(1);
        if ((++sp & 255u) == 0u) { if (xb_ld(&bar[XB_TMO])) break; if (sp > XB_SPIN_CAP) { atomicAdd(&bar[XB_TMO], 1u); break; } }
    }
    nloc = mine > 0u ? mine : 1u; nx = cnt > 0u ? cnt : 1u;
}

__device__ __forceinline__ void xcd_barrier(const XcdBarrier& b) {
    asm volatile("s_waitcnt vmcnt(0)" ::: "memory");
    __syncthreads();
    if (threadIdx.x == 0) {
        unsigned* bar = b.bar;
        __builtin_amdgcn_s_waitcnt(0);
        unsigned nloc = b.st[0], nx = b.st[1];
        if (nloc == 0u) { xcd_barrier_complete(bar, b.x, nloc, nx); b.st[0] = nloc; b.st[1] = nx; }
        const unsigned old = xb_add(&bar[XB_XSUB(b.x)], 1u);
        const unsigned gen = old / nloc;
        if (old + 1u == (gen + 1u) * nloc) {
            __builtin_amdgcn_fence(__ATOMIC_RELEASE, "agent");
            asm volatile("s_waitcnt vmcnt(0)" ::: "memory");
            const unsigned og = xb_add(&bar[XB_TOP], 1u);
            const unsigned tg = og / nx;
            if (og + 1u == (tg + 1u) * nx) xb_add(&bar[XB_TOPGEN], 1u);
            else XB_SPIN(xb_ld(&bar[XB_TOPGEN]) == tg, bar);
            __builtin_amdgcn_fence(__ATOMIC_ACQUIRE, "agent");
            xb_add(&bar[XB_XGEN(b.x)], 1u);
            asm volatile("s_waitcnt vmcnt(0)" ::: "memory");
        } else {
            XB_SPIN(xb_ld(&bar[XB_XGEN(b.x)]) == gen, bar);
            __builtin_amdgcn_fence(__ATOMIC_ACQUIRE, "agent");
            asm volatile("s_waitcnt vmcnt(0)" ::: "memory");
        }
    }
    __syncthreads();
}

__device__ __forceinline__ void p0_transpose_item(const float* W, int K, int N, bf16* WT, LAS float* scr, int item, int lane) {
    const int nblk = N / 32, kb = item / nblk, nb = item % nblk, k0 = 64 * kb, n0 = 32 * nb;
#pragma unroll 8
    for (int i = 0; i < 32; ++i) { const int kk = 2 * i + (lane >> 5); scr[kk * 33 + (lane & 31)] = W[(size_t)(k0 + kk) * N + n0 + (lane & 31)]; }
    LDS_WAIT(); asm volatile("" ::: "memory");
    const int c = lane & 7;
#pragma unroll
    for (int j = 0; j < 4; ++j) { const int n = (lane >> 3) + 8 * j; const LAS float* s = scr + (8 * c) * 33 + n;
        v4u o; o.x = pk2(s[0 * 33], s[1 * 33]); o.y = pk2(s[2 * 33], s[3 * 33]); o.z = pk2(s[4 * 33], s[5 * 33]); o.w = pk2(s[6 * 33], s[7 * 33]);
        *(GAS v4u*)(WT + (size_t)(n0 + n) * K + k0 + 8 * c) = o; }
    LDS_WAIT(); asm volatile("" ::: "memory");
}
__device__ __forceinline__ void p0_ada_item(const float* c, const float* cctx, const float* w_ada, float* part, int item, int lane) {
    const int nb = item % 96, ks = item / 96, n0 = nb * 256 + lane * 4, k0 = ks * 256;
    f32x4 acc[5];
#pragma unroll
    for (int r = 0; r < 5; ++r) acc[r] = (f32x4){0.f, 0.f, 0.f, 0.f};
    for (int kk = 0; kk < 256; kk += 4) {
        f32x4 w[4];
#pragma unroll
        for (int j = 0; j < 4; ++j) w[j] = *(const GAS f32x4*)(w_ada + (size_t)(k0 + kk + j) * NMOD + n0);
#pragma unroll
        for (int j = 0; j < 4; ++j) {
#pragma unroll
            for (int r = 0; r < 5; ++r) { const float cv = (r < 4) ? c[r * DM + k0 + kk + j] : cctx[k0 + kk + j]; const float s = cv / (1.f + expf(-cv)); acc[r] += w[j] * s; }
        }
    }
#pragma unroll
    for (int r = 0; r < 5; ++r) *(GAS f32x4*)(part + (size_t)(ks * 5 + r) * NMOD + n0) = acc[r];
}

struct P {
    const float *x, *c, *ctx, *cctx, *w_ada, *b_ada, *g_pre_mix, *g_post_mix, *g_pre_ffn, *g_post_ffn, *w_in;
    const float *lam_re, *lam_im, *log_step, *b_re, *b_im, *c_re, *c_im, *s5d, *w_glu, *g_q, *w_uq, *g_kv, *w_ukv, *w_out, *ffn_w_in, *conv_w, *conv_b, *ffn_w_down;
    float* out;
    float *mod, *abar, *bbr, *bbi, *rope, *part, *mix, *f, *ydir;
    bf16 *WinT, *WuqT, *WukvT, *WgluT, *WoutT, *WfinT, *WdownT;
    bf16 *h, *px, *qcn, *kvcn, *krope, *q, *kv, *mixin, *yg, *hx, *gu, *act;
};

__device__ __forceinline__ void phase_prologue(const P& p, LAS unsigned char* lds, int gw, int NGW, int wave, int lane, int gtid, int NGT) {
    LAS float* scr = (LAS float*)(lds + wave * 16384);
    constexpr int I_IN = (DM / 64) * (INC / 32), I_UQ = (QRANK / 64) * (NQ / 32), I_UKV = (KVRANK / 64) * (NKV / 32), I_GLU = (S5W / 64) * (S5W / 32),
                  I_OUT = (DM / 64) * (DM / 32), I_FIN = (DM / 64) * (2 * DFF / 32), I_DOWN = (DFF / 64) * (DM / 32), I_ADA = 96 * 16;
    constexpr int NITEMS = I_ADA + I_IN + I_UQ + I_UKV + I_GLU + I_OUT + I_FIN + I_DOWN;
    for (int it = gw; it < NITEMS; it += NGW) {
        int r = it;
        if (r < I_ADA) { p0_ada_item(p.c, p.cctx, p.w_ada, p.part, r, lane); continue; } r -= I_ADA;
        if (r < I_IN) { p0_transpose_item(p.w_in, DM, INC, p.WinT, scr, r, lane); continue; } r -= I_IN;
        if (r < I_UQ) { p0_transpose_item(p.w_uq, QRANK, NQ, p.WuqT, scr, r, lane); continue; } r -= I_UQ;
        if (r < I_UKV) { p0_transpose_item(p.w_ukv, KVRANK, NKV, p.WukvT, scr, r, lane); continue; } r -= I_UKV;
        if (r < I_GLU) { p0_transpose_item(p.w_glu, S5W, S5W, p.WgluT, scr, r, lane); continue; } r -= I_GLU;
        if (r < I_OUT) { p0_transpose_item(p.w_out, DM, DM, p.WoutT, scr, r, lane); continue; } r -= I_OUT;
        if (r < I_FIN) { p0_transpose_item(p.ffn_w_in, DM, 2 * DFF, p.WfinT, scr, r, lane); continue; } r -= I_FIN;
        p0_transpose_item(p.ffn_w_down, DFF, DM, p.WdownT, scr, r, lane);
    }
    { GAS v4u* z = (GAS v4u*)(p.WinT + (size_t)INC * DM); const int n16 = (INCP - INC) * DM * 2 / 16; for (int i = gtid; i < n16; i += NGT) z[i] = (v4u){0u, 0u, 0u, 0u}; }
    for (int i = gtid; i < 2 * 64 * 64; i += NGT) {
        const int dg = i >> 6;
        const float lr = p.lam_re[i], li = p.lam_im[i], dt = expf(p.log_step[dg]);
        const float mag = expf(lr * dt); float sn, cs; sincosf(li * dt, &sn, &cs);
        const float ar = mag * cs, ai = mag * sn, den = lr * lr + li * li, nr = ar - 1.f, ni = ai;
        const float fr = (nr * lr + ni * li) / den, fi = (ni * lr - nr * li) / den;
        p.abar[2 * i] = ar; p.abar[2 * i + 1] = ai;
#pragma unroll
        for (int cc = 0; cc < 16; ++cc) { const float br = p.b_re[(size_t)i * 16 + cc], bi = p.b_im[(size_t)i * 16 + cc]; p.bbr[(size_t)i * 16 + cc] = fr * br - fi * bi; p.bbi[(size_t)i * 16 + cc] = fr * bi + fi * br; }
    }
    for (int i = gtid; i < SEQ * 32; i += NGT) {
        const int t = i >> 5, j = i & 31; const float pos = (float)((j < 16) ? (t >> 6) : (t & 63));
        const float inv = powf(10000.f, -(float)(j & 15) * (1.f / 16.f)); float sn, cs; sincosf(pos * inv, &sn, &cs);
        p.rope[2 * i] = cs; p.rope[2 * i + 1] = sn;
    }
}
__device__ __forceinline__ void phase_modreduce(const P& p, int gtid, int NGT) {
    for (int i = gtid; i < 5 * NMOD; i += NGT) { const int n = i % NMOD; float s = p.b_ada[n];
#pragma unroll
        for (int ks = 0; ks < 16; ++ks) s += p.part[(size_t)ks * 5 * NMOD + i];
        p.mod[i] = s; }
}
__device__ __forceinline__ void phase_norm1(const P& p, int gw, int NGW, int lane) {
    for (int row = gw; row < MALL; row += NGW) {
        const float* src = row < MX ? p.x + (size_t)row * DM : p.ctx + (size_t)(row - MX) * DM;
        const float* md = p.mod + (size_t)(row < MX ? row / SEQ : 4) * NMOD;
        const GAS f32x4* xr = (const GAS f32x4*)src + lane;
        f32x4 v[16]; float ss = 0.f;
#pragma unroll
        for (int j = 0; j < 16; ++j) { v[j] = xr[64 * j]; ss += (v[j].x * v[j].x + v[j].y * v[j].y) + (v[j].z * v[j].z + v[j].w * v[j].w); }
        const float rstd = rsqrtf(wave_sum(ss) * (1.f / DM) + EPS);
        GAS unsigned long long* o8 = (GAS unsigned long long*)(p.h + (size_t)row * DM) + lane;
#pragma unroll
        for (int j = 0; j < 16; ++j) { const f32x4 g = ((const GAS f32x4*)p.g_pre_mix)[lane + 64 * j], sh = ((const GAS f32x4*)md)[lane + 64 * j], sc = ((const GAS f32x4*)(md + DM))[lane + 64 * j];
            const f32x4 o = (v[j] * rstd) * g * (sc + 1.f) + sh;
            o8[64 * j] = (unsigned long long)pk2(o.x, o.y) | ((unsigned long long)pk2(o.z, o.w) << 32); }
    }
}
__device__ __forceinline__ void phase_postin(const P& p, int gw, int NGW, int lane) {
    for (int row = gw; row < MALL; row += NGW) {
        const bf16* pr = p.px + (size_t)row * INCP;
        { const v4u w = *(const GAS v4u*)(pr + 2048 + lane * 8);
          float v[8] = {bflo(w.x), bfhi(w.x), bflo(w.y), bfhi(w.y), bflo(w.z), bfhi(w.z), bflo(w.w), bfhi(w.w)}; float ss = 0.f;
#pragma unroll
          for (int j = 0; j < 8; ++j) ss += v[j] * v[j];
          const float rstd = rsqrtf(wave_sum(ss) * (1.f / KVRANK) + EPS);
          const f32x4 g0 = *(const GAS f32x4*)(p.g_kv + lane * 8), g1 = *(const GAS f32x4*)(p.g_kv + lane * 8 + 4);
          v4u o; o.x = pk2(v[0] * rstd * g0.x, v[1] * rstd * g0.y); o.y = pk2(v[2] * rstd * g0.z, v[3] * rstd * g0.w); o.z = pk2(v[4] * rstd * g1.x, v[5] * rstd * g1.y); o.w = pk2(v[6] * rstd * g1.z, v[7] * rstd * g1.w);
          *(GAS v4u*)(p.kvcn + (size_t)row * KVRANK + lane * 8) = o; }
        if (lane < 32) { const unsigned w = *(const GAS unsigned*)(pr + 2560 + lane * 2); float x1 = bflo(w), x2 = bfhi(w);
          if (row < MX) { const int t = row & (SEQ - 1); const float cs = p.rope[((size_t)t * 32 + lane) * 2], sn = p.rope[((size_t)t * 32 + lane) * 2 + 1]; const float a = x1 * cs - x2 * sn, b = x1 * sn + x2 * cs; x1 = a; x2 = b; }
          *(GAS unsigned*)(p.krope + (size_t)row * ROPED + lane * 2) = pk2(x1, x2); }
        if (row < MX) {
          const v4u w0 = *(const GAS v4u*)(pr + 1024 + lane * 8), w1 = *(const GAS v4u*)(pr + 1024 + 512 + lane * 8);
          float v[16] = {bflo(w0.x), bfhi(w0.x), bflo(w0.y), bfhi(w0.y), bflo(w0.z), bfhi(w0.z), bflo(w0.w), bfhi(w0.w), bflo(w1.x), bfhi(w1.x), bflo(w1.y), bfhi(w1.y), bflo(w1.z), bfhi(w1.z), bflo(w1.w), bfhi(w1.w)}; float ss = 0.f;
#pragma unroll
          for (int j = 0; j < 16; ++j) ss += v[j] * v[j];
          const float rstd = rsqrtf(wave_sum(ss) * (1.f / QRANK) + EPS);
#pragma unroll
          for (int hh = 0; hh < 2; ++hh) { const f32x4 g0 = *(const GAS f32x4*)(p.g_q + hh * 512 + lane * 8), g1 = *(const GAS f32x4*)(p.g_q + hh * 512 + lane * 8 + 4);
            v4u o; o.x = pk2(v[8 * hh + 0] * rstd * g0.x, v[8 * hh + 1] * rstd * g0.y); o.y = pk2(v[8 * hh + 2] * rstd * g0.z, v[8 * hh + 3] * rstd * g0.w);
            o.z = pk2(v[8 * hh + 4] * rstd * g1.x, v[8 * hh + 5] * rstd * g1.y); o.w = pk2(v[8 * hh + 6] * rstd * g1.z, v[8 * hh + 7] * rstd * g1.w);
            *(GAS v4u*)(p.qcn + (size_t)row * QRANK + hh * 512 + lane * 8) = o; }
        }
    }
}

__device__ __forceinline__ void phase_attn_v0(const P& p, LAS unsigned char* lds, int blk, int G) {
    constexpr int QS = 400, KS = 400, VS = 272, PS = 272;
    LAS unsigned char* Qs = lds; LAS unsigned char* Ks = lds + 128 * QS; LAS unsigned char* Vs = Ks + 64 * KS; LAS unsigned char* Ps = Vs + 64 * VS;
    const int tid = ltid(), tq = tid >> 4, tk = tid & 15;
    for (int unit = blk; unit < NB * NH * (SEQ / 128); unit += G) {
        const int qt = unit % (SEQ / 128), bh = unit / (SEQ / 128), b = bh / NH, hd = bh % NH;
        const size_t qrow0 = (size_t)b * SEQ + qt * 128;
        __syncthreads();
        for (int c = tid; c < 128 * 24; c += 512) { const int r = c / 24, part = c % 24; *(LAS v4u*)(Qs + r * QS + part * 16) = *(const GAS v4u*)(p.q + (qrow0 + r) * NQ + hd * DQK + part * 8); }
        float m[4], l[4], o[4][8];
#pragma unroll
        for (int i = 0; i < 4; ++i) { m[i] = -INFINITY; l[i] = 0.f;
#pragma unroll
            for (int e = 0; e < 8; ++e) o[i][e] = 0.f; }
        for (int kt = 0; kt < NKT; ++kt) {
            __syncthreads();
            for (int c = tid; c < 64 * 24; c += 512) { const int kk = c / 24, part = c % 24; const int n = kt * 64 + kk; const size_t row = n < CTXL ? (size_t)MX + b * CTXL + n : (size_t)b * SEQ + (n - CTXL);
                const v4u w = part < 16 ? *(const GAS v4u*)(p.kv + row * NKV + hd * 256 + part * 8) : *(const GAS v4u*)(p.krope + row * ROPED + (part - 16) * 8);
                *(LAS v4u*)(Ks + kk * KS + part * 16) = w; }
            for (int c = tid; c < 64 * 16; c += 512) { const int kk = c / 16, part = c % 16; const int n = kt * 64 + kk; const size_t row = n < CTXL ? (size_t)MX + b * CTXL + n : (size_t)b * SEQ + (n - CTXL);
                *(LAS v4u*)(Vs + kk * VS + part * 16) = *(const GAS v4u*)(p.kv + row * NKV + hd * 256 + 128 + part * 8); }
            __syncthreads();
            float s[4][4];
#pragma unroll
            for (int i = 0; i < 4; ++i)
#pragma unroll
                for (int j = 0; j < 4; ++j) s[i][j] = 0.f;
            for (int d = 0; d < 24; ++d) {
                v4u qv[4], kv4[4];
#pragma unroll
                for (int i = 0; i < 4; ++i) { qv[i] = *(const LAS v4u*)(Qs + (4 * tq + i) * QS + d * 16); kv4[i] = *(const LAS v4u*)(Ks + (4 * tk + i) * KS + d * 16); }
#pragma unroll
                for (int i = 0; i < 4; ++i)
#pragma unroll
                    for (int j = 0; j < 4; ++j) {
                        s[i][j] += bflo(qv[i].x) * bflo(kv4[j].x) + bfhi(qv[i].x) * bfhi(kv4[j].x) + bflo(qv[i].y) * bflo(kv4[j].y) + bfhi(qv[i].y) * bfhi(kv4[j].y)
                                 + bflo(qv[i].z) * bflo(kv4[j].z) + bfhi(qv[i].z) * bfhi(kv4[j].z) + bflo(qv[i].w) * bflo(kv4[j].w) + bfhi(qv[i].w) * bfhi(kv4[j].w); }
            }
#pragma unroll
            for (int i = 0; i < 4; ++i) {
                float rm = fmaxf(fmaxf(s[i][0], s[i][1]), fmaxf(s[i][2], s[i][3]));
                rm = fmaxf(rm, __shfl_xor(rm, 1)); rm = fmaxf(rm, __shfl_xor(rm, 2)); rm = fmaxf(rm, __shfl_xor(rm, 4)); rm = fmaxf(rm, __shfl_xor(rm, 8));
                const float mn = fmaxf(m[i], rm), alpha = exp2f(m[i] - mn); m[i] = mn;
                float rs = 0.f;
#pragma unroll
                for (int j = 0; j < 4; ++j) { s[i][j] = exp2f(s[i][j] - mn); rs += s[i][j]; }
                rs += __shfl_xor(rs, 1); rs += __shfl_xor(rs, 2); rs += __shfl_xor(rs, 4); rs += __shfl_xor(rs, 8);
                l[i] = l[i] * alpha + rs;
#pragma unroll
                for (int e = 0; e < 8; ++e) o[i][e] *= alpha;
                *(LAS f32x4*)(Ps + (4 * tq + i) * PS + tk * 16) = (f32x4){s[i][0], s[i][1], s[i][2], s[i][3]};
            }
            __syncthreads();
            for (int j = 0; j < 64; ++j) {
                const v4u vv = *(const LAS v4u*)(Vs + j * VS + tk * 16);
                const float v8[8] = {bflo(vv.x), bfhi(vv.x), bflo(vv.y), bfhi(vv.y), bflo(vv.z), bfhi(vv.z), bflo(vv.w), bfhi(vv.w)};
#pragma unroll
                for (int i = 0; i < 4; ++i) { const float pj = *(const LAS float*)(Ps + (4 * tq + i) * PS + j * 4);
#pragma unroll
                    for (int e = 0; e < 8; ++e) o[i][e] += pj * v8[e]; }
            }
        }
#pragma unroll
        for (int i = 0; i < 4; ++i) { const float rl = 1.f / l[i];
            v4u w; w.x = pk2(o[i][0] * rl, o[i][1] * rl); w.y = pk2(o[i][2] * rl, o[i][3] * rl); w.z = pk2(o[i][4] * rl, o[i][5] * rl); w.w = pk2(o[i][6] * rl, o[i][7] * rl);
            *(GAS v4u*)(p.mixin + (qrow0 + 4 * tq + i) * DM + S5W + hd * DV + tk * 8) = w; }
    }
}

__device__ __forceinline__ void phase_s5_v0(const P& p, LAS unsigned char* lds, int blk, int G, int wave, int lane) {
    if (wave >= 2) return;
    LAS float* ul = (LAS float*)(lds + wave * 49152);
    LAS float* hbr = ul + 1024;
    LAS float* hbi = hbr + 64 * 65;
    LAS float* Cl = hbi + 64 * 65;
    for (int unit = blk + G * wave; unit < NB * 2 * 64; unit += 2 * G) {
        const int g = unit & 63, dir = (unit >> 6) & 1, b = unit >> 7;
        const int sidx = (dir * 64 + g) * 64 + lane;
        const float ar = p.abar[2 * sidx], ai = p.abar[2 * sidx + 1];
        float bbr[16], bbi[16];
#pragma unroll
        for (int cc = 0; cc < 16; ++cc) { bbr[cc] = p.bbr[(size_t)sidx * 16 + cc]; bbi[cc] = p.bbi[(size_t)sidx * 16 + cc]; }
        LDS_WAIT();
#pragma unroll
        for (int cc = 0; cc < 16; ++cc) { Cl[lane * 32 + cc] = p.c_re[((size_t)(dir * 64 + g) * 16 + cc) * 64 + lane]; Cl[lane * 32 + 16 + cc] = p.c_im[((size_t)(dir * 64 + g) * 16 + cc) * 64 + lane]; }
        float hr = 0.f, hi = 0.f;
        for (int k = 0; k < NKT; ++k) {
            { const int s = k * 64 + lane; size_t row;
              if (dir == 0) row = s < CTXL ? (size_t)MX + b * CTXL + s : (size_t)b * SEQ + (s - CTXL);
              else row = s < CTXL ? (size_t)MX + b * CTXL + (CTXL - 1 - s) : (size_t)b * SEQ + (SEQ - 1 - (s - CTXL));
              const v4u w0 = *(const GAS v4u*)(p.px + row * INCP + g * 16), w1 = *(const GAS v4u*)(p.px + row * INCP + g * 16 + 8);
              LDS_WAIT();
              *(LAS f32x4*)(ul + lane * 16) = (f32x4){bflo(w0.x), bfhi(w0.x), bflo(w0.y), bfhi(w0.y)}; *(LAS f32x4*)(ul + lane * 16 + 4) = (f32x4){bflo(w0.z), bfhi(w0.z), bflo(w0.w), bfhi(w0.w)};
              *(LAS f32x4*)(ul + lane * 16 + 8) = (f32x4){bflo(w1.x), bfhi(w1.x), bflo(w1.y), bfhi(w1.y)}; *(LAS f32x4*)(ul + lane * 16 + 12) = (f32x4){bflo(w1.z), bfhi(w1.z), bflo(w1.w), bfhi(w1.w)}; }
            LDS_WAIT();
#pragma unroll 4
            for (int j = 0; j < 64; ++j) {
                const f32x4 u0 = *(const LAS f32x4*)(ul + j * 16), u1 = *(const LAS f32x4*)(ul + j * 16 + 4), u2 = *(const LAS f32x4*)(ul + j * 16 + 8), u3 = *(const LAS f32x4*)(ul + j * 16 + 12);
                const float uu[16] = {u0.x, u0.y, u0.z, u0.w, u1.x, u1.y, u1.z, u1.w, u2.x, u2.y, u2.z, u2.w, u3.x, u3.y, u3.z, u3.w};
                float bur = 0.f, bui = 0.f;
#pragma unroll
                for (int cc = 0; cc < 16; ++cc) { bur += bbr[cc] * uu[cc]; bui += bbi[cc] * uu[cc]; }
                const float nhr = ar * hr - ai * hi + bur, nhi = ar * hi + ai * hr + bui; hr = nhr; hi = nhi;
                if (k >= CTXL / 64) { hbr[j * 65 + lane] = hr; hbi[j * 65 + lane] = hi; }
            }
            if (k >= CTXL / 64) {
                LDS_WAIT();
                float acc[16];
#pragma unroll
                for (int cc = 0; cc < 16; ++cc) acc[cc] = 0.f;
#pragma unroll 2
                for (int pp = 0; pp < 64; ++pp) {
                    const float xr = hbr[lane * 65 + pp], xi = hbi[lane * 65 + pp];
                    const f32x4 r0 = *(const LAS f32x4*)(Cl + pp * 32), r1 = *(const LAS f32x4*)(Cl + pp * 32 + 4), r2 = *(const LAS f32x4*)(Cl + pp * 32 + 8), r3 = *(const LAS f32x4*)(Cl + pp * 32 + 12);
                    const f32x4 i0 = *(const LAS f32x4*)(Cl + pp * 32 + 16), i1 = *(const LAS f32x4*)(Cl + pp * 32 + 20), i2 = *(const LAS f32x4*)(Cl + pp * 32 + 24), i3 = *(const LAS f32x4*)(Cl + pp * 32 + 28);
                    const float cr[16] = {r0.x, r0.y, r0.z, r0.w, r1.x, r1.y, r1.z, r1.w, r2.x, r2.y, r2.z, r2.w, r3.x, r3.y, r3.z, r3.w};
                    const float ci[16] = {i0.x, i0.y, i0.z, i0.w, i1.x, i1.y, i1.z, i1.w, i2.x, i2.y, i2.z, i2.w, i3.x, i3.y, i3.z, i3.w};
#pragma unroll
                    for (int cc = 0; cc < 16; ++cc) acc[cc] += cr[cc] * xr - ci[cc] * xi;
                }
                const int s = k * 64 + lane - CTXL; const int t = dir == 0 ? s : SEQ - 1 - s;
                GAS f32x4* yo = (GAS f32x4*)(p.ydir + ((size_t)dir * MX + (size_t)b * SEQ + t) * S5W + g * 16);
                yo[0] = (f32x4){acc[0], acc[1], acc[2], acc[3]}; yo[1] = (f32x4){acc[4], acc[5], acc[6], acc[7]}; yo[2] = (f32x4){acc[8], acc[9], acc[10], acc[11]}; yo[3] = (f32x4){acc[12], acc[13], acc[14], acc[15]};
            }
        }
    }
}
__device__ __forceinline__ void phase_s5gelu(const P& p, int gtid, int NGT) {
    for (int i = gtid; i < MX * (S5W / 8); i += NGT) {
        const int row = i >> 7, c0 = (i & 127) * 8;
        const v4u uw = *(const GAS v4u*)(p.px + (size_t)row * INCP + c0);
        const float u[8] = {bflo(uw.x), bfhi(uw.x), bflo(uw.y), bfhi(uw.y), bflo(uw.z), bfhi(uw.z), bflo(uw.w), bfhi(uw.w)};
        const f32x4 a0 = *(const GAS f32x4*)(p.ydir + (size_t)row * S5W + c0), a1 = *(const GAS f32x4*)(p.ydir + (size_t)row * S5W + c0 + 4);
        const f32x4 b0 = *(const GAS f32x4*)(p.ydir + ((size_t)MX + row) * S5W + c0), b1 = *(const GAS f32x4*)(p.ydir + ((size_t)MX + row) * S5W + c0 + 4);
        const f32x4 d0 = *(const GAS f32x4*)(p.s5d + c0), d1 = *(const GAS f32x4*)(p.s5d + c0 + 4);
        const float y[8] = {d0.x * u[0] + a0.x + b0.x, d0.y * u[1] + a0.y + b0.y, d0.z * u[2] + a0.z + b0.z, d0.w * u[3] + a0.w + b0.w, d1.x * u[4] + a1.x + b1.x, d1.y * u[5] + a1.y + b1.y, d1.z * u[6] + a1.z + b1.z, d1.w * u[7] + a1.w + b1.w};
        float gl[8];
#pragma unroll
        for (int j = 0; j < 8; ++j) { const float v = y[j]; gl[j] = 0.5f * v * (1.f + tanhf(0.7978845608028654f * (v + 0.044715f * v * v * v))); }
        v4u o; o.x = pk2(gl[0], gl[1]); o.y = pk2(gl[2], gl[3]); o.z = pk2(gl[4], gl[5]); o.w = pk2(gl[6], gl[7]);
        *(GAS v4u*)(p.yg + (size_t)row * S5W + c0) = o;
    }
}
__device__ __forceinline__ void phase_mid(const P& p, int gw, int NGW, int lane) {
    for (int row = gw; row < MX; row += NGW) {
        const float* md = p.mod + (size_t)(row / SEQ) * NMOD;
        const GAS f32x4* mr = (const GAS f32x4*)(p.mix + (size_t)row * DM) + lane; const GAS f32x4* xr = (const GAS f32x4*)(p.x + (size_t)row * DM) + lane;
        f32x4 v[16]; float ss = 0.f;
#pragma unroll
        for (int j = 0; j < 16; ++j) { v[j] = mr[64 * j]; ss += (v[j].x * v[j].x + v[j].y * v[j].y) + (v[j].z * v[j].z + v[j].w * v[j].w); }
        const float rstd = rsqrtf(wave_sum(ss) * (1.f / DM) + EPS); float s2 = 0.f;
        GAS f32x4* xo = (GAS f32x4*)(p.out + (size_t)row * DM) + lane;
#pragma unroll
        for (int j = 0; j < 16; ++j) { const f32x4 g = ((const GAS f32x4*)p.g_post_mix)[lane + 64 * j], ga = ((const GAS f32x4*)(md + 2 * DM))[lane + 64 * j];
            v[j] = xr[64 * j] + ga * ((v[j] * rstd) * g); xo[64 * j] = v[j]; s2 += (v[j].x * v[j].x + v[j].y * v[j].y) + (v[j].z * v[j].z + v[j].w * v[j].w); }
        const float rstd2 = rsqrtf(wave_sum(s2) * (1.f / DM) + EPS);
        GAS unsigned long long* o8 = (GAS unsigned long long*)(p.hx + (size_t)row * DM) + lane;
#pragma unroll
        for (int j = 0; j < 16; ++j) { const f32x4 g = ((const GAS f32x4*)p.g_pre_ffn)[lane + 64 * j], sh = ((const GAS f32x4*)(md + 3 * DM))[lane + 64 * j], sc = ((const GAS f32x4*)(md + 4 * DM))[lane + 64 * j];
            const f32x4 o = (v[j] * rstd2) * g * (sc + 1.f) + sh;
            o8[64 * j] = (unsigned long long)pk2(o.x, o.y) | ((unsigned long long)pk2(o.z, o.w) << 32); }
    }
}
__device__ __forceinline__ void phase_convact(const P& p, int gtid, int NGT) {
    constexpr int CB = DFF / 8;
    for (int it = gtid; it < (MX / 16) * CB; it += NGT) {
        const int cb = it % CB, rb = it / CB, c0 = cb * 8, r0 = rb * 16;
        float w0[8], w1[8], w2[8], bb[8];
#pragma unroll
        for (int j = 0; j < 8; ++j) { w0[j] = p.conv_w[c0 + j]; w1[j] = p.conv_w[DFF + c0 + j]; w2[j] = p.conv_w[2 * DFF + c0 + j]; bb[j] = p.conv_b[c0 + j]; }
        float gp[8], gc[8], gn[8];
        { const bool has = (r0 & (SEQ - 1)) != 0; v4u w = (v4u){0u, 0u, 0u, 0u}; if (has) w = *(const GAS v4u*)(p.gu + (size_t)(r0 - 1) * (2 * DFF) + c0);
          gp[0] = bflo(w.x); gp[1] = bfhi(w.x); gp[2] = bflo(w.y); gp[3] = bfhi(w.y); gp[4] = bflo(w.z); gp[5] = bfhi(w.z); gp[6] = bflo(w.w); gp[7] = bfhi(w.w); }
        { const v4u w = *(const GAS v4u*)(p.gu + (size_t)r0 * (2 * DFF) + c0);
          gc[0] = bflo(w.x); gc[1] = bfhi(w.x); gc[2] = bflo(w.y); gc[3] = bfhi(w.y); gc[4] = bflo(w.z); gc[5] = bfhi(w.z); gc[6] = bflo(w.w); gc[7] = bfhi(w.w); }
        for (int r = 0; r < 16; ++r) {
            const int row = r0 + r; const bool has = ((row + 1) & (SEQ - 1)) != 0; v4u w = (v4u){0u, 0u, 0u, 0u}; if (has) w = *(const GAS v4u*)(p.gu + (size_t)(row + 1) * (2 * DFF) + c0);
            gn[0] = bflo(w.x); gn[1] = bfhi(w.x); gn[2] = bflo(w.y); gn[3] = bfhi(w.y); gn[4] = bflo(w.z); gn[5] = bfhi(w.z); gn[6] = bflo(w.w); gn[7] = bfhi(w.w);
            const v4u uw = *(const GAS v4u*)(p.gu + (size_t)row * (2 * DFF) + DFF + c0);
            const float up[8] = {bflo(uw.x), bfhi(uw.x), bflo(uw.y), bfhi(uw.y), bflo(uw.z), bfhi(uw.z), bflo(uw.w), bfhi(uw.w)};
            float a[8];
#pragma unroll
            for (int j = 0; j < 8; ++j) { const float cv = w0[j] * gp[j] + w1[j] * gc[j] + w2[j] * gn[j] + bb[j]; a[j] = cv / (1.f + __expf(-cv)) * up[j]; gp[j] = gc[j]; gc[j] = gn[j]; }
            v4u o; o.x = pk2(a[0], a[1]); o.y = pk2(a[2], a[3]); o.z = pk2(a[4], a[5]); o.w = pk2(a[6], a[7]);
            *(GAS v4u*)(p.act + (size_t)row * DFF + c0) = o;
        }
    }
}
__device__ __forceinline__ void phase_final(const P& p, int gw, int NGW, int lane) {
    for (int row = gw; row < MX; row += NGW) {
        const float* md = p.mod + (size_t)(row / SEQ) * NMOD;
        const GAS f32x4* fr = (const GAS f32x4*)(p.f + (size_t)row * DM) + lane;
        f32x4 v[16]; float ss = 0.f;
#pragma unroll
        for (int j = 0; j < 16; ++j) { v[j] = fr[64 * j]; ss += (v[j].x * v[j].x + v[j].y * v[j].y) + (v[j].z * v[j].z + v[j].w * v[j].w); }
        const float rstd = rsqrtf(wave_sum(ss) * (1.f / DM) + EPS);
        GAS f32x4* xo = (GAS f32x4*)(p.out + (size_t)row * DM) + lane;
#pragma unroll
        for (int j = 0; j < 16; ++j) { const f32x4 g = ((const GAS f32x4*)p.g_post_ffn)[lane + 64 * j], ga = ((const GAS f32x4*)(md + 5 * DM))[lane + 64 * j];
            xo[64 * j] = xo[64 * j] + ga * ((v[j] * rstd) * g); }
    }
}

namespace att {
typedef short bf16x8 __attribute__((ext_vector_type(8)));
typedef short s16x4 __attribute__((ext_vector_type(4)));
typedef float f32x16 __attribute__((ext_vector_type(16)));
typedef unsigned u32x4 __attribute__((ext_vector_type(4)));
constexpr int KROWB = 384, KSLOT = 64 * KROWB, VSLOT = 16384, NSLOT = 3;
constexpr int L_K = 0, L_V = NSLOT * KSLOT, L_WS = L_V + NSLOT * VSLOT, L_END = L_WS + 8 * 256;
constexpr int OST_STRIDE = 272, OST_WAVE = 32 * OST_STRIDE;
static_assert(L_END <= 131072 && 8 * OST_WAVE <= L_V, "attention LDS map");
constexpr float THR2 = 8.f;
#define ATT_SBAR() __builtin_amdgcn_sched_barrier(0)
__device__ __forceinline__ int crow(int r, int hi) { return (r & 3) + 8 * (r >> 2) + 4 * hi; }
__device__ __forceinline__ unsigned cvtpk(float lo, float hi) { unsigned r; asm volatile("v_cvt_pk_bf16_f32 %0, %1, %2" : "=v"(r) : "v"(lo), "v"(hi)); return r; }
__device__ __forceinline__ void glds16(const void* gsrc, unsigned lds_dst) { unsigned keep;
    asm volatile("s_mov_b32 %0, m0\n\ts_mov_b32 m0, %2\n\ts_nop 0\n\tglobal_load_lds_dwordx4 %1, off\n\ts_mov_b32 m0, %0" : "=&s"(keep) : "v"(gsrc), "s"(lds_dst) : "memory"); }
#define ATT_WAITBAR(N) asm volatile("s_waitcnt vmcnt(" #N ") lgkmcnt(0)\n\ts_barrier" ::: "memory")

__device__ __forceinline__ void partialSM(f32x16& p0, f32x16& p1, float& m_reg, float& alpha) {
    float pmax = p0[0];
#pragma unroll
    for (int r = 1; r < 16; ++r) pmax = fmaxf(pmax, p0[r]);
#pragma unroll
    for (int r = 0; r < 16; ++r) pmax = fmaxf(pmax, p1[r]);
    { auto rr = __builtin_amdgcn_permlane32_swap(__float_as_uint(pmax), __float_as_uint(pmax), false, false); pmax = fmaxf(__uint_as_float(rr[0]), __uint_as_float(rr[1])); }
    float mn;
    if (__builtin_expect(__all(pmax - m_reg <= THR2), 1)) { mn = m_reg; alpha = 1.f; }
    else { mn = fmaxf(m_reg, pmax); alpha = __builtin_amdgcn_exp2f(m_reg - mn); m_reg = mn; }
#pragma unroll
    for (int r = 0; r < 16; ++r) { p0[r] -= mn; p1[r] -= mn; }
#pragma unroll
    for (int r = 0; r < 16; ++r) p0[r] = __builtin_amdgcn_exp2f(p0[r]);
}
__device__ __forceinline__ void finishSM(f32x16& p0, f32x16& p1, float alpha, float& l_reg, bf16x8& pa0, bf16x8& pa1, bf16x8& pa2, bf16x8& pa3) {
#pragma unroll
    for (int r = 0; r < 16; ++r) p1[r] = __builtin_amdgcn_exp2f(p1[r]);
    float ps = 0.f;
#pragma unroll
    for (int r = 0; r < 16; ++r) ps += p0[r];
#pragma unroll
    for (int r = 0; r < 16; ++r) ps += p1[r];
    { auto rr = __builtin_amdgcn_permlane32_swap(__float_as_uint(ps), __float_as_uint(ps), false, false); ps = __uint_as_float(rr[0]) + __uint_as_float(rr[1]); }
    l_reg = l_reg * alpha + ps;
#define ATT_PK4(P, BASE, OUT) do { unsigned a0 = cvtpk(P[BASE + 0], P[BASE + 1]), a1 = cvtpk(P[BASE + 2], P[BASE + 3]);   \
    unsigned b0 = cvtpk(P[BASE + 4], P[BASE + 5]), b1 = cvtpk(P[BASE + 6], P[BASE + 7]);                              \
    auto r0 = __builtin_amdgcn_permlane32_swap(a0, b0, false, false); auto r1 = __builtin_amdgcn_permlane32_swap(a1, b1, false, false); \
    u32x4 w = {r0[0], r1[0], r0[1], r1[1]}; OUT = __builtin_bit_cast(bf16x8, w); } while (0)
    ATT_PK4(p0, 0, pa0); ATT_PK4(p0, 8, pa1); ATT_PK4(p1, 0, pa2); ATT_PK4(p1, 8, pa3);
#undef ATT_PK4
}
__device__ __forceinline__ void qkt(f32x16& p0, f32x16& p1, const LAS unsigned char* Ks, const bf16x8 (&qr)[12], int r32, int hi) {
    p0 = f32x16{}; p1 = f32x16{};
    const int sw = (r32 & 7) << 4; const LAS unsigned char* ra = Ks + r32 * KROWB; const LAS unsigned char* rb = ra + 32 * KROWB;
    int lo[4];
#pragma unroll
    for (int q = 0; q < 4; ++q) lo[q] = (q * 32 + hi * 16) ^ sw;
#pragma unroll
    for (int d0 = 0; d0 < 12; ++d0) { const int off = lo[d0 & 3] + (d0 >> 2) * 128;
        const bf16x8 b0 = *(const LAS bf16x8*)(ra + off), b1 = *(const LAS bf16x8*)(rb + off);
        p0 = __builtin_amdgcn_mfma_f32_32x32x16_bf16(b0, qr[d0], p0, 0, 0, 0);
        p1 = __builtin_amdgcn_mfma_f32_32x32x16_bf16(b1, qr[d0], p1, 0, 0, 0); }
}
__device__ __forceinline__ int v_rd_base(int lane) { return ((lane & 3) << 3) | (((lane >> 2) & 3) << 6) | (((lane >> 4) & 1) << 5) | (((lane >> 5) & 1) << 8); }
constexpr int v_rd_off(int d0, int ks, int half) { return d0 * 512 + ks * 4096 + half * 2048; }
template <int OFF> __device__ __forceinline__ s16x4 tr_read(int vb) { s16x4 r; asm volatile("ds_read_b64_tr_b16 %0, %1 offset:%2" : "=&v"(r) : "v"(vb), "i"(OFF) : "memory"); return r; }
template <int D0> __device__ __forceinline__ void pv_one(f32x16& od, int vb, bf16x8 pa0, bf16x8 pa1, bf16x8 pa2, bf16x8 pa3) {
    const s16x4 l0 = tr_read<v_rd_off(D0, 0, 0)>(vb), h0 = tr_read<v_rd_off(D0, 0, 1)>(vb), l1 = tr_read<v_rd_off(D0, 1, 0)>(vb), h1 = tr_read<v_rd_off(D0, 1, 1)>(vb);
    const s16x4 l2 = tr_read<v_rd_off(D0, 2, 0)>(vb), h2 = tr_read<v_rd_off(D0, 2, 1)>(vb), l3 = tr_read<v_rd_off(D0, 3, 0)>(vb), h3 = tr_read<v_rd_off(D0, 3, 1)>(vb);
    asm volatile("s_waitcnt lgkmcnt(0)" ::: "memory"); ATT_SBAR();
#define ATT_PK(Lo, Hi) (bf16x8){Lo[0], Lo[1], Lo[2], Lo[3], Hi[0], Hi[1], Hi[2], Hi[3]}
    od = __builtin_amdgcn_mfma_f32_32x32x16_bf16(pa0, ATT_PK(l0, h0), od, 0, 0, 0);
    od = __builtin_amdgcn_mfma_f32_32x32x16_bf16(pa1, ATT_PK(l1, h1), od, 0, 0, 0);
    od = __builtin_amdgcn_mfma_f32_32x32x16_bf16(pa2, ATT_PK(l2, h2), od, 0, 0, 0);
    od = __builtin_amdgcn_mfma_f32_32x32x16_bf16(pa3, ATT_PK(l3, h3), od, 0, 0, 0);
#undef ATT_PK
}
__device__ __forceinline__ void pv_d0(f32x16 (&o)[4], int vb, bf16x8 pa0, bf16x8 pa1, bf16x8 pa2, bf16x8 pa3) {
    pv_one<0>(o[0], vb, pa0, pa1, pa2, pa3); pv_one<1>(o[1], vb, pa0, pa1, pa2, pa3); pv_one<2>(o[2], vb, pa0, pa1, pa2, pa3); pv_one<3>(o[3], vb, pa0, pa1, pa2, pa3);
}
}

__device__ __forceinline__ void phase_attn(const P& p, LAS unsigned char* L, int blk, int G) {
    using namespace att;
    const int tid = ltid(), lane = tid & 63, wid = __builtin_amdgcn_readfirstlane(tid >> 6), r32 = lane & 31, hi = lane >> 5;
    const unsigned lds0 = (unsigned)(uintptr_t)L;
    unsigned koff[3], voff[2]; bool krp[3];
#pragma unroll
    for (int i = 0; i < 3; ++i) { const int o = (wid + 8 * i) * 1024 + lane * 16; const int row = o / KROWB; const int cbs = o - row * KROWB; const int colB = cbs ^ ((row & 7) << 4);
        krp[i] = colB >= 256; koff[i] = krp[i] ? (unsigned)(row * (ROPED * 2) + (colB - 256)) : (unsigned)(row * (NKV * 2) + colB); }
#pragma unroll
    for (int i = 0; i < 2; ++i) { const int st = 2 * (wid + 8 * i) + (lane >> 5); const int kk = ((st >> 2) << 3) | ((lane & 31) >> 2); const int k = (kk & ~0xC) | ((kk & 4) << 1) | ((kk & 8) >> 1);
        const int c = (st & 3) * 32 + 8 * (lane & 3); voff[i] = (unsigned)(k * (NKV * 2) + (128 + c) * 2); }
    LAS float* wsf = (LAS float*)(L + L_WS) + wid * 64; LAS float* li_l = wsf; LAS float* al_l = wsf + 32;
    const int vb0 = (int)(lds0 + L_V) + v_rd_base(lane);
    const LAS unsigned char* Kb = L + L_K;
    const int NU = NB * NH * (SEQ / 256);
    for (int it = 0;; ++it) {
        int bh, qb;
        if (G == 256) { if (it >= 6) break; const int xcd = blk & 7, idx = blk >> 3; bh = it * 16 + xcd * 2 + (idx >> 4); qb = idx & 15; }
        else { const int unit = blk + G * it; if (unit >= NU) break; bh = unit >> 4; qb = unit & 15; }
        const int b = bh / NH, h = bh % NH;
        const size_t qrow0 = (size_t)b * SEQ + qb * 256 + wid * 32;
#define ATT_RB(t) ((t) < 4 ? (size_t)MX + (size_t)b * CTXL + (size_t)(t) * 64 : (size_t)b * SEQ + (size_t)((t) - 4) * 64)
#define ATT_DMA_K(t, slot) do { const size_t rb_ = ATT_RB(t); const char* kvt_ = (const char*)(p.kv + rb_ * NKV + h * 256); const char* krt_ = (const char*)(p.krope + rb_ * ROPED); \
        _Pragma("unroll") for (int i_ = 0; i_ < 3; ++i_) glds16((krp[i_] ? krt_ : kvt_) + koff[i_], (unsigned)__builtin_amdgcn_readfirstlane(lds0 + L_K + (slot) * KSLOT + (wid + 8 * i_) * 1024)); } while (0)
#define ATT_DMA_V(t, slot) do { const size_t rb_ = ATT_RB(t); const char* kvt_ = (const char*)(p.kv + rb_ * NKV + h * 256); \
        _Pragma("unroll") for (int i_ = 0; i_ < 2; ++i_) glds16(kvt_ + voff[i_], (unsigned)__builtin_amdgcn_readfirstlane(lds0 + L_V + (slot) * VSLOT + (wid + 8 * i_) * 1024)); } while (0)
        ATT_DMA_K(0, 0); ATT_DMA_V(0, 0); ATT_DMA_K(1, 1);
        bf16x8 qr[12];
        { const bf16* qp = p.q + (qrow0 + r32) * NQ + h * DQK + hi * 8;
#pragma unroll
          for (int d0 = 0; d0 < 12; ++d0) qr[d0] = *(const GAS bf16x8*)(qp + d0 * 16); }
        float m_reg = -1e30f, l_reg = 0.f; f32x16 o[4] = {};
        f32x16 pA0, pA1, pB0, pB1; float alA, alB; bf16x8 pa0, pa1, pa2, pa3;
#define ATT_RESC(a) do { if (__any((a) < 1.f)) { if (hi == 0) al_l[r32] = (a); asm volatile("s_waitcnt lgkmcnt(0)" ::: "memory"); \
        _Pragma("unroll") for (int d_ = 0; d_ < 4; ++d_) _Pragma("unroll") for (int r_ = 0; r_ < 16; ++r_) o[d_][r_] *= al_l[crow(r_, hi)]; } } while (0)
        ATT_DMA_V(1, 1); ATT_DMA_K(2, 2);
        ATT_WAITBAR(5);
        qkt(pA0, pA1, Kb, qr, r32, hi); partialSM(pA0, pA1, m_reg, alA);
        ATT_WAITBAR(5);
#define ATT_STEP(j, C0, C1, ALC, P0, P1, ALP) do { const int j_ = (j); \
        if (j_ + 1 < NKT) ATT_DMA_V(j_ + 1, (j_ + 1) % 3); if (j_ + 2 < NKT) ATT_DMA_K(j_ + 2, (j_ + 2) % 3); \
        ATT_SBAR(); qkt(C0, C1, Kb + (j_ % 3) * KSLOT, qr, r32, hi); \
        finishSM(P0, P1, ALP, l_reg, pa0, pa1, pa2, pa3); ATT_SBAR(); \
        pv_d0(o, vb0 + ((j_ - 1) % 3) * VSLOT, pa0, pa1, pa2, pa3); partialSM(C0, C1, m_reg, ALC); \
        ATT_RESC(ALC); \
        if (j_ + 2 < NKT) ATT_WAITBAR(5); else ATT_WAITBAR(0); } while (0)
        for (int j = 1; j + 1 < NKT; j += 2) {
            ATT_STEP(j, pB0, pB1, alB, pA0, pA1, alA);
            ATT_STEP(j + 1, pA0, pA1, alA, pB0, pB1, alB);
        }
        ATT_STEP(NKT - 1, pB0, pB1, alB, pA0, pA1, alA);
        finishSM(pB0, pB1, alB, l_reg, pa0, pa1, pa2, pa3); ATT_SBAR();
        pv_d0(o, vb0 + ((NKT - 1) % 3) * VSLOT, pa0, pa1, pa2, pa3);
        if (hi == 0) li_l[r32] = l_reg; asm volatile("s_waitcnt lgkmcnt(0)" ::: "memory");
        float rli[16];
#pragma unroll
        for (int r = 0; r < 16; ++r) rli[r] = __builtin_amdgcn_rcpf(li_l[crow(r, hi)]);
        LAS unsigned char* Os = L + L_K + wid * OST_WAVE;
#pragma unroll
        for (int r = 0; r < 16; ++r) { const int orow = crow(r, hi);
#pragma unroll
            for (int d0 = 0; d0 < 4; ++d0) *(LAS unsigned short*)(Os + orow * OST_STRIDE + (d0 * 32 + r32) * 2) = (unsigned short)cvtpk(o[d0][r] * rli[r], 0.f); }
        asm volatile("s_waitcnt lgkmcnt(0)" ::: "memory");
        { bf16* Ow = p.mixin + qrow0 * DM + S5W + h * DV;
#pragma unroll
          for (int i = 0; i < 8; ++i) { const int row = i * 4 + (lane >> 4), ch = lane & 15; const u32x4 v = *(const LAS u32x4*)(Os + row * OST_STRIDE + ch * 16); *(GAS u32x4*)(Ow + (size_t)row * DM + ch * 8) = v; } }
        ATT_WAITBAR(0);
#undef ATT_STEP
#undef ATT_RESC
#undef ATT_DMA_K
#undef ATT_DMA_V
#undef ATT_RB
    }
}

namespace s5 {
constexpr int TS = 32;
constexpr int NCH = (CTXL + SEQ) / TS, NCTX = CTXL / TS, NLAT = SEQ / TS, KD = TS * 16, NKB = KD / 32;
constexpr int UCH = TS * 32 + 16;
constexpr int L_LAG = 0, LAG_BYTES = (TS + 1) * 512;
constexpr int L_U = L_LAG + LAG_BYTES;
constexpr int SROW = 528;
constexpr int L_S = L_U + 16 * UCH;
constexpr int L_END = L_S + NCH * SROW;
static_assert(L_END <= 131072 && (L_U % 16) == 0 && (L_S % 16) == 0 && TS % 8 == 0 && NCTX <= 16 && NLAT % 16 == 0, "s5 LDS map");
typedef short bf16x8 __attribute__((ext_vector_type(8)));
}
__device__ __forceinline__ void s5_tables_p0(const P& p, float* pw, bf16* w1t, bf16* w3t, float* at, int gtid, int NGT) {
    constexpr int TS = s5::TS, NLQ = TS / 8, KD = s5::KD;
    for (int it = gtid; it < 128 * 64 * NLQ; it += NGT) {
        const int lq = it % NLQ, pp = (it / NLQ) & 63, dg = it / (NLQ * 64), sidx = dg * 64 + pp;
        const float lr = p.lam_re[sidx], li = p.lam_im[sidx], dt = expf(p.log_step[dg]);
        float sn, cs; sincosf(li * dt, &sn, &cs); const float mag = expf(lr * dt);
        const float ar = mag * cs, ai = mag * sn, den = lr * lr + li * li, nr = ar - 1.f, ni = ai;
        const float fr = (nr * lr + ni * li) / den, fi = (ni * lr - nr * li) / den;
        float bbr[16], bbi[16];
#pragma unroll
        for (int cc = 0; cc < 16; ++cc) { const float br = p.b_re[(size_t)sidx * 16 + cc], bi = p.b_im[(size_t)sidx * 16 + cc]; bbr[cc] = fr * br - fi * bi; bbi[cc] = fr * bi + fi * br; }
        float cr[16], ci[16];
#pragma unroll
        for (int co = 0; co < 16; ++co) { cr[co] = p.c_re[((size_t)dg * 16 + co) * 64 + pp]; ci[co] = p.c_im[((size_t)dg * 16 + co) * 64 + pp]; }
        const float l0 = (float)(8 * lq); float s0, c0; sincosf(li * dt * l0, &s0, &c0); const float m0 = expf(lr * dt * l0);
        float pr = m0 * c0, pi = m0 * s0;
        const int nl = (lq == NLQ - 1) ? 9 : 8;
        for (int dl = 0; dl < nl; ++dl) {
            const int l = 8 * lq + dl;
            pw[(((size_t)dg * (TS + 1) + l) * 64 + pp) * 2] = pr; pw[(((size_t)dg * (TS + 1) + l) * 64 + pp) * 2 + 1] = pi;
            if (l <= TS - 1) { const int i = TS - 1 - l;
                unsigned wr_[8], wi_[8];
#pragma unroll
                for (int cc = 0; cc < 8; ++cc) { const float r0 = pr * bbr[2 * cc] - pi * bbi[2 * cc], r1 = pr * bbr[2 * cc + 1] - pi * bbi[2 * cc + 1], i0 = pr * bbi[2 * cc] + pi * bbr[2 * cc], i1 = pr * bbi[2 * cc + 1] + pi * bbr[2 * cc + 1];
                    wr_[cc] = pk2(r0, r1); wi_[cc] = pk2(i0, i1); }
                GAS v4u* d0 = (GAS v4u*)(w1t + ((size_t)dg * 128 + 2 * pp) * KD + 16 * i); GAS v4u* d1 = (GAS v4u*)(w1t + ((size_t)dg * 128 + 2 * pp + 1) * KD + 16 * i);
                d0[0] = (v4u){wr_[0], wr_[1], wr_[2], wr_[3]}; d0[1] = (v4u){wr_[4], wr_[5], wr_[6], wr_[7]}; d1[0] = (v4u){wi_[0], wi_[1], wi_[2], wi_[3]}; d1[1] = (v4u){wi_[4], wi_[5], wi_[6], wi_[7]}; }
            if (l >= 1) { const int j = l - 1;
#pragma unroll
                for (int co = 0; co < 16; ++co) { const float re = cr[co] * pr - ci[co] * pi, im = cr[co] * pi + ci[co] * pr;
                    *(GAS unsigned*)(w3t + ((size_t)dg * KD + 16 * j + co) * 128 + 2 * pp) = pk2(re, -im); } }
            if (l == TS) { at[(size_t)sidx * 2] = pr; at[(size_t)sidx * 2 + 1] = pi; }
            const float npr = pr * ar - pi * ai, npi = pr * ai + pi * ar; pr = npr; pi = npi;
        }
    }
}
__device__ __forceinline__ void s5_tables_p1(const P& p, const float* pw, bf16* lagk, int gtid, int NGT) {
    constexpr int TS = s5::TS;
    for (int it = gtid; it < 128 * (TS + 1) * 16; it += NGT) {
        const int co = it & 15, lp = (it >> 4) % (TS + 1), dg = (it >> 4) / (TS + 1);
        float acc[16];
#pragma unroll
        for (int cc = 0; cc < 16; ++cc) acc[cc] = 0.f;
        if (lp > 0) { const int l = lp - 1;
            for (int pp = 0; pp < 64; ++pp) {
                const float cr = p.c_re[((size_t)dg * 16 + co) * 64 + pp], ci = p.c_im[((size_t)dg * 16 + co) * 64 + pp];
                const float pr = pw[(((size_t)dg * (TS + 1) + l) * 64 + pp) * 2], pi = pw[(((size_t)dg * (TS + 1) + l) * 64 + pp) * 2 + 1];
                const float xr = cr * pr - ci * pi, xi = cr * pi + ci * pr;
                const f32x4* br = (const f32x4*)(p.bbr + ((size_t)dg * 64 + pp) * 16); const f32x4* bi = (const f32x4*)(p.bbi + ((size_t)dg * 64 + pp) * 16);
#pragma unroll
                for (int v = 0; v < 4; ++v) { const f32x4 r4 = br[v], i4 = bi[v];
                    acc[4 * v + 0] += xr * r4.x - xi * i4.x; acc[4 * v + 1] += xr * r4.y - xi * i4.y; acc[4 * v + 2] += xr * r4.z - xi * i4.z; acc[4 * v + 3] += xr * r4.w - xi * i4.w; }
            } }
        GAS v4u* d = (GAS v4u*)(lagk + (((size_t)dg * (TS + 1) + lp) * 16 + co) * 16);
        d[0] = (v4u){pk2(acc[0], acc[1]), pk2(acc[2], acc[3]), pk2(acc[4], acc[5]), pk2(acc[6], acc[7])}; d[1] = (v4u){pk2(acc[8], acc[9]), pk2(acc[10], acc[11]), pk2(acc[12], acc[13]), pk2(acc[14], acc[15])};
    }
}
__device__ __forceinline__ void phase_s5(const P& p, const bf16* lagk, const bf16* w1t, const bf16* w3t, const float* at, LAS unsigned char* L, int blk, int G) {
    using namespace s5;
    const int tid = ltid(), lane = tid & 63, wid = __builtin_amdgcn_readfirstlane(tid >> 6), ml = lane & 15, q = lane >> 4;
    for (int unit = blk; unit < NB * 2 * 64; unit += G) {
        const int g = unit & 63, dir = (unit >> 6) & 1, b = unit >> 7, dg = dir * 64 + g;
#define S5_ROW(s) ((dir == 0) ? ((s) < CTXL ? (size_t)MX + (size_t)b * CTXL + (s) : (size_t)b * SEQ + ((s) - CTXL)) : ((s) < CTXL ? (size_t)MX + (size_t)b * CTXL + (CTXL - 1 - (s)) : (size_t)b * SEQ + (SEQ - 1 - ((s) - CTXL))))
#define S5_STAGE(s0, nvalid) do { const int m_ = tid / TS, i_ = tid % TS; v4u a_ = (v4u){0u, 0u, 0u, 0u}, b_ = a_; \
            if (m_ < (nvalid)) { const int s_ = (s0) + TS * m_ + i_; const bf16* src_ = p.px + S5_ROW(s_) * INCP + g * 16; a_ = *(const GAS v4u*)src_; b_ = *(const GAS v4u*)(src_ + 8); } \
            *(LAS v4u*)(L + L_U + m_ * UCH + i_ * 32) = a_; *(LAS v4u*)(L + L_U + m_ * UCH + i_ * 32 + 16) = b_; } while (0)
        static_assert(16 * TS == 512, "one (chunk, step) pair per thread");
        __syncthreads();
        for (int c = tid; c < LAG_BYTES / 16; c += 512) *(LAS v4u*)(L + L_LAG + c * 16) = *(const GAS v4u*)(lagk + (size_t)dg * (LAG_BYTES / 2) + c * 8);
        bf16x8 w1[NKB];
        { const bf16* wp = w1t + ((size_t)dg * 128 + wid * 16 + ml) * KD + 8 * q;
#pragma unroll
          for (int kb = 0; kb < NKB; ++kb) w1[kb] = *(const GAS bf16x8*)(wp + kb * 32); }
        for (int tl = 0; tl <= NLAT / 16; ++tl) {
            __syncthreads();
            if (tl == 0) S5_STAGE(0, NCTX); else S5_STAGE(CTXL + 16 * TS * (tl - 1), 16);
            __syncthreads();
            pg8::f32x4 acc = (pg8::f32x4){0.f, 0.f, 0.f, 0.f};
#pragma unroll
            for (int k8 = 0; k8 < NKB / 8; ++k8) { bf16x8 a[8];
#pragma unroll
                for (int kk = 0; kk < 8; ++kk) a[kk] = *(const LAS bf16x8*)(L + L_U + ml * UCH + (2 * (8 * k8 + kk) + (q >> 1)) * 32 + (q & 1) * 16);
#pragma unroll
                for (int kk = 0; kk < 8; ++kk) acc = __builtin_amdgcn_mfma_f32_16x16x32_bf16(a[kk], w1[8 * k8 + kk], acc, 0, 0, 0);
                __builtin_amdgcn_sched_barrier(0); }
#pragma unroll
            for (int r = 0; r < 4; ++r) { const int m = 4 * q + r; const int ck = tl == 0 ? m : NCTX + 16 * (tl - 1) + m; if (tl > 0 || m < NCTX) *(LAS float*)(L + L_S + ck * SROW + (wid * 16 + ml) * 4) = acc[r]; }
        }
        __syncthreads();
        if (tid < 64) { const float tr = at[((size_t)dg * 64 + tid) * 2], ti = at[((size_t)dg * 64 + tid) * 2 + 1]; float hr = 0.f, hi = 0.f;
#pragma unroll 8
            for (int ck = 0; ck < NCH; ++ck) {
                const float sr = *(const LAS float*)(L + L_S + ck * SROW + (2 * tid) * 4), si = *(const LAS float*)(L + L_S + ck * SROW + (2 * tid + 1) * 4);
                asm volatile("s_waitcnt lgkmcnt(0)" ::: "memory");
                *(LAS unsigned*)(L + L_S + ck * SROW + tid * 4) = pk2(hr, hi);
                const float nr = tr * hr - ti * hi + sr, ni = tr * hi + ti * hr + si; hr = nr; hi = ni; } }
        for (int lt = 0; lt < NLAT / 16; ++lt) {
            __syncthreads();
            S5_STAGE(CTXL + 16 * TS * lt, 16);
            __syncthreads();
            for (int jj = 0; jj < TS / 8; ++jj) { const int j = wid + 8 * jj;
                bf16x8 w3[4];
                { const bf16* wp = w3t + ((size_t)dg * KD + j * 16 + ml) * 128 + 8 * q;
#pragma unroll
                  for (int kb = 0; kb < 4; ++kb) w3[kb] = *(const GAS bf16x8*)(wp + kb * 32); }
                pg8::f32x4 acc = (pg8::f32x4){0.f, 0.f, 0.f, 0.f};
                const LAS unsigned char* ua = L + L_U + ml * UCH + (q >> 1) * 32 + (q & 1) * 16;
                const LAS unsigned char* la = L + L_LAG + (j - (q >> 1) + 1) * 512 + ml * 32 + (q & 1) * 16;
                for (int kb = 0; kb <= (j >> 1); ++kb) { const bf16x8 a = *(const LAS bf16x8*)(ua + kb * 64), bb = *(const LAS bf16x8*)(la - kb * 1024); acc = __builtin_amdgcn_mfma_f32_16x16x32_bf16(a, bb, acc, 0, 0, 0); }
#pragma unroll
                for (int kb = 0; kb < 4; ++kb) { const bf16x8 a = *(const LAS bf16x8*)(L + L_S + (NCTX + lt * 16 + ml) * SROW + kb * 64 + q * 16); acc = __builtin_amdgcn_mfma_f32_16x16x32_bf16(a, w3[kb], acc, 0, 0, 0); }
#pragma unroll
                for (int r = 0; r < 4; ++r) { const int sl = 16 * TS * lt + TS * (4 * q + r) + j; const int t = dir == 0 ? sl : SEQ - 1 - sl;
                    p.ydir[((size_t)dir * MX + (size_t)b * SEQ + t) * S5W + g * 16 + ml] = acc[r]; }
            }
        }
#undef S5_STAGE
#undef S5_ROW
    }
}

constexpr int N_PHASES = 16;
struct Args { const float* in[29]; float* out; unsigned char* ws; int ph_lo, ph_hi, li, pad; };
__global__ void __launch_bounds__(NWAVES * 64, 2) skel_fwd(Args args) {
    extern __shared__ __attribute__((aligned(16))) unsigned char lds_raw[];
    LAS unsigned char* lds = (LAS unsigned char*)lds_raw;
    volatile LAS unsigned* MISC = (volatile LAS unsigned*)(lds + MISC_OFF);
    const int G = gridDim.x, blk = blockIdx.x;
    const int vcu = (G % 8 == 0) ? (blk % 8) * (G / 8) + blk / 8 : blk;
    const int NGW = G * NWAVES, NGT = G * NWAVES * 64;
#define IDS() const int tid = ltid(), lane = tid & 63, wave = __builtin_amdgcn_readfirstlane(tid >> 6), gw = vcu * NWAVES + wave, gtid = blk * (NWAVES * 64) + tid; (void)lane; (void)gw; (void)gtid
    unsigned char* ws = args.ws;
    P p;
    p.x = args.in[0]; p.c = args.in[1]; p.ctx = args.in[2]; p.cctx = args.in[3]; p.w_ada = args.in[4]; p.b_ada = args.in[5];
    p.g_pre_mix = args.in[6]; p.g_post_mix = args.in[7]; p.g_pre_ffn = args.in[8]; p.g_post_ffn = args.in[9]; p.w_in = args.in[10];
    p.lam_re = args.in[11]; p.lam_im = args.in[12]; p.log_step = args.in[13]; p.b_re = args.in[14]; p.b_im = args.in[15]; p.c_re = args.in[16]; p.c_im = args.in[17];
    p.s5d = args.in[18]; p.w_glu = args.in[19]; p.g_q = args.in[20]; p.w_uq = args.in[21]; p.g_kv = args.in[22]; p.w_ukv = args.in[23]; p.w_out = args.in[24];
    p.ffn_w_in = args.in[25]; p.conv_w = args.in[26]; p.conv_b = args.in[27]; p.ffn_w_down = args.in[28];
    p.out = args.out;
    p.mod = (float*)(ws + WS_MOD); p.abar = (float*)(ws + WS_S5A); p.bbr = (float*)(ws + WS_S5BR); p.bbi = (float*)(ws + WS_S5BI); p.rope = (float*)(ws + WS_ROPE); p.part = (float*)(ws + WS_PART);
    p.mix = (float*)(ws + WS_MIX); p.f = (float*)(ws + WS_F); p.ydir = (float*)(ws + WS_YDIR);
    p.WinT = (bf16*)(ws + WS_WIN); p.WuqT = (bf16*)(ws + WS_WUQ); p.WukvT = (bf16*)(ws + WS_WUKV); p.WgluT = (bf16*)(ws + WS_WGLU); p.WoutT = (bf16*)(ws + WS_WOUT); p.WfinT = (bf16*)(ws + WS_WFIN); p.WdownT = (bf16*)(ws + WS_WDOWN);
    p.h = (bf16*)(ws + WS_H); p.px = (bf16*)(ws + WS_PX); p.qcn = (bf16*)(ws + WS_QCN); p.kvcn = (bf16*)(ws + WS_KVCN); p.krope = (bf16*)(ws + WS_KROPE); p.q = (bf16*)(ws + WS_Q); p.kv = (bf16*)(ws + WS_KV);
    p.mixin = (bf16*)(ws + WS_MIXIN); p.yg = (bf16*)(ws + WS_YG); p.hx = (bf16*)(ws + WS_HX); p.gu = (bf16*)(ws + WS_GU); p.act = (bf16*)(ws + WS_ACT);

    for (int u = ltid(); u < (LDS_BYTES - LDSCTL_OFF) / 4; u += NWAVES * 64) ((LAS unsigned*)(lds + LDSCTL_OFF))[u] = 0u;
    __syncthreads();
#if MK_ONE_LAUNCH
    XcdBarrier bar = xcd_barrier_post((unsigned*)(ws + WS_CTL) + CW_BAR, MISC + 8);
#define GRID_BAR() xcd_barrier(bar)
#else
    (void)MISC;
#define GRID_BAR() do { } while (0)
#endif
    const int lo = args.ph_lo, hi = args.ph_hi;
#define IN(k) (lo <= (k) && (k) < hi)
#define SEAM(k) do { if (IN(k) && IN((k) + 1)) GRID_BAR(); } while (0)
    typedef pg8::StaticOrder SO;

    bf16* s5_lagk = (bf16*)(ws + WS_S5LAG); bf16* s5_w1t = (bf16*)(ws + WS_S5W1); bf16* s5_w3t = (bf16*)(ws + WS_S5W3); float* s5_at = (float*)(ws + WS_S5AT); float* s5_pw = (float*)(ws + WS_S5PW);
    if (IN(0)) { IDS(); phase_prologue(p, lds, gw, NGW, wave, lane, gtid, NGT); s5_tables_p0(p, s5_pw, s5_w1t, s5_w3t, s5_at, gtid, NGT); } SEAM(0);
    if (IN(1)) { IDS(); phase_modreduce(p, gtid, NGT); s5_tables_p1(p, s5_pw, s5_lagk, gtid, NGT); } SEAM(1);
    if (IN(2)) { IDS(); phase_norm1(p, gw, NGW, lane); } SEAM(2);
    if (IN(3)) { pg8::Gemm g{p.h, p.WinT, MALL, INCP, DM}; SO S; S.init(MALL, INCP, G, blk); pg8::EpiBf16P E{p.px, INCP};
                 pg8::gemm_phase<pg8::EpiBf16P, SO, true, true>(lds, g, S, E); } SEAM(3);
    if (IN(4)) { IDS(); phase_postin(p, gw, NGW, lane); } SEAM(4);
    if (IN(5)) { { pg8::Gemm g{p.qcn, p.WuqT, MX, NQ, QRANK}; SO S; S.init(MX, NQ, G, blk); pg8::EpiQ E{p.q, p.rope, QSCALE};
                   pg8::gemm_phase<pg8::EpiQ, SO, true, true>(lds, g, S, E); }
                 { pg8::Gemm g{p.kvcn, p.WukvT, MALL, NKV, KVRANK}; SO S; S.init(MALL, NKV, G, blk); pg8::EpiBf16P E{p.kv, NKV};
                   pg8::gemm_phase<pg8::EpiBf16P, SO, true, true>(lds, g, S, E); } } SEAM(5);
    if (IN(6)) { phase_attn(p, lds, blk, G); } SEAM(6);
    if (IN(7)) { phase_s5(p, s5_lagk, s5_w1t, s5_w3t, s5_at, lds, blk, G); } SEAM(7);
    if (IN(8)) { IDS(); phase_s5gelu(p, gtid, NGT); } SEAM(8);
    if (IN(9)) { pg8::Gemm g{p.yg, p.WgluT, MX, S5W, S5W}; SO S; S.init(MX, S5W, G, blk); pg8::EpiGlu E{p.yg, p.mixin, DM};
                 pg8::gemm_phase<pg8::EpiGlu, SO, true, true>(lds, g, S, E); } SEAM(9);
    if (IN(10)) { pg8::Gemm g{p.mixin, p.WoutT, MX, DM, DM}; SO S; S.init(MX, DM, G, blk); pg8::EpiF32P E{p.mix, DM};
                  pg8::gemm_phase<pg8::EpiF32P, SO, true, true>(lds, g, S, E); } SEAM(10);
    if (IN(11)) { IDS(); phase_mid(p, gw, NGW, lane); } SEAM(11);
    if (IN(12)) { pg8::Gemm g{p.hx, p.WfinT, MX, 2 * DFF, DM}; SO S; S.init(MX, 2 * DFF, G, blk); pg8::EpiBf16P E{p.gu, 2 * DFF};
                  pg8::gemm_phase<pg8::EpiBf16P, SO, true, true>(lds, g, S, E); } SEAM(12);
    if (IN(13)) { IDS(); phase_convact(p, gtid, NGT); } SEAM(13);
    if (IN(14)) { pg8::Gemm g{p.act, p.WdownT, MX, DM, DFF}; SO S; S.init(MX, DM, G, blk); pg8::EpiF32P E{p.f, DM};
                  pg8::gemm_phase<pg8::EpiF32P, SO, true, true>(lds, g, S, E); } SEAM(14);
    if (IN(15)) { IDS(); phase_final(p, gw, NGW, lane); }
#undef IN
#undef SEAM
}

extern "C" void kernel_launch(void* const* d_in, const int* in_sizes, int n_in, void* d_out, int out_size, void* d_ws, size_t ws_size, hipStream_t stream) {
    static int grid = 0;
    if (grid == 0) {
        if (n_in != 29 || out_size != MX * DM || ws_size < WS_END) { fprintf(stderr, "kernel_launch: unexpected shapes: n_in %d out %d ws %zu (need %zu)\n", n_in, out_size, ws_size, (size_t)WS_END); grid = -1; return; }
        int dev = 0, cus = 0;
        if (hipGetDevice(&dev) != hipSuccess || hipDeviceGetAttribute(&cus, hipDeviceAttributeMultiprocessorCount, dev) != hipSuccess) { grid = -1; return; }
        if (hipFuncSetAttribute((const void*)skel_fwd, hipFuncAttributeMaxDynamicSharedMemorySize, LDS_BYTES) != hipSuccess) { fprintf(stderr, "kernel_launch: hipFuncSetAttribute failed\n"); grid = -1; return; }
        int per_cu = 0;
        if (hipOccupancyMaxActiveBlocksPerMultiprocessor(&per_cu, (const void*)skel_fwd, NWAVES * 64, LDS_BYTES) != hipSuccess || per_cu < 1) fprintf(stderr, "kernel_launch: occupancy query says %d\n", per_cu);
        (void)hipGetLastError();
        grid = cus;
    }
    if (grid < 0) return;
    (void)hipMemsetAsync((char*)d_ws + WS_CTL, 0, CTL_ZERO_BYTES, stream);
    Args a{};
    for (int i = 0; i < 29; ++i) a.in[i] = (const float*)d_in[i];
    a.out = (float*)d_out; a.ws = (unsigned char*)d_ws;
#if MK_ONE_LAUNCH
    a.ph_lo = 0; a.ph_hi = N_PHASES; a.li = 0;
    hipLaunchKernelGGL(skel_fwd, dim3(grid), dim3(NWAVES * 64), LDS_BYTES, stream, a);
#else
    for (int ph = 0; ph < N_PHASES; ++ph) { a.ph_lo = ph; a.ph_hi = ph + 1; a.li = ph; hipLaunchKernelGGL(skel_fwd, dim3(grid), dim3(NWAVES * 64), LDS_BYTES, stream, a); }
#endif
    const hipError_t le = hipPeekAtLastError();
    if (le != hipSuccess) fprintf(stderr, "kernel_launch: launch failed: %s\n", hipGetErrorName(le));
}
```

```cpp
#include <hip/hip_runtime.h>
#include <cstdio>
#include <cstdint>
#include <cmath>

#ifndef MK_ONE_LAUNCH
#define MK_ONE_LAUNCH 1
#endif

__device__ __forceinline__ int ltid() { int t = threadIdx.x; asm volatile("" : "+v"(t)); return t; }

namespace pg8 {
#define PG8_LAS __attribute__((address_space(3)))
typedef unsigned short bf16_t;
typedef short bf16x8 __attribute__((ext_vector_type(8)));
typedef float f32x4 __attribute__((ext_vector_type(4)));
typedef float f32x2 __attribute__((ext_vector_type(2)));
typedef unsigned u32x4 __attribute__((ext_vector_type(4)));
constexpr int BM = 256, BK = 64, HALF = 128, HTB = HALF * BK * 2  , STAGE_BYTES = 8 * HTB, NXCD = 8, WGM = 8;

__host__ __device__ __forceinline__ int lds_byte(int r, int c) { const int st = (r >> 4) * 2 + (c >> 5), rr = r & 15, cc = c & 31, ob = rr * 64 + cc * 2; return st * 1024 + (ob ^ (((ob >> 9) & 1) << 5)); }
__host__ __device__ __forceinline__ void stage_rc(int b, int& R, int& C) { const int st = b / 1024, sb = b % 1024, swz = sb ^ (((sb >> 9) & 1) << 5); R = (st >> 1) * 16 + swz / 64; C = (st & 1) * 32 + (swz % 64) / 2; }
__host__ __device__ __forceinline__ int perm32(int rho) { const int n = rho >> 4, i = rho & 15; return 8 * (i >> 2) + 4 * n + (i & 3); }

struct Unit { int pm, pn; };
struct Gemm { const bf16_t* A; const bf16_t* Bt; int M, N, K; };

struct StaticOrder {
    int nM, nN, nwg, G, c;
    __host__ __device__ void init(int M, int N, int G_, int c_) { nM = M / BM; nN = N / BM; nwg = nM * nN; G = G_; c = c_; }
    __host__ __device__ bool next(int i, Unit& u) const {
        const long L = (long)i * G + c; if (L >= nwg) return false;
        int wgid = (int)L; { const int q = nwg / NXCD, r = nwg % NXCD, xcd = wgid % NXCD, off = wgid / NXCD; wgid = (xcd < r ? xcd * (q + 1) : r * (q + 1) + (xcd - r) * q) + off; }
        const int nig = WGM * nN, gid = wgid / nig, fm = gid * WGM, gsz = (nM - fm) < WGM ? (nM - fm) : WGM;
        u.pm = fm + ((wgid % nig) % gsz); u.pn = (wgid % nig) / gsz; return true;
    }
    __device__ __forceinline__ void a_ready(const Unit&) const {}
    __device__ __forceinline__ void done(const Unit&) const {}
};

__device__ __forceinline__ unsigned cvt_pk_bf16(float lo, float hi) { unsigned r; asm volatile("v_cvt_pk_bf16_f32 %0, %1, %2" : "=v"(r) : "v"(lo), "v"(hi)); return r; }
__device__ __forceinline__ float bf_lo(unsigned w) { return __uint_as_float(w << 16); }
__device__ __forceinline__ float bf_hi(unsigned w) { return __uint_as_float(w & 0xffff0000u); }

struct EpiBf16P {
    static constexpr bool PERM = true, AFTER_DRAIN = false;
    bf16_t* O; int ldc;
    __device__ __forceinline__ void operator()(const f32x4 (&acc)[2][2][4][2], const Unit& u, int wr, int wc, int fr, int fq) const {
        const int row0 = u.pm * BM + wr * 64 + fr, col0 = u.pn * BM + wc * 32 + 8 * fq;
#pragma unroll
        for (int ai = 0; ai < 2; ++ai)
#pragma unroll
            for (int m = 0; m < 4; ++m) { bf16_t* rowp = O + (size_t)(row0 + ai * HALF + m * 16) * ldc + col0;
#pragma unroll
                for (int bj = 0; bj < 2; ++bj) { const f32x4 v0 = acc[ai][bj][m][0], v1 = acc[ai][bj][m][1];
                    u32x4 w; w.x = cvt_pk_bf16(v0[0], v0[1]); w.y = cvt_pk_bf16(v0[2], v0[3]); w.z = cvt_pk_bf16(v1[0], v1[1]); w.w = cvt_pk_bf16(v1[2], v1[3]);
                    *(u32x4*)(rowp + bj * HALF) = w; } }
    }
};
struct EpiF32P {
    static constexpr bool PERM = false, AFTER_DRAIN = false;
    float* C; int ldc;
    __device__ __forceinline__ void operator()(const f32x4 (&acc)[2][2][4][2], const Unit& u, int wr, int wc, int fr, int fq) const {
        const int row0 = u.pm * BM + wr * 64 + fr, col0 = u.pn * BM + wc * 32 + 4 * fq;
#pragma unroll
        for (int ai = 0; ai < 2; ++ai)
#pragma unroll
            for (int m = 0; m < 4; ++m) { float* rowp = C + (size_t)(row0 + ai * HALF + m * 16) * ldc + col0;
#pragma unroll
                for (int bj = 0; bj < 2; ++bj)
#pragma unroll
                    for (int n = 0; n < 2; ++n) *(f32x4*)(rowp + bj * HALF + n * 16) = acc[ai][bj][m][n]; }
    }
};
struct EpiQ {
    static constexpr bool PERM = true, AFTER_DRAIN = false;
    bf16_t* O; const float* rope; float scale;
    __device__ __forceinline__ void operator()(const f32x4 (&acc)[2][2][4][2], const Unit& u, int wr, int wc, int fr, int fq) const {
        const int row0 = u.pm * BM + wr * 64 + fr, col0 = u.pn * BM + wc * 32 + 8 * fq;
#pragma unroll
        for (int ai = 0; ai < 2; ++ai)
#pragma unroll
            for (int m = 0; m < 4; ++m) { const int row = row0 + ai * HALF + m * 16; const int t = row & 4095; bf16_t* rowp = O + (size_t)row * 4608 + col0;
#pragma unroll
                for (int bj = 0; bj < 2; ++bj) { f32x4 v0 = acc[ai][bj][m][0] * scale, v1 = acc[ai][bj][m][1] * scale;
                    const int col = col0 + bj * HALF; const int within = col % 192;
                    if (within >= 128) { const float* cs = rope + ((size_t)t * 32 + ((within - 128) >> 1)) * 2; const f32x4 c01 = *(const f32x4*)cs, c23 = *(const f32x4*)(cs + 4);
                        const float a0 = v0[0], a1 = v0[1], a2 = v0[2], a3 = v0[3], b0 = v1[0], b1 = v1[1], b2 = v1[2], b3 = v1[3];
                        v0[0] = a0 * c01[0] - a1 * c01[1]; v0[1] = a0 * c01[1] + a1 * c01[0]; v0[2] = a2 * c01[2] - a3 * c01[3]; v0[3] = a2 * c01[3] + a3 * c01[2];
                        v1[0] = b0 * c23[0] - b1 * c23[1]; v1[1] = b0 * c23[1] + b1 * c23[0]; v1[2] = b2 * c23[2] - b3 * c23[3]; v1[3] = b2 * c23[3] + b3 * c23[2]; }
                    u32x4 w; w.x = cvt_pk_bf16(v0[0], v0[1]); w.y = cvt_pk_bf16(v0[2], v0[3]); w.z = cvt_pk_bf16(v1[0], v1[1]); w.w = cvt_pk_bf16(v1[2], v1[3]);
                    *(u32x4*)(rowp + bj * HALF) = w; } }
    }
};
struct EpiGlu {
    static constexpr bool PERM = true, AFTER_DRAIN = false;
    const bf16_t* YG; bf16_t* O; int ldo;
    __device__ __forceinline__ void operator()(const f32x4 (&acc)[2][2][4][2], const Unit& u, int wr, int wc, int fr, int fq) const {
        const int row0 = u.pm * BM + wr * 64 + fr, col0 = u.pn * BM + wc * 32 + 8 * fq;
#pragma unroll
        for (int ai = 0; ai < 2; ++ai)
#pragma unroll
            for (int m = 0; m < 4; ++m) { const int row = row0 + ai * HALF + m * 16;
#pragma unroll
                for (int bj = 0; bj < 2; ++bj) { const int col = col0 + bj * HALF; const u32x4 y = *(const u32x4*)(YG + (size_t)row * 1024 + col);
                    const f32x4 v0 = acc[ai][bj][m][0], v1 = acc[ai][bj][m][1];
                    float o[8]; const float yv[8] = {bf_lo(y.x), bf_hi(y.x), bf_lo(y.y), bf_hi(y.y), bf_lo(y.z), bf_hi(y.z), bf_lo(y.w), bf_hi(y.w)};
#pragma unroll
                    for (int j = 0; j < 4; ++j) { o[j] = yv[j] / (1.f + __expf(-v0[j])); o[4 + j] = yv[4 + j] / (1.f + __expf(-v1[j])); }
                    u32x4 w; w.x = cvt_pk_bf16(o[0], o[1]); w.y = cvt_pk_bf16(o[2], o[3]); w.z = cvt_pk_bf16(o[4], o[5]); w.w = cvt_pk_bf16(o[6], o[7]);
                    *(u32x4*)(O + (size_t)row * ldo + col) = w; } }
    }
};
__device__ __forceinline__ float dpp_prev(float x, float xprev_grp) {
    const int o = __builtin_amdgcn_update_dpp(0, __builtin_bit_cast(int, xprev_grp), 0x121  , 0xf, 0xf, false);
    return __builtin_bit_cast(float, __builtin_amdgcn_update_dpp(o, __builtin_bit_cast(int, x), 0x111  , 0xf, 0xf, false)); }
__device__ __forceinline__ float dpp_next(float x, float xnext_grp) {
    const int o = __builtin_amdgcn_update_dpp(0, __builtin_bit_cast(int, xnext_grp), 0x12F  , 0xf, 0xf, false);
    return __builtin_bit_cast(float, __builtin_amdgcn_update_dpp(o, __builtin_bit_cast(int, x), 0x101  , 0xf, 0xf, false)); }
struct EpiConvAct {
    static constexpr bool PERM = true, AFTER_DRAIN = false;
    bf16_t* ACT; const float* cw; const float* cb; float* hg; float* hu; int dff;
    __device__ __forceinline__ void operator()(const f32x4 (&acc)[2][2][4][2], const Unit& u, int wr, int wc, int fr, int fq) const {
        const int c0 = u.pn * HALF + wc * 32 + 8 * fq;
        float w0[8], w1[8], w2[8], bb[8];
#pragma unroll
        for (int h = 0; h < 2; ++h) { const f32x4 a = *(const f32x4*)(cw + c0 + 4 * h), b = *(const f32x4*)(cw + dff + c0 + 4 * h), c = *(const f32x4*)(cw + 2 * dff + c0 + 4 * h), d = *(const f32x4*)(cb + c0 + 4 * h);
#pragma unroll
            for (int e = 0; e < 4; ++e) { w0[4 * h + e] = a[e]; w1[4 * h + e] = b[e]; w2[4 * h + e] = c[e]; bb[4 * h + e] = d[e]; } }
#pragma unroll
        for (int ai = 0; ai < 2; ++ai) {
            const int blk64 = u.pm * 4 + ai * 2 + wr;
#pragma unroll
            for (int m = 0; m < 4; ++m) {
                const int row = blk64 * 64 + m * 16 + fr;
                float o[8];
#pragma unroll
                for (int n = 0; n < 2; ++n)
#pragma unroll
                    for (int e = 0; e < 4; ++e) { const float g = acc[ai][0][m][n][e];
                        const float gpv = dpp_prev(g, m > 0 ? acc[ai][0][m - 1][n][e] : 0.f), gnx = dpp_next(g, m < 3 ? acc[ai][0][m + 1][n][e] : 0.f);
                        const float cv = w0[4 * n + e] * gpv + w1[4 * n + e] * g + w2[4 * n + e] * gnx + bb[4 * n + e];
                        o[4 * n + e] = cv * __builtin_amdgcn_rcpf(1.f + __builtin_amdgcn_exp2f(-1.4426950408889634f * cv)) * acc[ai][1][m][n][e]; }
                u32x4 w; w.x = cvt_pk_bf16(o[0], o[1]); w.y = cvt_pk_bf16(o[2], o[3]); w.z = cvt_pk_bf16(o[4], o[5]); w.w = cvt_pk_bf16(o[6], o[7]);
                *(u32x4*)(ACT + (size_t)row * dff + c0) = w;
                if (m == 0 || m == 3) { const int slot = m == 0 ? fr : fr - 12;
                    if ((m == 0 && fr < 2) || (m == 3 && fr >= 14)) { float* gp = hg + ((size_t)blk64 * 4 + slot) * dff + c0; *(f32x4*)gp = acc[ai][0][m][0]; *(f32x4*)(gp + 4) = acc[ai][0][m][1]; }
                    if ((m == 0 && fr == 0) || (m == 3 && fr == 15)) { float* up = hu + ((size_t)blk64 * 2 + (m == 0 ? 0 : 1)) * dff + c0; *(f32x4*)up = acc[ai][1][m][0]; *(f32x4*)(up + 4) = acc[ai][1][m][1]; } }
            }
        }
    }
};

template <class Epi, class Sched, bool ALIGN_EPI = false, bool SP2 = false>
__device__ __forceinline__ void gemm_phase(PG8_LAS unsigned char* lds, const Gemm g, const Sched& S, const Epi& E) {
    const int tid = ltid(), wid = __builtin_amdgcn_readfirstlane(tid >> 6), lane = tid & 63, wr = wid >> 2, wc = wid & 3, fr = lane & 15, fq = lane >> 4;
    const int K = g.K, nt = K / BK;
    unsigned voffA[2], voffB[2];
#pragma unroll
    for (int i = 0; i < 2; ++i) { int R, C; stage_rc(tid * 16 + i * 8192, R, C); const int Rb = Epi::PERM ? ((R & ~31) + perm32(R & 31)) : R;
        voffA[i] = (unsigned)(R * K + C) * 2u; voffB[i] = (unsigned)(Rb * K + C) * 2u; }
    const size_t kstep = (size_t)(BK * 2);
    const size_t hstep = (size_t)HALF * K * 2;
    const size_t tstep = 2 * hstep;
    const unsigned ldsw = (unsigned)wid * 1024u;
    const int aoff = lds_byte(wr * 64 + fr, fq * 8), boff = lds_byte(wc * 32 + fr, fq * 8);
#define PG8_SA(b, h) (((b) * 2 + (h)) * HTB)
#define PG8_SB(b, h) ((4 + (b) * 2 + (h)) * HTB)
#define PG8_STAGE(bufoff, gbase, voff) do { _Pragma("unroll") for (int _i = 0; _i < 2; ++_i) \
        __builtin_amdgcn_global_load_lds((const unsigned*)((const char*)(gbase) + (voff)[_i]), (PG8_LAS unsigned*)(lds + (bufoff) + ldsw + _i * 8192), 16, 0, 0); } while (0)
#define PG8_LDA(dst, b, h) do { _Pragma("unroll") for (int m = 0; m < 4; ++m) _Pragma("unroll") for (int k = 0; k < 2; ++k) dst[m][k] = *(const PG8_LAS bf16x8*)(lds + PG8_SA(b, h) + aoff + m * 2048 + k * 1024); } while (0)
#define PG8_LDB(dst, b, h) do { _Pragma("unroll") for (int n = 0; n < 2; ++n) _Pragma("unroll") for (int k = 0; k < 2; ++k) dst[n][k] = *(const PG8_LAS bf16x8*)(lds + PG8_SB(b, h) + boff + n * 2048 + k * 1024); } while (0)
#define PG8_MMA(ai, bj, At, Bt) do { __builtin_amdgcn_s_setprio(1); _Pragma("unroll") for (int m = 0; m < 4; ++m) _Pragma("unroll") for (int n = 0; n < 2; ++n) _Pragma("unroll") for (int k = 0; k < 2; ++k) \
        acc[ai][bj][m][n] = __builtin_amdgcn_mfma_f32_16x16x32_bf16(Bt[n][k], At[m][k], acc[ai][bj][m][n], 0, 0, 0); __builtin_amdgcn_s_setprio(0); } while (0)
#define PG8_WAIT_V(n) asm volatile("s_waitcnt vmcnt(" #n ")" ::: "memory")
#define PG8_WAIT_L(n) asm volatile("s_waitcnt lgkmcnt(" #n ")" ::: "memory")
#define PG8_BAR __builtin_amdgcn_s_barrier()
#define PG8_SCHED __builtin_amdgcn_sched_barrier(0)
    Unit cur, nxt; int ui = 0;
    if (!S.next(0, cur)) return;
    f32x4 acc[2][2][4][2];
#pragma unroll
    for (int a = 0; a < 2; ++a)
#pragma unroll
        for (int b = 0; b < 2; ++b)
#pragma unroll
            for (int m = 0; m < 4; ++m)
#pragma unroll
                for (int n = 0; n < 2; ++n) acc[a][b][m][n] = (f32x4){0.f, 0.f, 0.f, 0.f};
    bf16x8 At[4][2], B0[2][2], B1[2][2];
    const char* cA = (const char*)g.A + (size_t)cur.pm * tstep; const char* cB = (const char*)g.Bt + (size_t)cur.pn * tstep;
    S.a_ready(cur);
    if constexpr (SP2) {
        PG8_STAGE(PG8_SB(0, 0), cB, voffB); PG8_STAGE(PG8_SB(0, 1), cB + hstep, voffB); PG8_STAGE(PG8_SA(0, 0), cA, voffA); PG8_STAGE(PG8_SA(0, 1), cA + hstep, voffA);
        if (wr == 1) PG8_BAR;
        PG8_WAIT_V(2); PG8_BAR;
        PG8_STAGE(PG8_SB(1, 0), cB + kstep, voffB); PG8_STAGE(PG8_SA(1, 0), cA + kstep, voffA); PG8_STAGE(PG8_SB(1, 1), cB + hstep + kstep, voffB);
        PG8_WAIT_V(6); PG8_BAR;
    } else {
        PG8_STAGE(PG8_SB(0, 0), cB, voffB); PG8_STAGE(PG8_SA(0, 0), cA, voffA); PG8_STAGE(PG8_SB(0, 1), cB + hstep, voffB); PG8_STAGE(PG8_SA(0, 1), cA + hstep, voffA);
        if (wr == 1) PG8_BAR;
        PG8_WAIT_V(4); PG8_BAR;
        PG8_STAGE(PG8_SB(1, 0), cB + kstep, voffB); PG8_STAGE(PG8_SA(1, 0), cA + kstep, voffA); PG8_STAGE(PG8_SB(1, 1), cB + hstep + kstep, voffB);
        PG8_WAIT_V(6); PG8_BAR;
    }
    for (;;) {
        const bool has_next = S.next(ui + 1, nxt);
        const char* nA = has_next ? (const char*)g.A + (size_t)nxt.pm * tstep : cA; const char* nB = has_next ? (const char*)g.Bt + (size_t)nxt.pn * tstep : cB;
        for (int t = 0; t < nt; t += 2) {
            const bool last = (t == nt - 2);
            const char* a1 = cA + (size_t)(t + 1) * kstep;
            const char* a2 = last ? nA : cA + (size_t)(t + 2) * kstep; const char* b2 = last ? nB : cB + (size_t)(t + 2) * kstep;
            const char* a3 = a2 + kstep; const char* b3 = b2 + kstep;
            if (last && has_next) S.a_ready(nxt);
            if constexpr (SP2) {
            PG8_LDB(B0, 0, 0); PG8_LDB(B1, 0, 1); PG8_SCHED; PG8_LDA(At, 0, 0); PG8_STAGE(PG8_SA(1, 1), a1 + hstep, voffA);
            PG8_WAIT_V(8); PG8_WAIT_L(0); PG8_BAR; PG8_MMA(0, 0, At, B0); PG8_MMA(0, 1, At, B1); PG8_BAR; PG8_SCHED;
            PG8_LDA(At, 0, 1); PG8_STAGE(PG8_SB(0, 0), b2, voffB); PG8_STAGE(PG8_SB(0, 1), b2 + hstep, voffB); PG8_STAGE(PG8_SA(0, 0), a2, voffA);
            PG8_WAIT_V(8); PG8_WAIT_L(0); PG8_BAR; PG8_MMA(1, 0, At, B0); PG8_MMA(1, 1, At, B1); PG8_BAR; PG8_SCHED;
            PG8_LDB(B0, 1, 0); PG8_LDB(B1, 1, 1); PG8_SCHED; PG8_LDA(At, 1, 0); PG8_STAGE(PG8_SA(0, 1), a2 + hstep, voffA);
            PG8_WAIT_V(8); PG8_WAIT_L(0); PG8_BAR; PG8_MMA(0, 0, At, B0); PG8_MMA(0, 1, At, B1); PG8_BAR; PG8_SCHED;
            PG8_LDA(At, 1, 1); PG8_STAGE(PG8_SB(1, 0), b3, voffB); PG8_STAGE(PG8_SB(1, 1), b3 + hstep, voffB); PG8_STAGE(PG8_SA(1, 0), a3, voffA);
            PG8_WAIT_V(8); PG8_WAIT_L(0); PG8_BAR; PG8_MMA(1, 0, At, B0); PG8_MMA(1, 1, At, B1); PG8_BAR; PG8_SCHED;
            } else {
            PG8_LDB(B0, 0, 0); PG8_SCHED; PG8_LDA(At, 0, 0); PG8_STAGE(PG8_SA(1, 1), a1 + hstep, voffA);
            PG8_WAIT_L(8); PG8_BAR; PG8_WAIT_L(0); PG8_MMA(0, 0, At, B0); PG8_BAR; PG8_SCHED;
            PG8_LDB(B1, 0, 1); PG8_STAGE(PG8_SB(0, 0), b2, voffB);
            PG8_BAR; PG8_WAIT_L(0); PG8_MMA(0, 1, At, B1); PG8_BAR;
            PG8_LDA(At, 0, 1); PG8_STAGE(PG8_SA(0, 0), a2, voffA);
            PG8_BAR; PG8_WAIT_L(0); PG8_MMA(1, 0, At, B0); PG8_BAR; PG8_SCHED;
            PG8_STAGE(PG8_SB(0, 1), b2 + hstep, voffB);
            PG8_WAIT_V(6); PG8_BAR; PG8_MMA(1, 1, At, B1); PG8_BAR;
            PG8_LDB(B0, 1, 0); PG8_SCHED; PG8_LDA(At, 1, 0); PG8_STAGE(PG8_SA(0, 1), a2 + hstep, voffA);
            PG8_WAIT_L(8); PG8_BAR; PG8_WAIT_L(0); PG8_MMA(0, 0, At, B0); PG8_BAR; PG8_SCHED;
            PG8_LDB(B1, 1, 1); PG8_STAGE(PG8_SB(1, 0), b3, voffB);
            PG8_BAR; PG8_WAIT_L(0); PG8_MMA(0, 1, At, B1); PG8_BAR;
            PG8_LDA(At, 1, 1); PG8_STAGE(PG8_SA(1, 0), a3, voffA);
            PG8_BAR; PG8_WAIT_L(0); PG8_MMA(1, 0, At, B0); PG8_BAR; PG8_SCHED;
            PG8_STAGE(PG8_SB(1, 1), b3 + hstep, voffB);
            PG8_WAIT_V(6); PG8_BAR; PG8_MMA(1, 1, At, B1); PG8_BAR;
            }
        }
        if constexpr (ALIGN_EPI) { if (wr == 0) PG8_BAR; }
        if constexpr (!Epi::AFTER_DRAIN) { E(acc, cur, wr, wc, fr, fq); S.done(cur); }
        if (!has_next) break;
#pragma unroll
        for (int a = 0; a < 2; ++a)
#pragma unroll
            for (int b = 0; b < 2; ++b)
#pragma unroll
                for (int m = 0; m < 4; ++m)
#pragma unroll
                    for (int n = 0; n < 2; ++n) acc[a][b][m][n] = (f32x4){0.f, 0.f, 0.f, 0.f};
        cur = nxt; cA = nA; cB = nB; ++ui;
        if constexpr (ALIGN_EPI) { if (wr == 1) PG8_BAR; }
    }
    PG8_WAIT_V(0);
    if constexpr (!ALIGN_EPI) { if (wr == 0) PG8_BAR; }
    PG8_BAR;
    if constexpr (Epi::AFTER_DRAIN) { E.fused(acc, cur, wr, wc, fr, fq, lds, wid, lane); S.done(cur); }
#undef PG8_SA
#undef PG8_SB
#undef PG8_STAGE
#undef PG8_LDA
#undef PG8_LDB
#undef PG8_MMA
#undef PG8_WAIT_V
#undef PG8_WAIT_L
#undef PG8_BAR
#undef PG8_SCHED
}
}

constexpr int DM = 4096, NB = 4, SEQ = 4096, CTXL = 256;
constexpr int MX = NB * SEQ, MC = NB * CTXL, MALL = MX + MC;
constexpr int S5W = 1024, QRANK = 1024, KVRANK = 512, ROPED = 64;
constexpr int INC = 2624, INCP = 2816;
constexpr int NH = 24, DQK = 192, DNOPE = 128, DV = 128;
constexpr int NQ = NH * DQK, NKV = NH * (DNOPE + DV);
constexpr int DFF = 11008, NMOD = 6 * DM;
constexpr float EPS = 1e-6f;
constexpr float QSCALE = 0.07216878364870322f * 1.4426950408889634f;
constexpr int NKT = (CTXL + SEQ) / 64;

constexpr size_t MiB = 1u << 20;
constexpr size_t WS_CTL = 0, CTL_ZERO_BYTES = 1 * MiB;
constexpr size_t WS_MOD = 1 * MiB;
constexpr size_t WS_S5A = 2 * MiB;
constexpr size_t WS_S5BR = 2 * MiB + 65536;
constexpr size_t WS_S5BI = WS_S5BR + 524288;
constexpr size_t WS_ROPE = 4 * MiB;
constexpr size_t WS_PART = 5 * MiB;
constexpr size_t WS_WIN = 16 * MiB, WS_WUQ = 38 * MiB, WS_WUKV = 47 * MiB, WS_WGLU = 53 * MiB, WS_WOUT = 55 * MiB, WS_WFIN = 87 * MiB, WS_WDOWN = 259 * MiB;
constexpr size_t WS_R1 = 345 * MiB, WS_R2 = 1033 * MiB, WS_END = 1377 * MiB;
constexpr size_t WS_H = WS_R1, WS_PX = WS_R1 + 136 * MiB, WS_QCN = WS_R1 + 230 * MiB, WS_KVCN = WS_R1 + 262 * MiB, WS_KROPE = WS_R1 + 279 * MiB, WS_Q = WS_R1 + 282 * MiB, WS_KV = WS_R1 + 426 * MiB;
constexpr size_t WS_MIX = WS_R1, WS_F = WS_R1;
constexpr size_t WS_ACT = WS_R1 + 256 * MiB, WS_HG = WS_R1 + 600 * MiB, WS_HU = WS_R1 + 644 * MiB;
constexpr size_t WS_MIXIN = WS_R2, WS_YG = WS_R2 + 128 * MiB, WS_YDIR = WS_R2 + 160 * MiB, WS_HX = WS_R2;
constexpr size_t WS_S5W1 = WS_R2 + 288 * MiB, WS_S5LAG = WS_R2 + 320 * MiB, WS_S5PW = WS_R2 + 325 * MiB, WS_S5AT = WS_R2 + 330 * MiB, WS_S5W3 = WS_R1 + 630 * MiB;
static_assert(WS_KV + (size_t)MALL * NKV * 2 <= WS_S5W3 && WS_S5W3 + 32 * MiB <= WS_R2 && WS_S5AT + 65536 <= WS_END && (size_t)128 * 65 * 64 * 8 <= 5 * MiB, "ws map (s5)");
static_assert(WS_KV + (size_t)MALL * NKV * 2 <= WS_R2 && WS_YDIR + (size_t)2 * MX * S5W * 4 <= WS_END && WS_ACT + (size_t)MX * DFF * 2 <= WS_HG && WS_HG + (size_t)1024 * DFF * 4 <= WS_HU && WS_HU + (size_t)512 * DFF * 4 <= WS_R2, "ws map");
static_assert(WS_WIN + (size_t)INCP * DM * 2 <= WS_WUQ && WS_WFIN + (size_t)2 * DFF * DM * 2 <= WS_WDOWN && WS_WDOWN + (size_t)DM * DFF * 2 <= WS_R1 && WS_PART + (size_t)16 * 5 * NMOD * 4 <= WS_WIN, "ws map (weights)");
constexpr int CW_BAR = 4096;

constexpr int RING_BYTES = 131072;
constexpr int LDSCTL_OFF = RING_BYTES, MISC_OFF = LDSCTL_OFF + 320;
constexpr int LDS_BYTES = 147456;
constexpr int NWAVES = 8;

#define GAS __attribute__((address_space(1)))
#define LAS __attribute__((address_space(3)))
typedef unsigned short bf16;
typedef unsigned v4u __attribute__((ext_vector_type(4)));
typedef unsigned v2u __attribute__((ext_vector_type(2)));
typedef float f32x4 __attribute__((ext_vector_type(4)));
#define LDS_WAIT() asm volatile("s_waitcnt lgkmcnt(0)" ::: "memory")
__device__ __forceinline__ unsigned f2bf(float f) { unsigned u = __builtin_bit_cast(unsigned, f); return (u + 0x7fffu + ((u >> 16) & 1u)) >> 16; }
__device__ __forceinline__ unsigned pk2(float lo, float hi) { return f2bf(lo) | (f2bf(hi) << 16); }
__device__ __forceinline__ float bflo(unsigned w) { return __uint_as_float(w << 16); }
__device__ __forceinline__ float bfhi(unsigned w) { return __uint_as_float(w & 0xffff0000u); }
__device__ __forceinline__ float wave_sum(float v) {
#pragma unroll
    for (int o = 1; o < 64; o <<= 1) v += __shfl_xor(v, o);
    return v;
}

#define XB_TMO      128
#define XB_XCNT(j)  (256  + 64 * (j))
#define XB_XSUB(j)  (1280 + 64 * (j))
#define XB_XGEN(j)  (2304 + 64 * (j))
#define XB_TOP      3328
#define XB_TOPGEN   3392
#define XCD_BAR_WORDS 3456
#define XB_SPIN_CAP (1u << 18)

__device__ __forceinline__ unsigned xb_ld(unsigned* p)              { return __hip_atomic_load(p, __ATOMIC_RELAXED, __HIP_MEMORY_SCOPE_AGENT); }
__device__ __forceinline__ unsigned xb_add(unsigned* p, unsigned v) { return __hip_atomic_fetch_add(p, v, __ATOMIC_RELAXED, __HIP_MEMORY_SCOPE_AGENT); }
__device__ __forceinline__ unsigned xb_xcc_id() { return (unsigned)__builtin_amdgcn_s_getreg((3 << 11) | 20) & 0xFu; }
#define XB_SPIN(cond, bar) do { unsigned _sp = 0; while (cond) { __builtin_amdgcn_s_sleep(1); \
    if ((++_sp & 255u) == 0u) { if (xb_ld(&(bar)[XB_TMO])) break; if (_sp > XB_SPIN_CAP) { atomicAdd(&(bar)[XB_TMO], 1u); break; } } } } while (0)

struct XcdBarrier {
    unsigned* bar; unsigned x;
    volatile LAS unsigned* st;
};

__device__ __forceinline__ XcdBarrier xcd_barrier_post(unsigned* bar, volatile LAS unsigned* st) {
    XcdBarrier b; b.bar = bar; b.x = xb_xcc_id(); b.st = st;
    if (threadIdx.x == 0) (void)xb_add(&bar[XB_XCNT(b.x)], 1u);
    return b;
}
__device__ __forceinline__ void xcd_barrier_complete(unsigned* bar, unsigned x, unsigned& nloc, unsigned& nx) {
    const unsigned G = gridDim.x * gridDim.y * gridDim.z;
    unsigned sum, cnt, mine, sp = 0u;
    for (;;) {
        sum = 0u; cnt = 0u; mine = 0u;
#pragma unroll
        for (unsigned j = 0; j < 16; ++j) { const unsigned c = xb_ld(&bar[XB_XCNT(j)]); sum += c; cnt += (c > 0u) ? 1u : 0u; mine = (j == x) ? c : mine; }
        if (sum == G) break;
        __builtin_amdgcn_s_sleep(1);
        if ((++sp & 255u) == 0u) { if (xb_ld(&bar[XB_TMO])) break; if (sp > XB_SPIN_CAP) { atomicAdd(&bar[XB_TMO], 1u); break; } }
    }
    nloc = mine > 0u ? mine : 1u; nx = cnt > 0u ? cnt : 1u;
}

__device__ __forceinline__ void xcd_barrier(const XcdBarrier& b) {
    asm volatile("s_waitcnt vmcnt(0)" ::: "memory");
    __syncthreads();
    if (threadIdx.x == 0) {
        unsigned* bar = b.bar;
        __builtin_amdgcn_s_waitcnt(0);
        unsigned nloc = b.st[0], nx = b.st[1];
        if (nloc == 0u) { xcd_barrier_complete(bar, b.x, nloc, nx); b.st[0] = nloc; b.st[1] = nx; }
        const unsigned old = xb_add(&bar[XB_XSUB(b.x)], 1u);
        const unsigned gen = old / nloc;
        if (old + 1u == (gen + 1u) * nloc) {
            __builtin_amdgcn_fence(__ATOMIC_RELEASE, "agent");
            asm volatile("s_waitcnt vmcnt(0)" ::: "memory");
            const unsigned og = xb_add(&bar[XB_TOP], 1u);
            const unsigned tg = og / nx;
            if (og + 1u == (tg + 1u) * nx) xb_add(&bar[XB_TOPGEN], 1u);
            else XB_SPIN(xb_ld(&bar[XB_TOPGEN]) == tg, bar);
            __builtin_amdgcn_fence(__ATOMIC_ACQUIRE, "agent");
            xb_add(&bar[XB_XGEN(b.x)], 1u);
            asm volatile("s_waitcnt vmcnt(0)" ::: "memory");
        } else {
            XB_SPIN(xb_ld(&bar[XB_XGEN(b.x)]) == gen, bar);
            __builtin_amdgcn_fence(__ATOMIC_ACQUIRE, "agent");
            asm volatile("s_waitcnt vmcnt(0)" ::: "memory");
        }
    }
    __syncthreads();
}

template <bool FFN_IL = false> __device__ __forceinline__ void p0_transpose_item(const float* W, int K, int N, bf16* WT, LAS float* scr, int item, int lane) {
    const int nblk = N / 32, kb = item / nblk, nb = item % nblk, k0 = 64 * kb, n0 = 32 * nb;
    const int dn0 = !FFN_IL ? n0 : (n0 < DFF ? 256 * (n0 / 128) + (n0 % 128) : 256 * ((n0 - DFF) / 128) + 128 + ((n0 - DFF) % 128));
#pragma unroll 8
    for (int i = 0; i < 32; ++i) { const int kk = 2 * i + (lane >> 5); scr[kk * 33 + (lane & 31)] = W[(size_t)(k0 + kk) * N + n0 + (lane & 31)]; }
    LDS_WAIT(); asm volatile("" ::: "memory");
    const int c = lane & 7;
#pragma unroll
    for (int j = 0; j < 4; ++j) { const int n = (lane >> 3) + 8 * j; const LAS float* s = scr + (8 * c) * 33 + n;
        v4u o; o.x = pk2(s[0 * 33], s[1 * 33]); o.y = pk2(s[2 * 33], s[3 * 33]); o.z = pk2(s[4 * 33], s[5 * 33]); o.w = pk2(s[6 * 33], s[7 * 33]);
        *(GAS v4u*)(WT + (size_t)(dn0 + n) * K + k0 + 8 * c) = o; }
    LDS_WAIT(); asm volatile("" ::: "memory");
}
__device__ __forceinline__ void p0_ada_item(const float* c, const float* cctx, const float* w_ada, float* part, int item, int lane) {
    const int nb = item % 96, ks = item / 96, n0 = nb * 256 + lane * 4, k0 = ks * 256;
    f32x4 acc[5];
#pragma unroll
    for (int r = 0; r < 5; ++r) acc[r] = (f32x4){0.f, 0.f, 0.f, 0.f};
    for (int kk = 0; kk < 256; kk += 4) {
        f32x4 w[4];
#pragma unroll
        for (int j = 0; j < 4; ++j) w[j] = *(const GAS f32x4*)(w_ada + (size_t)(k0 + kk + j) * NMOD + n0);
#pragma unroll
        for (int j = 0; j < 4; ++j) {
#pragma unroll
            for (int r = 0; r < 5; ++r) { const float cv = (r < 4) ? c[r * DM + k0 + kk + j] : cctx[k0 + kk + j]; const float s = cv / (1.f + expf(-cv)); acc[r] += w[j] * s; }
        }
    }
#pragma unroll
    for (int r = 0; r < 5; ++r) *(GAS f32x4*)(part + (size_t)(ks * 5 + r) * NMOD + n0) = acc[r];
}

struct P {
    const float *x, *c, *ctx, *cctx, *w_ada, *b_ada, *g_pre_mix, *g_post_mix, *g_pre_ffn, *g_post_ffn, *w_in;
    const float *lam_re, *lam_im, *log_step, *b_re, *b_im, *c_re, *c_im, *s5d, *w_glu, *g_q, *w_uq, *g_kv, *w_ukv, *w_out, *ffn_w_in, *conv_w, *conv_b, *ffn_w_down;
    float* out;
    float *mod, *abar, *bbr, *bbi, *rope, *part, *mix, *f, *ydir;
    bf16 *WinT, *WuqT, *WukvT, *WgluT, *WoutT, *WfinT, *WdownT;
    bf16 *h, *px, *qcn, *kvcn, *krope, *q, *kv, *mixin, *yg, *hx, *act;
};

__device__ __forceinline__ void phase_prologue(const P& p, LAS unsigned char* lds, int gw, int NGW, int wave, int lane, int gtid, int NGT) {
    LAS float* scr = (LAS float*)(lds + wave * 16384);
    constexpr int I_IN = (DM / 64) * (INC / 32), I_UQ = (QRANK / 64) * (NQ / 32), I_UKV = (KVRANK / 64) * (NKV / 32), I_GLU = (S5W / 64) * (S5W / 32),
                  I_OUT = (DM / 64) * (DM / 32), I_FIN = (DM / 64) * (2 * DFF / 32), I_DOWN = (DFF / 64) * (DM / 32), I_ADA = 96 * 16;
    constexpr int NITEMS = I_ADA + I_IN + I_UQ + I_UKV + I_GLU + I_OUT + I_FIN + I_DOWN;
    for (int it = gw; it < NITEMS; it += NGW) {
        int r = it;
        if (r < I_ADA) { p0_ada_item(p.c, p.cctx, p.w_ada, p.part, r, lane); continue; } r -= I_ADA;
        if (r < I_IN) { p0_transpose_item(p.w_in, DM, INC, p.WinT, scr, r, lane); continue; } r -= I_IN;
        if (r < I_UQ) { p0_transpose_item(p.w_uq, QRANK, NQ, p.WuqT, scr, r, lane); continue; } r -= I_UQ;
        if (r < I_UKV) { p0_transpose_item(p.w_ukv, KVRANK, NKV, p.WukvT, scr, r, lane); continue; } r -= I_UKV;
        if (r < I_GLU) { p0_transpose_item(p.w_glu, S5W, S5W, p.WgluT, scr, r, lane); continue; } r -= I_GLU;
        if (r < I_OUT) { p0_transpose_item(p.w_out, DM, DM, p.WoutT, scr, r, lane); continue; } r -= I_OUT;
        if (r < I_FIN) { p0_transpose_item<true>(p.ffn_w_in, DM, 2 * DFF, p.WfinT, scr, r, lane); continue; } r -= I_FIN;
        p0_transpose_item(p.ffn_w_down, DFF, DM, p.WdownT, scr, r, lane);
    }
    { GAS v4u* z = (GAS v4u*)(p.WinT + (size_t)INC * DM); const int n16 = (INCP - INC) * DM * 2 / 16; for (int i = gtid; i < n16; i += NGT) z[i] = (v4u){0u, 0u, 0u, 0u}; }
    for (int i = gtid; i < 2 * 64 * 64; i += NGT) {
        const int dg = i >> 6;
        const float lr = p.lam_re[i], li = p.lam_im[i], dt = expf(p.log_step[dg]);
        const float mag = expf(lr * dt); float sn, cs; sincosf(li * dt, &sn, &cs);
        const float ar = mag * cs, ai = mag * sn, den = lr * lr + li * li, nr = ar - 1.f, ni = ai;
        const float fr = (nr * lr + ni * li) / den, fi = (ni * lr - nr * li) / den;
        p.abar[2 * i] = ar; p.abar[2 * i + 1] = ai;
#pragma unroll
        for (int cc = 0; cc < 16; ++cc) { const float br = p.b_re[(size_t)i * 16 + cc], bi = p.b_im[(size_t)i * 16 + cc]; p.bbr[(size_t)i * 16 + cc] = fr * br - fi * bi; p.bbi[(size_t)i * 16 + cc] = fr * bi + fi * br; }
    }
    for (int i = gtid; i < SEQ * 32; i += NGT) {
        const int t = i >> 5, j = i & 31; const float pos = (float)((j < 16) ? (t >> 6) : (t & 63));
        const float inv = powf(10000.f, -(float)(j & 15) * (1.f / 16.f)); float sn, cs; sincosf(pos * inv, &sn, &cs);
        p.rope[2 * i] = cs; p.rope[2 * i + 1] = sn;
    }
}
__device__ __forceinline__ void phase_modreduce(const P& p, int gtid, int NGT) {
    for (int i = gtid; i < 5 * NMOD; i += NGT) { const int n = i % NMOD; float s = p.b_ada[n];
#pragma unroll
        for (int ks = 0; ks < 16; ++ks) s += p.part[(size_t)ks * 5 * NMOD + i];
        p.mod[i] = s; }
}
__device__ __forceinline__ void phase_norm1(const P& p, int gw, int NGW, int lane) {
    for (int row = gw; row < MALL; row += NGW) {
        const float* src = row < MX ? p.x + (size_t)row * DM : p.ctx + (size_t)(row - MX) * DM;
        const float* md = p.mod + (size_t)(row < MX ? row / SEQ : 4) * NMOD;
        const GAS f32x4* xr = (const GAS f32x4*)src + lane;
        f32x4 v[16]; float ss = 0.f;
#pragma unroll
        for (int j = 0; j < 16; ++j) { v[j] = xr[64 * j]; ss += (v[j].x * v[j].x + v[j].y * v[j].y) + (v[j].z * v[j].z + v[j].w * v[j].w); }
        const float rstd = rsqrtf(wave_sum(ss) * (1.f / DM) + EPS);
        GAS unsigned long long* o8 = (GAS unsigned long long*)(p.h + (size_t)row * DM) + lane;
#pragma unroll
        for (int j = 0; j < 16; ++j) { const f32x4 g = ((const GAS f32x4*)p.g_pre_mix)[lane + 64 * j], sh = ((const GAS f32x4*)md)[lane + 64 * j], sc = ((const GAS f32x4*)(md + DM))[lane + 64 * j];
            const f32x4 o = (v[j] * rstd) * g * (sc + 1.f) + sh;
            o8[64 * j] = (unsigned long long)pk2(o.x, o.y) | ((unsigned long long)pk2(o.z, o.w) << 32); }
    }
}
__device__ __forceinline__ void phase_postin(const P& p, int gw, int NGW, int lane) {
    for (int row = gw; row < MALL; row += NGW) {
        const bf16* pr = p.px + (size_t)row * INCP;
        { const v4u w = *(const GAS v4u*)(pr + 2048 + lane * 8);
          float v[8] = {bflo(w.x), bfhi(w.x), bflo(w.y), bfhi(w.y), bflo(w.z), bfhi(w.z), bflo(w.w), bfhi(w.w)}; float ss = 0.f;
#pragma unroll
          for (int j = 0; j < 8; ++j) ss += v[j] * v[j];
          const float rstd = rsqrtf(wave_sum(ss) * (1.f / KVRANK) + EPS);
          const f32x4 g0 = *(const GAS f32x4*)(p.g_kv + lane * 8), g1 = *(const GAS f32x4*)(p.g_kv + lane * 8 + 4);
          v4u o; o.x = pk2(v[0] * rstd * g0.x, v[1] * rstd * g0.y); o.y = pk2(v[2] * rstd * g0.z, v[3] * rstd * g0.w); o.z = pk2(v[4] * rstd * g1.x, v[5] * rstd * g1.y); o.w = pk2(v[6] * rstd * g1.z, v[7] * rstd * g1.w);
          *(GAS v4u*)(p.kvcn + (size_t)row * KVRANK + lane * 8) = o; }
        if (lane < 32) { const unsigned w = *(const GAS unsigned*)(pr + 2560 + lane * 2); float x1 = bflo(w), x2 = bfhi(w);
          if (row < MX) { const int t = row & (SEQ - 1); const float cs = p.rope[((size_t)t * 32 + lane) * 2], sn = p.rope[((size_t)t * 32 + lane) * 2 + 1]; const float a = x1 * cs - x2 * sn, b = x1 * sn + x2 * cs; x1 = a; x2 = b; }
          *(GAS unsigned*)(p.krope + (size_t)row * ROPED + lane * 2) = pk2(x1, x2); }
        if (row < MX) {
          const v4u w0 = *(const GAS v4u*)(pr + 1024 + lane * 8), w1 = *(const GAS v4u*)(pr + 1024 + 512 + lane * 8);
          float v[16] = {bflo(w0.x), bfhi(w0.x), bflo(w0.y), bfhi(w0.y), bflo(w0.z), bfhi(w0.z), bflo(w0.w), bfhi(w0.w), bflo(w1.x), bfhi(w1.x), bflo(w1.y), bfhi(w1.y), bflo(w1.z), bfhi(w1.z), bflo(w1.w), bfhi(w1.w)}; float ss = 0.f;
#pragma unroll
          for (int j = 0; j < 16; ++j) ss += v[j] * v[j];
          const float rstd = rsqrtf(wave_sum(ss) * (1.f / QRANK) + EPS);
#pragma unroll
          for (int hh = 0; hh < 2; ++hh) { const f32x4 g0 = *(const GAS f32x4*)(p.g_q + hh * 512 + lane * 8), g1 = *(const GAS f32x4*)(p.g_q + hh * 512 + lane * 8 + 4);
            v4u o; o.x = pk2(v[8 * hh + 0] * rstd * g0.x, v[8 * hh + 1] * rstd * g0.y); o.y = pk2(v[8 * hh + 2] * rstd * g0.z, v[8 * hh + 3] * rstd * g0.w);
            o.z = pk2(v[8 * hh + 4] * rstd * g1.x, v[8 * hh + 5] * rstd * g1.y); o.w = pk2(v[8 * hh + 6] * rstd * g1.z, v[8 * hh + 7] * rstd * g1.w);
            *(GAS v4u*)(p.qcn + (size_t)row * QRANK + hh * 512 + lane * 8) = o; }
        }
    }
}

__device__ __forceinline__ void phase_attn_v0(const P& p, LAS unsigned char* lds, int blk, int G) {
    constexpr int QS = 400, KS = 400, VS = 272, PS = 272;
    LAS unsigned char* Qs = lds; LAS unsigned char* Ks = lds + 128 * QS; LAS unsigned char* Vs = Ks + 64 * KS; LAS unsigned char* Ps = Vs + 64 * VS;
    const int tid = ltid(), tq = tid >> 4, tk = tid & 15;
    for (int unit = blk; unit < NB * NH * (SEQ / 128); unit += G) {
        const int qt = unit % (SEQ / 128), bh = unit / (SEQ / 128), b = bh / NH, hd = bh % NH;
        const size_t qrow0 = (size_t)b * SEQ + qt * 128;
        __syncthreads();
        for (int c = tid; c < 128 * 24; c += 512) { const int r = c / 24, part = c % 24; *(LAS v4u*)(Qs + r * QS + part * 16) = *(const GAS v4u*)(p.q + (qrow0 + r) * NQ + hd * DQK + part * 8); }
        float m[4], l[4], o[4][8];
#pragma unroll
        for (int i = 0; i < 4; ++i) { m[i] = -INFINITY; l[i] = 0.f;
#pragma unroll
            for (int e = 0; e < 8; ++e) o[i][e] = 0.f; }
        for (int kt = 0; kt < NKT; ++kt) {
            __syncthreads();
            for (int c = tid; c < 64 * 24; c += 512) { const int kk = c / 24, part = c % 24; const int n = kt * 64 + kk; const size_t row = n < CTXL ? (size_t)MX + b * CTXL + n : (size_t)b * SEQ + (n - CTXL);
                const v4u w = part < 16 ? *(const GAS v4u*)(p.kv + row * NKV + hd * 256 + part * 8) : *(const GAS v4u*)(p.krope + row * ROPED + (part - 16) * 8);
                *(LAS v4u*)(Ks + kk * KS + part * 16) = w; }
            for (int c = tid; c < 64 * 16; c += 512) { const int kk = c / 16, part = c % 16; const int n = kt * 64 + kk; const size_t row = n < CTXL ? (size_t)MX + b * CTXL + n : (size_t)b * SEQ + (n - CTXL);
                *(LAS v4u*)(Vs + kk * VS + part * 16) = *(const GAS v4u*)(p.kv + row * NKV + hd * 256 + 128 + part * 8); }
            __syncthreads();
            float s[4][4];
#pragma unroll
            for (int i = 0; i < 4; ++i)
#pragma unroll
                for (int j = 0; j < 4; ++j) s[i][j] = 0.f;
            for (int d = 0; d < 24; ++d) {
                v4u qv[4], kv4[4];
#pragma unroll
                for (int i = 0; i < 4; ++i) { qv[i] = *(const LAS v4u*)(Qs + (4 * tq + i) * QS + d * 16); kv4[i] = *(const LAS v4u*)(Ks + (4 * tk + i) * KS + d * 16); }
#pragma unroll
                for (int i = 0; i < 4; ++i)
#pragma unroll
                    for (int j = 0; j < 4; ++j) {
                        s[i][j] += bflo(qv[i].x) * bflo(kv4[j].x) + bfhi(qv[i].x) * bfhi(kv4[j].x) + bflo(qv[i].y) * bflo(kv4[j].y) + bfhi(qv[i].y) * bfhi(kv4[j].y)
                                 + bflo(qv[i].z) * bflo(kv4[j].z) + bfhi(qv[i].z) * bfhi(kv4[j].z) + bflo(qv[i].w) * bflo(kv4[j].w) + bfhi(qv[i].w) * bfhi(kv4[j].w); }
            }
#pragma unroll
            for (int i = 0; i < 4; ++i) {
                float rm = fmaxf(fmaxf(s[i][0], s[i][1]), fmaxf(s[i][2], s[i][3]));
                rm = fmaxf(rm, __shfl_xor(rm, 1)); rm = fmaxf(rm, __shfl_xor(rm, 2)); rm = fmaxf(rm, __shfl_xor(rm, 4)); rm = fmaxf(rm, __shfl_xor(rm, 8));
                const float mn = fmaxf(m[i], rm), alpha = exp2f(m[i] - mn); m[i] = mn;
                float rs = 0.f;
#pragma unroll
                for (int j = 0; j < 4; ++j) { s[i][j] = exp2f(s[i][j] - mn); rs += s[i][j]; }
                rs += __shfl_xor(rs, 1); rs += __shfl_xor(rs, 2); rs += __shfl_xor(rs, 4); rs += __shfl_xor(rs, 8);
                l[i] = l[i] * alpha + rs;
#pragma unroll
                for (int e = 0; e < 8; ++e) o[i][e] *= alpha;
                *(LAS f32x4*)(Ps + (4 * tq + i) * PS + tk * 16) = (f32x4){s[i][0], s[i][1], s[i][2], s[i][3]};
            }
            __syncthreads();
            for (int j = 0; j < 64; ++j) {
                const v4u vv = *(const LAS v4u*)(Vs + j * VS + tk * 16);
                const float v8[8] = {bflo(vv.x), bfhi(vv.x), bflo(vv.y), bfhi(vv.y), bflo(vv.z), bfhi(vv.z), bflo(vv.w), bfhi(vv.w)};
#pragma unroll
                for (int i = 0; i < 4; ++i) { const float pj = *(const LAS float*)(Ps + (4 * tq + i) * PS + j * 4);
#pragma unroll
                    for (int e = 0; e < 8; ++e) o[i][e] += pj * v8[e]; }
            }
        }
#pragma unroll
        for (int i = 0; i < 4; ++i) { const float rl = 1.f / l[i];
            v4u w; w.x = pk2(o[i][0] * rl, o[i][1] * rl); w.y = pk2(o[i][2] * rl, o[i][3] * rl); w.z = pk2(o[i][4] * rl, o[i][5] * rl); w.w = pk2(o[i][6] * rl, o[i][7] * rl);
            *(GAS v4u*)(p.mixin + (qrow0 + 4 * tq + i) * DM + S5W + hd * DV + tk * 8) = w; }
    }
}

__device__ __forceinline__ void phase_s5_v0(const P& p, LAS unsigned char* lds, int blk, int G, int wave, int lane) {
    if (wave >= 2) return;
    LAS float* ul = (LAS float*)(lds + wave * 49152);
    LAS float* hbr = ul + 1024;
    LAS float* hbi = hbr + 64 * 65;
    LAS float* Cl = hbi + 64 * 65;
    for (int unit = blk + G * wave; unit < NB * 2 * 64; unit += 2 * G) {
        const int g = unit & 63, dir = (unit >> 6) & 1, b = unit >> 7;
        const int sidx = (dir * 64 + g) * 64 + lane;
        const float ar = p.abar[2 * sidx], ai = p.abar[2 * sidx + 1];
        float bbr[16], bbi[16];
#pragma unroll
        for (int cc = 0; cc < 16; ++cc) { bbr[cc] = p.bbr[(size_t)sidx * 16 + cc]; bbi[cc] = p.bbi[(size_t)sidx * 16 + cc]; }
        LDS_WAIT();
#pragma unroll
        for (int cc = 0; cc < 16; ++cc) { Cl[lane * 32 + cc] = p.c_re[((size_t)(dir * 64 + g) * 16 + cc) * 64 + lane]; Cl[lane * 32 + 16 + cc] = p.c_im[((size_t)(dir * 64 + g) * 16 + cc) * 64 + lane]; }
        float hr = 0.f, hi = 0.f;
        for (int k = 0; k < NKT; ++k) {
            { const int s = k * 64 + lane; size_t row;
              if (dir == 0) row = s < CTXL ? (size_t)MX + b * CTXL + s : (size_t)b * SEQ + (s - CTXL);
              else row = s < CTXL ? (size_t)MX + b * CTXL + (CTXL - 1 - s) : (size_t)b * SEQ + (SEQ - 1 - (s - CTXL));
              const v4u w0 = *(const GAS v4u*)(p.px + row * INCP + g * 16), w1 = *(const GAS v4u*)(p.px + row * INCP + g * 16 + 8);
              LDS_WAIT();
              *(LAS f32x4*)(ul + lane * 16) = (f32x4){bflo(w0.x), bfhi(w0.x), bflo(w0.y), bfhi(w0.y)}; *(LAS f32x4*)(ul + lane * 16 + 4) = (f32x4){bflo(w0.z), bfhi(w0.z), bflo(w0.w), bfhi(w0.w)};
              *(LAS f32x4*)(ul + lane * 16 + 8) = (f32x4){bflo(w1.x), bfhi(w1.x), bflo(w1.y), bfhi(w1.y)}; *(LAS f32x4*)(ul + lane * 16 + 12) = (f32x4){bflo(w1.z), bfhi(w1.z), bflo(w1.w), bfhi(w1.w)}; }
            LDS_WAIT();
#pragma unroll 4
            for (int j = 0; j < 64; ++j) {
                const f32x4 u0 = *(const LAS f32x4*)(ul + j * 16), u1 = *(const LAS f32x4*)(ul + j * 16 + 4), u2 = *(const LAS f32x4*)(ul + j * 16 + 8), u3 = *(const LAS f32x4*)(ul + j * 16 + 12);
                const float uu[16] = {u0.x, u0.y, u0.z, u0.w, u1.x, u1.y, u1.z, u1.w, u2.x, u2.y, u2.z, u2.w, u3.x, u3.y, u3.z, u3.w};
                float bur = 0.f, bui = 0.f;
#pragma unroll
                for (int cc = 0; cc < 16; ++cc) { bur += bbr[cc] * uu[cc]; bui += bbi[cc] * uu[cc]; }
                const float nhr = ar * hr - ai * hi + bur, nhi = ar * hi + ai * hr + bui; hr = nhr; hi = nhi;
                if (k >= CTXL / 64) { hbr[j * 65 + lane] = hr; hbi[j * 65 + lane] = hi; }
            }
            if (k >= CTXL / 64) {
                LDS_WAIT();
                float acc[16];
#pragma unroll
                for (int cc = 0; cc < 16; ++cc) acc[cc] = 0.f;
#pragma unroll 2
                for (int pp = 0; pp < 64; ++pp) {
                    const float xr = hbr[lane * 65 + pp], xi = hbi[lane * 65 + pp];
                    const f32x4 r0 = *(const LAS f32x4*)(Cl + pp * 32), r1 = *(const LAS f32x4*)(Cl + pp * 32 + 4), r2 = *(const LAS f32x4*)(Cl + pp * 32 + 8), r3 = *(const LAS f32x4*)(Cl + pp * 32 + 12);
                    const f32x4 i0 = *(const LAS f32x4*)(Cl + pp * 32 + 16), i1 = *(const LAS f32x4*)(Cl + pp * 32 + 20), i2 = *(const LAS f32x4*)(Cl + pp * 32 + 24), i3 = *(const LAS f32x4*)(Cl + pp * 32 + 28);
                    const float cr[16] = {r0.x, r0.y, r0.z, r0.w, r1.x, r1.y, r1.z, r1.w, r2.x, r2.y, r2.z, r2.w, r3.x, r3.y, r3.z, r3.w};
                    const float ci[16] = {i0.x, i0.y, i0.z, i0.w, i1.x, i1.y, i1.z, i1.w, i2.x, i2.y, i2.z, i2.w, i3.x, i3.y, i3.z, i3.w};
#pragma unroll
                    for (int cc = 0; cc < 16; ++cc) acc[cc] += cr[cc] * xr - ci[cc] * xi;
                }
                const int s = k * 64 + lane - CTXL; const int t = dir == 0 ? s : SEQ - 1 - s;
                GAS f32x4* yo = (GAS f32x4*)(p.ydir + ((size_t)dir * MX + (size_t)b * SEQ + t) * S5W + g * 16);
                yo[0] = (f32x4){acc[0], acc[1], acc[2], acc[3]}; yo[1] = (f32x4){acc[4], acc[5], acc[6], acc[7]}; yo[2] = (f32x4){acc[8], acc[9], acc[10], acc[11]}; yo[3] = (f32x4){acc[12], acc[13], acc[14], acc[15]};
            }
        }
    }
}
__device__ __forceinline__ void phase_s5gelu(const P& p, int gtid, int NGT) {
    for (int i = gtid; i < MX * (S5W / 8); i += NGT) {
        const int row = i >> 7, c0 = (i & 127) * 8;
        const v4u uw = *(const GAS v4u*)(p.px + (size_t)row * INCP + c0);
        const float u[8] = {bflo(uw.x), bfhi(uw.x), bflo(uw.y), bfhi(uw.y), bflo(uw.z), bfhi(uw.z), bflo(uw.w), bfhi(uw.w)};
        const f32x4 a0 = *(const GAS f32x4*)(p.ydir + (size_t)row * S5W + c0), a1 = *(const GAS f32x4*)(p.ydir + (size_t)row * S5W + c0 + 4);
        const f32x4 b0 = *(const GAS f32x4*)(p.ydir + ((size_t)MX + row) * S5W + c0), b1 = *(const GAS f32x4*)(p.ydir + ((size_t)MX + row) * S5W + c0 + 4);
        const f32x4 d0 = *(const GAS f32x4*)(p.s5d + c0), d1 = *(const GAS f32x4*)(p.s5d + c0 + 4);
        const float y[8] = {d0.x * u[0] + a0.x + b0.x, d0.y * u[1] + a0.y + b0.y, d0.z * u[2] + a0.z + b0.z, d0.w * u[3] + a0.w + b0.w, d1.x * u[4] + a1.x + b1.x, d1.y * u[5] + a1.y + b1.y, d1.z * u[6] + a1.z + b1.z, d1.w * u[7] + a1.w + b1.w};
        float gl[8];
#pragma unroll
        for (int j = 0; j < 8; ++j) { const float v = y[j]; gl[j] = 0.5f * v * (1.f + tanhf(0.7978845608028654f * (v + 0.044715f * v * v * v))); }
        v4u o; o.x = pk2(gl[0], gl[1]); o.y = pk2(gl[2], gl[3]); o.z = pk2(gl[4], gl[5]); o.w = pk2(gl[6], gl[7]);
        *(GAS v4u*)(p.yg + (size_t)row * S5W + c0) = o;
    }
}
__device__ __forceinline__ void phase_mid(const P& p, int gw, int NGW, int lane) {
    for (int row = gw; row < MX; row += NGW) {
        const float* md = p.mod + (size_t)(row / SEQ) * NMOD;
        const GAS f32x4* mr = (const GAS f32x4*)(p.mix + (size_t)row * DM) + lane; const GAS f32x4* xr = (const GAS f32x4*)(p.x + (size_t)row * DM) + lane;
        f32x4 v[16]; float ss = 0.f;
#pragma unroll
        for (int j = 0; j < 16; ++j) { v[j] = mr[64 * j]; ss += (v[j].x * v[j].x + v[j].y * v[j].y) + (v[j].z * v[j].z + v[j].w * v[j].w); }
        const float rstd = rsqrtf(wave_sum(ss) * (1.f / DM) + EPS); float s2 = 0.f;
        GAS f32x4* xo = (GAS f32x4*)(p.out + (size_t)row * DM) + lane;
#pragma unroll
        for (int j = 0; j < 16; ++j) { const f32x4 g = ((const GAS f32x4*)p.g_post_mix)[lane + 64 * j], ga = ((const GAS f32x4*)(md + 2 * DM))[lane + 64 * j];
            v[j] = xr[64 * j] + ga * ((v[j] * rstd) * g); xo[64 * j] = v[j]; s2 += (v[j].x * v[j].x + v[j].y * v[j].y) + (v[j].z * v[j].z + v[j].w * v[j].w); }
        const float rstd2 = rsqrtf(wave_sum(s2) * (1.f / DM) + EPS);
        GAS unsigned long long* o8 = (GAS unsigned long long*)(p.hx + (size_t)row * DM) + lane;
#pragma unroll
        for (int j = 0; j < 16; ++j) { const f32x4 g = ((const GAS f32x4*)p.g_pre_ffn)[lane + 64 * j], sh = ((const GAS f32x4*)(md + 3 * DM))[lane + 64 * j], sc = ((const GAS f32x4*)(md + 4 * DM))[lane + 64 * j];
            const f32x4 o = (v[j] * rstd2) * g * (sc + 1.f) + sh;
            o8[64 * j] = (unsigned long long)pk2(o.x, o.y) | ((unsigned long long)pk2(o.z, o.w) << 32); }
    }
}
__device__ __forceinline__ void phase_convfix(const P& p, const float* hg, const float* hu, int gtid, int NGT) {
    constexpr int C4 = DFF / 4;
    for (int it = gtid; it < (MX / 64) * 2 * C4; it += NGT) {
        const int c0 = (it % C4) * 4, er = it / C4, blk = er >> 1, last = er & 1;
        const int row = blk * 64 + (last ? 63 : 0);
        const f32x4 z = (f32x4){0.f, 0.f, 0.f, 0.f};
        f32x4 gp, gc, gn;
        if (!last) { gp = (row & (SEQ - 1)) != 0 ? *(const GAS f32x4*)(hg + ((size_t)(blk - 1) * 4 + 3) * DFF + c0) : z; gc = *(const GAS f32x4*)(hg + ((size_t)blk * 4 + 0) * DFF + c0); gn = *(const GAS f32x4*)(hg + ((size_t)blk * 4 + 1) * DFF + c0); }
        else { gp = *(const GAS f32x4*)(hg + ((size_t)blk * 4 + 2) * DFF + c0); gc = *(const GAS f32x4*)(hg + ((size_t)blk * 4 + 3) * DFF + c0); gn = ((row + 1) & (SEQ - 1)) != 0 ? *(const GAS f32x4*)(hg + ((size_t)(blk + 1) * 4 + 0) * DFF + c0) : z; }
        const f32x4 up = *(const GAS f32x4*)(hu + ((size_t)blk * 2 + last) * DFF + c0);
        const f32x4 w0 = *(const GAS f32x4*)(p.conv_w + c0), w1 = *(const GAS f32x4*)(p.conv_w + DFF + c0), w2 = *(const GAS f32x4*)(p.conv_w + 2 * DFF + c0), cb = *(const GAS f32x4*)(p.conv_b + c0);
        const f32x4 cv = w0 * gp + w1 * gc + w2 * gn + cb;
        float o[4];
#pragma unroll
        for (int e = 0; e < 4; ++e) o[e] = cv[e] * __builtin_amdgcn_rcpf(1.f + __builtin_amdgcn_exp2f(-1.4426950408889634f * cv[e])) * up[e];
        *(GAS v2u*)(p.act + (size_t)row * DFF + c0) = (v2u){pk2(o[0], o[1]), pk2(o[2], o[3])};
    }
}
__device__ __forceinline__ void phase_final(const P& p, int gw, int NGW, int lane) {
    for (int row = gw; row < MX; row += NGW) {
        const float* md = p.mod + (size_t)(row / SEQ) * NMOD;
        const GAS f32x4* fr = (const GAS f32x4*)(p.f + (size_t)row * DM) + lane;
        f32x4 v[16]; float ss = 0.f;
#pragma unroll
        for (int j = 0; j < 16; ++j) { v[j] = fr[64 * j]; ss += (v[j].x * v[j].x + v[j].y * v[j].y) + (v[j].z * v[j].z + v[j].w * v[j].w); }
        const float rstd = rsqrtf(wave_sum(ss) * (1.f / DM) + EPS);
        GAS f32x4* xo = (GAS f32x4*)(p.out + (size_t)row * DM) + lane;
#pragma unroll
        for (int j = 0; j < 16; ++j) { const f32x4 g = ((const GAS f32x4*)p.g_post_ffn)[lane + 64 * j], ga = ((const GAS f32x4*)(md + 5 * DM))[lane + 64 * j];
            xo[64 * j] = xo[64 * j] + ga * ((v[j] * rstd) * g); }
    }
}

namespace att {
typedef short bf16x8 __attribute__((ext_vector_type(8)));
typedef short s16x4 __attribute__((ext_vector_type(4)));
typedef float f32x16 __attribute__((ext_vector_type(16)));
typedef unsigned u32x4 __attribute__((ext_vector_type(4)));
constexpr int KROWB = 384, KSLOT = 64 * KROWB, VSLOT = 16384, NSLOT = 3;
constexpr int L_K = 0, L_V = NSLOT * KSLOT, L_WS = L_V + NSLOT * VSLOT, L_END = L_WS + 8 * 256;
constexpr int OST_STRIDE = 272, OST_WAVE = 32 * OST_STRIDE;
static_assert(L_END <= 131072 && 8 * OST_WAVE <= L_V, "attention LDS map");
constexpr float THR2 = 8.f;
#define ATT_SBAR() __builtin_amdgcn_sched_barrier(0)
__device__ __forceinline__ int crow(int r, int hi) { return (r & 3) + 8 * (r >> 2) + 4 * hi; }
__device__ __forceinline__ unsigned cvtpk(float lo, float hi) { unsigned r; asm volatile("v_cvt_pk_bf16_f32 %0, %1, %2" : "=v"(r) : "v"(lo), "v"(hi)); return r; }
__device__ __forceinline__ void glds16(const void* gsrc, unsigned lds_dst) { unsigned keep;
    asm volatile("s_mov_b32 %0, m0\n\ts_mov_b32 m0, %2\n\ts_nop 0\n\tglobal_load_lds_dwordx4 %1, off\n\ts_mov_b32 m0, %0" : "=&s"(keep) : "v"(gsrc), "s"(lds_dst) : "memory"); }
#define ATT_WAITBAR(N) asm volatile("s_waitcnt vmcnt(" #N ") lgkmcnt(0)\n\ts_barrier" ::: "memory")

__device__ __forceinline__ void partialSM(f32x16& p0, f32x16& p1, float& m_reg, float& alpha) {
    float pmax = p0[0];
#pragma unroll
    for (int r = 1; r < 16; ++r) pmax = fmaxf(pmax, p0[r]);
#pragma unroll
    for (int r = 0; r < 16; ++r) pmax = fmaxf(pmax, p1[r]);
    { auto rr = __builtin_amdgcn_permlane32_swap(__float_as_uint(pmax), __float_as_uint(pmax), false, false); pmax = fmaxf(__uint_as_float(rr[0]), __uint_as_float(rr[1])); }
    float mn;
    if (__builtin_expect(__all(pmax - m_reg <= THR2), 1)) { mn = m_reg; alpha = 1.f; }
    else { mn = fmaxf(m_reg, pmax); alpha = __builtin_amdgcn_exp2f(m_reg - mn); m_reg = mn; }
#pragma unroll
    for (int r = 0; r < 16; ++r) { p0[r] -= mn; p1[r] -= mn; }
#pragma unroll
    for (int r = 0; r < 16; ++r) p0[r] = __builtin_amdgcn_exp2f(p0[r]);
}
__device__ __forceinline__ void finishSM(f32x16& p0, f32x16& p1, float alpha, float& l_reg, bf16x8& pa0, bf16x8& pa1, bf16x8& pa2, bf16x8& pa3) {
#pragma unroll
    for (int r = 0; r < 16; ++r) p1[r] = __builtin_amdgcn_exp2f(p1[r]);
    float ps = 0.f;
#pragma unroll
    for (int r = 0; r < 16; ++r) ps += p0[r];
#pragma unroll
    for (int r = 0; r < 16; ++r) ps += p1[r];
    { auto rr = __builtin_amdgcn_permlane32_swap(__float_as_uint(ps), __float_as_uint(ps), false, false); ps = __uint_as_float(rr[0]) + __uint_as_float(rr[1]); }
    l_reg = l_reg * alpha + ps;
#define ATT_PK4(P, BASE, OUT) do { unsigned a0 = cvtpk(P[BASE + 0], P[BASE + 1]), a1 = cvtpk(P[BASE + 2], P[BASE + 3]);   \
    unsigned b0 = cvtpk(P[BASE + 4], P[BASE + 5]), b1 = cvtpk(P[BASE + 6], P[BASE + 7]);                              \
    auto r0 = __builtin_amdgcn_permlane32_swap(a0, b0, false, false); auto r1 = __builtin_amdgcn_permlane32_swap(a1, b1, false, false); \
    u32x4 w = {r0[0], r1[0], r0[1], r1[1]}; OUT = __builtin_bit_cast(bf16x8, w); } while (0)
    ATT_PK4(p0, 0, pa0); ATT_PK4(p0, 8, pa1); ATT_PK4(p1, 0, pa2); ATT_PK4(p1, 8, pa3);
#undef ATT_PK4
}
__device__ __forceinline__ void qkt(f32x16& p0, f32x16& p1, const LAS unsigned char* Ks, const bf16x8 (&qr)[12], int r32, int hi) {
    p0 = f32x16{}; p1 = f32x16{};
    const int sw = (r32 & 7) << 4; const LAS unsigned char* ra = Ks + r32 * KROWB; const LAS unsigned char* rb = ra + 32 * KROWB;
    int lo[4];
#pragma unroll
    for (int q = 0; q < 4; ++q) lo[q] = (q * 32 + hi * 16) ^ sw;
#pragma unroll
    for (int d0 = 0; d0 < 12; ++d0) { const int off = lo[d0 & 3] + (d0 >> 2) * 128;
        const bf16x8 b0 = *(const LAS bf16x8*)(ra + off), b1 = *(const LAS bf16x8*)(rb + off);
        p0 = __builtin_amdgcn_mfma_f32_32x32x16_bf16(b0, qr[d0], p0, 0, 0, 0);
        p1 = __builtin_amdgcn_mfma_f32_32x32x16_bf16(b1, qr[d0], p1, 0, 0, 0); }
}
__device__ __forceinline__ int v_rd_base(int lane) { return ((lane & 3) << 3) | (((lane >> 2) & 3) << 6) | (((lane >> 4) & 1) << 5) | (((lane >> 5) & 1) << 8); }
constexpr int v_rd_off(int d0, int ks, int half) { return d0 * 512 + ks * 4096 + half * 2048; }
template <int OFF> __device__ __forceinline__ s16x4 tr_read(int vb) { s16x4 r; asm volatile("ds_read_b64_tr_b16 %0, %1 offset:%2" : "=&v"(r) : "v"(vb), "i"(OFF) : "memory"); return r; }
template <int D0> __device__ __forceinline__ void pv_one(f32x16& od, int vb, bf16x8 pa0, bf16x8 pa1, bf16x8 pa2, bf16x8 pa3) {
    const s16x4 l0 = tr_read<v_rd_off(D0, 0, 0)>(vb), h0 = tr_read<v_rd_off(D0, 0, 1)>(vb), l1 = tr_read<v_rd_off(D0, 1, 0)>(vb), h1 = tr_read<v_rd_off(D0, 1, 1)>(vb);
    const s16x4 l2 = tr_read<v_rd_off(D0, 2, 0)>(vb), h2 = tr_read<v_rd_off(D0, 2, 1)>(vb), l3 = tr_read<v_rd_off(D0, 3, 0)>(vb), h3 = tr_read<v_rd_off(D0, 3, 1)>(vb);
    asm volatile("s_waitcnt lgkmcnt(0)" ::: "memory"); ATT_SBAR();
#define ATT_PK(Lo, Hi) (bf16x8){Lo[0], Lo[1], Lo[2], Lo[3], Hi[0], Hi[1], Hi[2], Hi[3]}
    od = __builtin_amdgcn_mfma_f32_32x32x16_bf16(pa0, ATT_PK(l0, h0), od, 0, 0, 0);
    od = __builtin_amdgcn_mfma_f32_32x32x16_bf16(pa1, ATT_PK(l1, h1), od, 0, 0, 0);
    od = __builtin_amdgcn_mfma_f32_32x32x16_bf16(pa2, ATT_PK(l2, h2), od, 0, 0, 0);
    od = __builtin_amdgcn_mfma_f32_32x32x16_bf16(pa3, ATT_PK(l3, h3), od, 0, 0, 0);
#undef ATT_PK
}
__device__ __forceinline__ void pv_d0(f32x16 (&o)[4], int vb, bf16x8 pa0, bf16x8 pa1, bf16x8 pa2, bf16x8 pa3) {
    pv_one<0>(o[0], vb, pa0, pa1, pa2, pa3); pv_one<1>(o[1], vb, pa0, pa1, pa2, pa3); pv_one<2>(o[2], vb, pa0, pa1, pa2, pa3); pv_one<3>(o[3], vb, pa0, pa1, pa2, pa3);
}
}

__device__ __forceinline__ void phase_attn(const P& p, LAS unsigned char* L, int blk, int G) {
    using namespace att;
    const int tid = ltid(), lane = tid & 63, wid = __builtin_amdgcn_readfirstlane(tid >> 6), r32 = lane & 31, hi = lane >> 5;
    const unsigned lds0 = (unsigned)(uintptr_t)L;
    unsigned koff[3], voff[2]; bool krp[3];
#pragma unroll
    for (int i = 0; i < 3; ++i) { const int o = (wid + 8 * i) * 1024 + lane * 16; const int row = o / KROWB; const int cbs = o - row * KROWB; const int colB = cbs ^ ((row & 7) << 4);
        krp[i] = colB >= 256; koff[i] = krp[i] ? (unsigned)(row * (ROPED * 2) + (colB - 256)) : (unsigned)(row * (NKV * 2) + colB); }
#pragma unroll
    for (int i = 0; i < 2; ++i) { const int st = 2 * (wid + 8 * i) + (lane >> 5); const int kk = ((st >> 2) << 3) | ((lane & 31) >> 2); const int k = (kk & ~0xC) | ((kk & 4) << 1) | ((kk & 8) >> 1);
        const int c = (st & 3) * 32 + 8 * (lane & 3); voff[i] = (unsigned)(k * (NKV * 2) + (128 + c) * 2); }
    LAS float* wsf = (LAS float*)(L + L_WS) + wid * 64; LAS float* li_l = wsf; LAS float* al_l = wsf + 32;
    const int vb0 = (int)(lds0 + L_V) + v_rd_base(lane);
    const LAS unsigned char* Kb = L + L_K;
    const int NU = NB * NH * (SEQ / 256);
    for (int it = 0;; ++it) {
        int bh, qb;
        if (G == 256) { if (it >= 6) break; const int xcd = blk & 7, idx = blk >> 3; bh = it * 16 + xcd * 2 + (idx >> 4); qb = idx & 15; }
        else { const int unit = blk + G * it; if (unit >= NU) break; bh = unit >> 4; qb = unit & 15; }
        const int b = bh / NH, h = bh % NH;
        const size_t qrow0 = (size_t)b * SEQ + qb * 256 + wid * 32;
#define ATT_RB(t) ((t) < 4 ? (size_t)MX + (size_t)b * CTXL + (size_t)(t) * 64 : (size_t)b * SEQ + (size_t)((t) - 4) * 64)
#define ATT_DMA_K(t, slot) do { const size_t rb_ = ATT_RB(t); const char* kvt_ = (const char*)(p.kv + rb_ * NKV + h * 256); const char* krt_ = (const char*)(p.krope + rb_ * ROPED); \
        _Pragma("unroll") for (int i_ = 0; i_ < 3; ++i_) glds16((krp[i_] ? krt_ : kvt_) + koff[i_], (unsigned)__builtin_amdgcn_readfirstlane(lds0 + L_K + (slot) * KSLOT + (wid + 8 * i_) * 1024)); } while (0)
#define ATT_DMA_V(t, slot) do { const size_t rb_ = ATT_RB(t); const char* kvt_ = (const char*)(p.kv + rb_ * NKV + h * 256); \
        _Pragma("unroll") for (int i_ = 0; i_ < 2; ++i_) glds16(kvt_ + voff[i_], (unsigned)__builtin_amdgcn_readfirstlane(lds0 + L_V + (slot) * VSLOT + (wid + 8 * i_) * 1024)); } while (0)
        ATT_DMA_K(0, 0); ATT_DMA_V(0, 0); ATT_DMA_K(1, 1);
        bf16x8 qr[12];
        { const bf16* qp = p.q + (qrow0 + r32) * NQ + h * DQK + hi * 8;
#pragma unroll
          for (int d0 = 0; d0 < 12; ++d0) qr[d0] = *(const GAS bf16x8*)(qp + d0 * 16); }
        float m_reg = -1e30f, l_reg = 0.f; f32x16 o[4] = {};
        f32x16 pA0, pA1, pB0, pB1; float alA, alB; bf16x8 pa0, pa1, pa2, pa3;
#define ATT_RESC(a) do { if (__any((a) < 1.f)) { if (hi == 0) al_l[r32] = (a); asm volatile("s_waitcnt lgkmcnt(0)" ::: "memory"); \
        _Pragma("unroll") for (int d_ = 0; d_ < 4; ++d_) _Pragma("unroll") for (int r_ = 0; r_ < 16; ++r_) o[d_][r_] *= al_l[crow(r_, hi)]; } } while (0)
        ATT_DMA_V(1, 1); ATT_DMA_K(2, 2);
        ATT_WAITBAR(5);
        qkt(pA0, pA1, Kb, qr, r32, hi); partialSM(pA0, pA1, m_reg, alA);
        ATT_WAITBAR(5);
#define ATT_STEP(j, C0, C1, ALC, P0, P1, ALP) do { const int j_ = (j); \
        if (j_ + 1 < NKT) ATT_DMA_V(j_ + 1, (j_ + 1) % 3); if (j_ + 2 < NKT) ATT_DMA_K(j_ + 2, (j_ + 2) % 3); \
        ATT_SBAR(); qkt(C0, C1, Kb + (j_ % 3) * KSLOT, qr, r32, hi); \
        finishSM(P0, P1, ALP, l_reg, pa0, pa1, pa2, pa3); ATT_SBAR(); \
        pv_d0(o, vb0 + ((j_ - 1) % 3) * VSLOT, pa0, pa1, pa2, pa3); partialSM(C0, C1, m_reg, ALC); \
        ATT_RESC(ALC); \
        if (j_ + 2 < NKT) ATT_WAITBAR(5); else ATT_WAITBAR(0); } while (0)
        for (int j = 1; j + 1 < NKT; j += 2) {
            ATT_STEP(j, pB0, pB1, alB, pA0, pA1, alA);
            ATT_STEP(j + 1, pA0, pA1, alA, pB0, pB1, alB);
        }
        ATT_STEP(NKT - 1, pB0, pB1, alB, pA0, pA1, alA);
        finishSM(pB0, pB1, alB, l_reg, pa0, pa1, pa2, pa3); ATT_SBAR();
        pv_d0(o, vb0 + ((NKT - 1) % 3) * VSLOT, pa0, pa1, pa2, pa3);
        if (hi == 0) li_l[r32] = l_reg; asm volatile("s_waitcnt lgkmcnt(0)" ::: "memory");
        float rli[16];
#pragma unroll
        for (int r = 0; r < 16; ++r) rli[r] = __builtin_amdgcn_rcpf(li_l[crow(r, hi)]);
        LAS unsigned char* Os = L + L_K + wid * OST_WAVE;
#pragma unroll
        for (int r = 0; r < 16; ++r) { const int orow = crow(r, hi);
#pragma unroll
            for (int d0 = 0; d0 < 4; ++d0) *(LAS unsigned short*)(Os + orow * OST_STRIDE + (d0 * 32 + r32) * 2) = (unsigned short)cvtpk(o[d0][r] * rli[r], 0.f); }
        asm volatile("s_waitcnt lgkmcnt(0)" ::: "memory");
        { bf16* Ow = p.mixin + qrow0 * DM + S5W + h * DV;
#pragma unroll
          for (int i = 0; i < 8; ++i) { const int row = i * 4 + (lane >> 4), ch = lane & 15; const u32x4 v = *(const LAS u32x4*)(Os + row * OST_STRIDE + ch * 16); *(GAS u32x4*)(Ow + (size_t)row * DM + ch * 8) = v; } }
        ATT_WAITBAR(0);
#undef ATT_STEP
#undef ATT_RESC
#undef ATT_DMA_K
#undef ATT_DMA_V
#undef ATT_RB
    }
}

namespace s5 {
constexpr int TS = 32;
constexpr int NCH = (CTXL + SEQ) / TS, NCTX = CTXL / TS, NLAT = SEQ / TS, KD = TS * 16, NKB = KD / 32;
constexpr int UCH = TS * 32 + 16;
constexpr int L_LAG = 0, LAG_BYTES = (TS + 1) * 512;
constexpr int L_U = L_LAG + LAG_BYTES;
constexpr int SROW = 528;
constexpr int L_S = L_U + 16 * UCH;
constexpr int L_END = L_S + NCH * SROW;
static_assert(L_END <= 131072 && (L_U % 16) == 0 && (L_S % 16) == 0 && TS % 8 == 0 && NCTX <= 16 && NLAT % 16 == 0, "s5 LDS map");
typedef short bf16x8 __attribute__((ext_vector_type(8)));
}
__device__ __forceinline__ void s5_tables_a(const P& p, float* pw, bf16* w1t, bf16* w3t, float* at, int gtid, int NGT) {
    constexpr int TS = s5::TS, KD = s5::KD;
    for (int it = gtid; it < 128 * 64 * (TS + 1); it += NGT) {
        const int pp = it & 63, l = (it >> 6) % (TS + 1), dg = (it >> 6) / (TS + 1), sidx = dg * 64 + pp;
        const float lr = p.lam_re[sidx], li = p.lam_im[sidx], dt = expf(p.log_step[dg]), fl = (float)l;
        float sn, cs; sincosf(li * dt * fl, &sn, &cs); const float mg = expf(lr * dt * fl);
        const float pr = mg * cs, pi = mg * sn;
        pw[(((size_t)dg * (TS + 1) + l) * 64 + pp) * 2] = pr; pw[(((size_t)dg * (TS + 1) + l) * 64 + pp) * 2 + 1] = pi;
        if (l <= TS - 1) { const int i = TS - 1 - l;
            const f32x4* brp = (const f32x4*)(p.bbr + (size_t)sidx * 16); const f32x4* bip = (const f32x4*)(p.bbi + (size_t)sidx * 16);
            unsigned wr_[8], wi_[8];
#pragma unroll
            for (int v = 0; v < 4; ++v) { const f32x4 r4 = brp[v], i4 = bip[v];
                wr_[2 * v] = pk2(pr * r4.x - pi * i4.x, pr * r4.y - pi * i4.y); wr_[2 * v + 1] = pk2(pr * r4.z - pi * i4.z, pr * r4.w - pi * i4.w);
                wi_[2 * v] = pk2(pr * i4.x + pi * r4.x, pr * i4.y + pi * r4.y); wi_[2 * v + 1] = pk2(pr * i4.z + pi * r4.z, pr * i4.w + pi * r4.w); }
            GAS v4u* d0 = (GAS v4u*)(w1t + ((size_t)dg * 128 + 2 * pp) * KD + 16 * i); GAS v4u* d1 = (GAS v4u*)(w1t + ((size_t)dg * 128 + 2 * pp + 1) * KD + 16 * i);
            d0[0] = (v4u){wr_[0], wr_[1], wr_[2], wr_[3]}; d0[1] = (v4u){wr_[4], wr_[5], wr_[6], wr_[7]}; d1[0] = (v4u){wi_[0], wi_[1], wi_[2], wi_[3]}; d1[1] = (v4u){wi_[4], wi_[5], wi_[6], wi_[7]}; }
        if (l >= 1) { const int j = l - 1;
#pragma unroll
            for (int co = 0; co < 16; ++co) { const float cr = p.c_re[((size_t)dg * 16 + co) * 64 + pp], ci = p.c_im[((size_t)dg * 16 + co) * 64 + pp];
                *(GAS unsigned*)(w3t + ((size_t)dg * KD + 16 * j + co) * 128 + 2 * pp) = pk2(cr * pr - ci * pi, -(cr * pi + ci * pr)); } }
        if (l == TS) { at[(size_t)sidx * 2] = pr; at[(size_t)sidx * 2 + 1] = pi; }
    }
}
__device__ __forceinline__ void s5_tables_b(const P& p, const float* pw, bf16* lagk, int gtid, int NGT) {
    constexpr int TS = s5::TS;
    for (int it = gtid; it < 128 * (TS + 1) * 64; it += NGT) {
        const int c4 = it & 3, co = (it >> 2) & 15, lp = (it >> 6) % (TS + 1), dg = (it >> 6) / (TS + 1);
        float a0 = 0.f, a1 = 0.f, a2 = 0.f, a3 = 0.f;
        if (lp > 0) { const int l = lp - 1;
            const float* crp = p.c_re + ((size_t)dg * 16 + co) * 64; const float* cip = p.c_im + ((size_t)dg * 16 + co) * 64; const float* pwp = pw + ((size_t)dg * (TS + 1) + l) * 128;
            const float* brp = p.bbr + (size_t)dg * 1024 + c4 * 4; const float* bip = p.bbi + (size_t)dg * 1024 + c4 * 4;
#pragma unroll 8
            for (int pp = 0; pp < 64; ++pp) {
                const float cr = crp[pp], ci = cip[pp], pr = pwp[2 * pp], pi = pwp[2 * pp + 1];
                const float xr = cr * pr - ci * pi, xi = cr * pi + ci * pr;
                const f32x4 r4 = *(const f32x4*)(brp + pp * 16), i4 = *(const f32x4*)(bip + pp * 16);
                a0 += xr * r4.x - xi * i4.x; a1 += xr * r4.y - xi * i4.y; a2 += xr * r4.z - xi * i4.z; a3 += xr * r4.w - xi * i4.w; } }
        *(GAS v2u*)(lagk + (((size_t)dg * (TS + 1) + lp) * 16 + co) * 16 + c4 * 4) = (v2u){pk2(a0, a1), pk2(a2, a3)};
    }
}
__device__ __forceinline__ void phase_s5(const P& p, const bf16* lagk, const bf16* w1t, const bf16* w3t, const float* at, LAS unsigned char* L, int blk, int G) {
    using namespace s5;
    const int tid = ltid(), lane = tid & 63, wid = __builtin_amdgcn_readfirstlane(tid >> 6), ml = lane & 15, q = lane >> 4;
    for (int unit = blk; unit < NB * 2 * 64; unit += G) {
        const int g = unit & 63, dir = (unit >> 6) & 1, b = unit >> 7, dg = dir * 64 + g;
#define S5_ROW(s) ((dir == 0) ? ((s) < CTXL ? (size_t)MX + (size_t)b * CTXL + (s) : (size_t)b * SEQ + ((s) - CTXL)) : ((s) < CTXL ? (size_t)MX + (size_t)b * CTXL + (CTXL - 1 - (s)) : (size_t)b * SEQ + (SEQ - 1 - ((s) - CTXL))))
#define S5_LOAD(s0, nvalid, A_, B_) do { const int m_ = tid / TS, i_ = tid % TS; A_ = (v4u){0u, 0u, 0u, 0u}; B_ = A_; \
            if (m_ < (nvalid)) { const int s_ = (s0) + TS * m_ + i_; const bf16* src_ = p.px + S5_ROW(s_) * INCP + g * 16; A_ = *(const GAS v4u*)src_; B_ = *(const GAS v4u*)(src_ + 8); } } while (0)
#define S5_PUT(A_, B_) do { const int m_ = tid / TS, i_ = tid % TS; *(LAS v4u*)(L + L_U + m_ * UCH + i_ * 32) = A_; *(LAS v4u*)(L + L_U + m_ * UCH + i_ * 32 + 16) = B_; } while (0)
        static_assert(16 * TS == 512, "one (chunk, step) pair per thread");
        __syncthreads();
        for (int c = tid; c < LAG_BYTES / 16; c += 512) *(LAS v4u*)(L + L_LAG + c * 16) = *(const GAS v4u*)(lagk + (size_t)dg * (LAG_BYTES / 2) + c * 8);
        bf16x8 w1[NKB];
        { const bf16* wp = w1t + ((size_t)dg * 128 + wid * 16 + ml) * KD + 8 * q;
#pragma unroll
          for (int kb = 0; kb < NKB; ++kb) w1[kb] = *(const GAS bf16x8*)(wp + kb * 32); }
        v4u pa_, pb_; S5_LOAD(0, NCTX, pa_, pb_);
        for (int tl = 0; tl <= NLAT / 16; ++tl) {
            __syncthreads();
            S5_PUT(pa_, pb_);
            if (tl < NLAT / 16) S5_LOAD(CTXL + 16 * TS * tl, 16, pa_, pb_);
            __syncthreads();
            pg8::f32x4 acc = (pg8::f32x4){0.f, 0.f, 0.f, 0.f};
#pragma unroll
            for (int k8 = 0; k8 < NKB / 8; ++k8) { bf16x8 a[8];
#pragma unroll
                for (int kk = 0; kk < 8; ++kk) a[kk] = *(const LAS bf16x8*)(L + L_U + ml * UCH + (2 * (8 * k8 + kk) + (q >> 1)) * 32 + (q & 1) * 16);
#pragma unroll
                for (int kk = 0; kk < 8; ++kk) acc = __builtin_amdgcn_mfma_f32_16x16x32_bf16(a[kk], w1[8 * k8 + kk], acc, 0, 0, 0);
                __builtin_amdgcn_sched_barrier(0); }
#pragma unroll
            for (int r = 0; r < 4; ++r) { const int m = 4 * q + r; const int ck = tl == 0 ? m : NCTX + 16 * (tl - 1) + m; if (tl > 0 || m < NCTX) *(LAS float*)(L + L_S + ck * SROW + (wid * 16 + ml) * 4) = acc[r]; }
        }
        __syncthreads();
        if (tid < 64) { const float tr = at[((size_t)dg * 64 + tid) * 2], ti = at[((size_t)dg * 64 + tid) * 2 + 1]; float hr = 0.f, hi = 0.f;
            for (int c8 = 0; c8 < NCH; c8 += 8) {
                float sr[8], si[8]; unsigned hw[8];
#pragma unroll
                for (int e = 0; e < 8; ++e) { const pg8::f32x2 v = *(const LAS pg8::f32x2*)(L + L_S + (c8 + e) * SROW + tid * 8); sr[e] = v.x; si[e] = v.y; }
                asm volatile("s_waitcnt lgkmcnt(0)" ::: "memory");
#pragma unroll
                for (int e = 0; e < 8; ++e) { hw[e] = pk2(hr, hi); const float nr = tr * hr - ti * hi + sr[e], ni = tr * hi + ti * hr + si[e]; hr = nr; hi = ni; }
#pragma unroll
                for (int e = 0; e < 8; ++e) *(LAS unsigned*)(L + L_S + (c8 + e) * SROW + tid * 4) = hw[e];
                asm volatile("s_waitcnt lgkmcnt(0)" ::: "memory"); } }
        static_assert(NCH % 8 == 0, "carry batches");
        bf16x8 w3[TS / 8][4];
#pragma unroll
        for (int jj = 0; jj < TS / 8; ++jj) { const bf16* wp = w3t + ((size_t)dg * KD + (wid + 8 * jj) * 16 + ml) * 128 + 8 * q;
#pragma unroll
            for (int kb = 0; kb < 4; ++kb) w3[jj][kb] = *(const GAS bf16x8*)(wp + kb * 32); }
        v4u na, nb; S5_LOAD(CTXL, 16, na, nb);
        for (int lt = 0; lt < NLAT / 16; ++lt) {
            __syncthreads();
            S5_PUT(na, nb);
            if (lt + 1 < NLAT / 16) S5_LOAD(CTXL + 16 * TS * (lt + 1), 16, na, nb);
            __syncthreads();
#pragma unroll
            for (int jj = 0; jj < TS / 8; ++jj) { const int j = wid + 8 * jj;
                pg8::f32x4 acc = (pg8::f32x4){0.f, 0.f, 0.f, 0.f};
                const LAS unsigned char* ua = L + L_U + ml * UCH + (q >> 1) * 32 + (q & 1) * 16;
                const LAS unsigned char* la = L + L_LAG + (j - (q >> 1) + 1) * 512 + ml * 32 + (q & 1) * 16;
                for (int kb = 0; kb <= (j >> 1); ++kb) { const bf16x8 a = *(const LAS bf16x8*)(ua + kb * 64), bb = *(const LAS bf16x8*)(la - kb * 1024); acc = __builtin_amdgcn_mfma_f32_16x16x32_bf16(a, bb, acc, 0, 0, 0); }
#pragma unroll
                for (int kb = 0; kb < 4; ++kb) { const bf16x8 a = *(const LAS bf16x8*)(L + L_S + (NCTX + lt * 16 + ml) * SROW + kb * 64 + q * 16); acc = __builtin_amdgcn_mfma_f32_16x16x32_bf16(a, w3[jj][kb], acc, 0, 0, 0); }
#pragma unroll
                for (int r = 0; r < 4; ++r) { const int sl = 16 * TS * lt + TS * (4 * q + r) + j; const int t = dir == 0 ? sl : SEQ - 1 - sl;
                    p.ydir[((size_t)dir * MX + (size_t)b * SEQ + t) * S5W + g * 16 + ml] = acc[r]; }
            }
        }
#undef S5_LOAD
#undef S5_PUT
#undef S5_STAGE
#undef S5_ROW
    }
}

constexpr int N_PHASES = 16;
struct Args { const float* in[29]; float* out; unsigned char* ws; int ph_lo, ph_hi, li, pad; };
__global__ void __launch_bounds__(NWAVES * 64, 2) skel_fwd(Args args) {
    extern __shared__ __attribute__((aligned(16))) unsigned char lds_raw[];
    LAS unsigned char* lds = (LAS unsigned char*)lds_raw;
    volatile LAS unsigned* MISC = (volatile LAS unsigned*)(lds + MISC_OFF);
    const int G = gridDim.x, blk = blockIdx.x;
    const int vcu = (G % 8 == 0) ? (blk % 8) * (G / 8) + blk / 8 : blk;
    const int NGW = G * NWAVES, NGT = G * NWAVES * 64;
#define IDS() const int tid = ltid(), lane = tid & 63, wave = __builtin_amdgcn_readfirstlane(tid >> 6), gw = vcu * NWAVES + wave, gtid = blk * (NWAVES * 64) + tid; (void)lane; (void)gw; (void)gtid
    unsigned char* ws = args.ws;
    P p;
    p.x = args.in[0]; p.c = args.in[1]; p.ctx = args.in[2]; p.cctx = args.in[3]; p.w_ada = args.in[4]; p.b_ada = args.in[5];
    p.g_pre_mix = args.in[6]; p.g_post_mix = args.in[7]; p.g_pre_ffn = args.in[8]; p.g_post_ffn = args.in[9]; p.w_in = args.in[10];
    p.lam_re = args.in[11]; p.lam_im = args.in[12]; p.log_step = args.in[13]; p.b_re = args.in[14]; p.b_im = args.in[15]; p.c_re = args.in[16]; p.c_im = args.in[17];
    p.s5d = args.in[18]; p.w_glu = args.in[19]; p.g_q = args.in[20]; p.w_uq = args.in[21]; p.g_kv = args.in[22]; p.w_ukv = args.in[23]; p.w_out = args.in[24];
    p.ffn_w_in = args.in[25]; p.conv_w = args.in[26]; p.conv_b = args.in[27]; p.ffn_w_down = args.in[28];
    p.out = args.out;
    p.mod = (float*)(ws + WS_MOD); p.abar = (float*)(ws + WS_S5A); p.bbr = (float*)(ws + WS_S5BR); p.bbi = (float*)(ws + WS_S5BI); p.rope = (float*)(ws + WS_ROPE); p.part = (float*)(ws + WS_PART);
    p.mix = (float*)(ws + WS_MIX); p.f = (float*)(ws + WS_F); p.ydir = (float*)(ws + WS_YDIR);
    p.WinT = (bf16*)(ws + WS_WIN); p.WuqT = (bf16*)(ws + WS_WUQ); p.WukvT = (bf16*)(ws + WS_WUKV); p.WgluT = (bf16*)(ws + WS_WGLU); p.WoutT = (bf16*)(ws + WS_WOUT); p.WfinT = (bf16*)(ws + WS_WFIN); p.WdownT = (bf16*)(ws + WS_WDOWN);
    p.h = (bf16*)(ws + WS_H); p.px = (bf16*)(ws + WS_PX); p.qcn = (bf16*)(ws + WS_QCN); p.kvcn = (bf16*)(ws + WS_KVCN); p.krope = (bf16*)(ws + WS_KROPE); p.q = (bf16*)(ws + WS_Q); p.kv = (bf16*)(ws + WS_KV);
    p.mixin = (bf16*)(ws + WS_MIXIN); p.yg = (bf16*)(ws + WS_YG); p.hx = (bf16*)(ws + WS_HX); p.act = (bf16*)(ws + WS_ACT);

    for (int u = ltid(); u < (LDS_BYTES - LDSCTL_OFF) / 4; u += NWAVES * 64) ((LAS unsigned*)(lds + LDSCTL_OFF))[u] = 0u;
    __syncthreads();
#if MK_ONE_LAUNCH
    XcdBarrier bar = xcd_barrier_post((unsigned*)(ws + WS_CTL) + CW_BAR, MISC + 8);
#define GRID_BAR() xcd_barrier(bar)
#else
    (void)MISC;
#define GRID_BAR() do { } while (0)
#endif
    const int lo = args.ph_lo, hi = args.ph_hi;
#define IN(k) (lo <= (k) && (k) < hi)
#define SEAM(k) do { if (IN(k) && IN((k) + 1)) GRID_BAR(); } while (0)
    typedef pg8::StaticOrder SO;

    bf16* s5_lagk = (bf16*)(ws + WS_S5LAG); bf16* s5_w1t = (bf16*)(ws + WS_S5W1); bf16* s5_w3t = (bf16*)(ws + WS_S5W3); float* s5_at = (float*)(ws + WS_S5AT); float* s5_pw = (float*)(ws + WS_S5PW);
    if (IN(0)) { IDS(); phase_prologue(p, lds, gw, NGW, wave, lane, gtid, NGT); } SEAM(0);
    if (IN(1)) { IDS(); phase_modreduce(p, gtid, NGT); s5_tables_a(p, s5_pw, s5_w1t, s5_w3t, s5_at, gtid, NGT); } SEAM(1);
    if (IN(2)) { IDS(); phase_norm1(p, gw, NGW, lane); s5_tables_b(p, s5_pw, s5_lagk, gtid, NGT); } SEAM(2);
    if (IN(3)) { pg8::Gemm g{p.h, p.WinT, MALL, INCP, DM}; SO S; S.init(MALL, INCP, G, blk); pg8::EpiBf16P E{p.px, INCP};
                 pg8::gemm_phase<pg8::EpiBf16P, SO, true, true>(lds, g, S, E); } SEAM(3);
    if (IN(4)) { IDS(); phase_postin(p, gw, NGW, lane); } SEAM(4);
    if (IN(5)) { { pg8::Gemm g{p.qcn, p.WuqT, MX, NQ, QRANK}; SO S; S.init(MX, NQ, G, blk); pg8::EpiQ E{p.q, p.rope, QSCALE};
                   pg8::gemm_phase<pg8::EpiQ, SO, true, true>(lds, g, S, E); }
                 { pg8::Gemm g{p.kvcn, p.WukvT, MALL, NKV, KVRANK}; SO S; S.init(MALL, NKV, G, blk); pg8::EpiBf16P E{p.kv, NKV};
                   pg8::gemm_phase<pg8::EpiBf16P, SO, true, true>(lds, g, S, E); } } SEAM(5);
    if (IN(6)) { phase_attn(p, lds, blk, G); } SEAM(6);
    if (IN(7)) { phase_s5(p, s5_lagk, s5_w1t, s5_w3t, s5_at, lds, blk, G); } SEAM(7);
    if (IN(8)) { IDS(); phase_s5gelu(p, gtid, NGT); } SEAM(8);
    if (IN(9)) { pg8::Gemm g{p.yg, p.WgluT, MX, S5W, S5W}; SO S; S.init(MX, S5W, G, blk); pg8::EpiGlu E{p.yg, p.mixin, DM};
                 pg8::gemm_phase<pg8::EpiGlu, SO, true, true>(lds, g, S, E); } SEAM(9);
    if (IN(10)) { pg8::Gemm g{p.mixin, p.WoutT, MX, DM, DM}; SO S; S.init(MX, DM, G, blk); pg8::EpiF32P E{p.mix, DM};
                  pg8::gemm_phase<pg8::EpiF32P, SO, true, true>(lds, g, S, E); } SEAM(10);
    if (IN(11)) { IDS(); phase_mid(p, gw, NGW, lane); } SEAM(11);
    float* halo_g = (float*)(ws + WS_HG); float* halo_u = (float*)(ws + WS_HU);
    if (IN(12)) { pg8::Gemm g{p.hx, p.WfinT, MX, 2 * DFF, DM}; SO S; S.init(MX, 2 * DFF, G, blk); pg8::EpiConvAct E{p.act, p.conv_w, p.conv_b, halo_g, halo_u, DFF};
                  pg8::gemm_phase<pg8::EpiConvAct, SO, true, true>(lds, g, S, E); } SEAM(12);
    if (IN(13)) { IDS(); phase_convfix(p, halo_g, halo_u, gtid, NGT); } SEAM(13);
    if (IN(14)) { pg8::Gemm g{p.act, p.WdownT, MX, DM, DFF}; SO S; S.init(MX, DM, G, blk); pg8::EpiF32P E{p.f, DM};
                  pg8::gemm_phase<pg8::EpiF32P, SO, true, true>(lds, g, S, E); } SEAM(14);
    if (IN(15)) { IDS(); phase_final(p, gw, NGW, lane); }
#undef IN
#undef SEAM
}

extern "C" void kernel_launch(void* const* d_in, const int* in_sizes, int n_in, void* d_out, int out_size, void* d_ws, size_t ws_size, hipStream_t stream) {
    static int grid = 0;
    if (grid == 0) {
        if (n_in != 29 || out_size != MX * DM || ws_size < WS_END) { fprintf(stderr, "kernel_launch: unexpected shapes: n_in %d out %d ws %zu (need %zu)\n", n_in, out_size, ws_size, (size_t)WS_END); grid = -1; return; }
        int dev = 0, cus = 0;
        if (hipGetDevice(&dev) != hipSuccess || hipDeviceGetAttribute(&cus, hipDeviceAttributeMultiprocessorCount, dev) != hipSuccess) { grid = -1; return; }
        if (hipFuncSetAttribute((const void*)skel_fwd, hipFuncAttributeMaxDynamicSharedMemorySize, LDS_BYTES) != hipSuccess) { fprintf(stderr, "kernel_launch: hipFuncSetAttribute failed\n"); grid = -1; return; }
        int per_cu = 0;
        if (hipOccupancyMaxActiveBlocksPerMultiprocessor(&per_cu, (const void*)skel_fwd, NWAVES * 64, LDS_BYTES) != hipSuccess || per_cu < 1) fprintf(stderr, "kernel_launch: occupancy query says %d\n", per_cu);
        (void)hipGetLastError();
        grid = cus;
    }
    if (grid < 0) return;
    (void)hipMemsetAsync((char*)d_ws + WS_CTL, 0, CTL_ZERO_BYTES, stream);
    Args a{};
    for (int i = 0; i < 29; ++i) a.in[i] = (const float*)d_in[i];
    a.out = (float*)d_out; a.ws = (unsigned char*)d_ws;
#if MK_ONE_LAUNCH
    a.ph_lo = 0; a.ph_hi = N_PHASES; a.li = 0;
    hipLaunchKernelGGL(skel_fwd, dim3(grid), dim3(NWAVES * 64), LDS_BYTES, stream, a);
#else
    for (int ph = 0; ph < N_PHASES; ++ph) { a.ph_lo = ph; a.ph_hi = ph + 1; a.li = ph; hipLaunchKernelGGL(skel_fwd, dim3(grid), dim3(NWAVES * 64), LDS_BYTES, stream, a); }
#endif
    const hipError_t le = hipPeekAtLastError();
    if (le != hipSuccess) fprintf(stderr, "kernel_launch: launch failed: %s\n", hipGetErrorName(le));
}
```
